# Optimizing an MI355X kernel written in HIP

```python
import math
import jax, jax.numpy as jnp
from jax import lax
import numpy as np

D_MODEL = 1024
BATCH = 2
SEQ = 8192
DEPTH = 2
DEC_BATCH = 128
DEC_SEQ = 4
PAST_LEN = 8192
PAGE_SIZE = 128

N_Q_HEADS = 8
N_KV_HEADS = 2
HEAD_DIM = D_MODEL // 16
GQA_GROUP = N_Q_HEADS // N_KV_HEADS
ATTN_WIDTH = N_Q_HEADS * HEAD_DIM
KV_WIDTH = N_KV_HEADS * HEAD_DIM
CONV_DIM = D_MODEL // 2
CONV_WIDTH = 3
MIX_WIDTH = ATTN_WIDTH + CONV_DIM
IN_WIDTH = ATTN_WIDTH + 2 * KV_WIDTH + 3 * CONV_DIM
SPLITS = [ATTN_WIDTH, ATTN_WIDTH + KV_WIDTH, ATTN_WIDTH + 2 * KV_WIDTH,
          ATTN_WIDTH + 2 * KV_WIDTH + CONV_DIM, ATTN_WIDTH + 2 * KV_WIDTH + 2 * CONV_DIM]
WINDOW = 128
BLOCK = WINDOW
N_BUCKETS = 32
MAX_DISTANCE = WINDOW
D_FF = ((8 * D_MODEL + 3 * 256 - 1) // (3 * 256)) * 256
EPS = 1e-6
NEG = -1e30
SCALE = HEAD_DIM ** -0.5

kernel_name = "hymba_swa_sink_shortconv_step"


def rms(x):
    xf = x.astype(jnp.float32)
    return (xf * lax.rsqrt(jnp.mean(xf * xf, axis=-1, keepdims=True) + EPS)).astype(x.dtype)


def rms_norm(x, g):
    return rms(x) * g


def t5_bucket(n):
    max_exact = N_BUCKETS // 2
    nf = jnp.maximum(n, 1).astype(jnp.float32)
    large = max_exact + (jnp.log(nf / max_exact) / math.log(MAX_DISTANCE / max_exact)
                         * (N_BUCKETS - max_exact)).astype(jnp.int32)
    large = jnp.minimum(large, N_BUCKETS - 1)
    return jnp.where(n < max_exact, n, large)


def gather_bias(bias_d, d):
    b = bias_d[:, jnp.clip(d, 0, WINDOW - 1)]
    return b.reshape((N_KV_HEADS, GQA_GROUP) + d.shape)


def sink_softmax(logits, sink):
    s = jnp.broadcast_to(sink[:, :, None, None], logits.shape[:-1] + (1,))
    m = jnp.maximum(logits.max(axis=-1, keepdims=True), s)
    e = jnp.exp(logits - m)
    return e / (e.sum(axis=-1, keepdims=True) + jnp.exp(s - m))


def project(hn, w_in):
    z = hn @ w_in
    lead = z.shape[:-1]
    q, k, v, gb, gc, u = jnp.split(z, SPLITS, axis=-1)
    q = q.reshape(lead + (N_KV_HEADS, GQA_GROUP, HEAD_DIM))
    k = k.reshape(lead + (N_KV_HEADS, HEAD_DIM))
    v = v.reshape(lead + (N_KV_HEADS, HEAD_DIM))
    return q, k, v, gb, gc * u


def short_conv(ext, conv_w, t):
    out = conv_w[0] * ext[:, 0:t]
    for i in range(1, CONV_WIDTH):
        out = out + conv_w[i] * ext[:, i:i + t]
    return out


def band_attention(q, k, v, sink, bias_d):
    b, s = k.shape[0], k.shape[1]
    nb = s // BLOCK
    qb = q.reshape(b, nb, BLOCK, N_KV_HEADS, GQA_GROUP, HEAD_DIM)
    kb = k.reshape(b, nb, BLOCK, N_KV_HEADS, HEAD_DIM)
    vb = v.reshape(b, nb, BLOCK, N_KV_HEADS, HEAD_DIM)

    def with_prev(t):
        prev = jnp.concatenate([jnp.zeros_like(t[:, :1]), t[:, :-1]], axis=1)
        return jnp.concatenate([prev, t], axis=2)

    kk, vv = with_prev(kb), with_prev(vb)
    logits = jnp.einsum('bnqkgd,bnskd->bnkgqs', qb, kk).astype(jnp.float32) * SCALE
    d = (jnp.arange(BLOCK) + BLOCK)[:, None] - jnp.arange(2 * BLOCK)[None, :]
    valid = (d >= 0) & (d < WINDOW)
    first = (jnp.arange(nb) == 0)[:, None, None] & (jnp.arange(2 * BLOCK) < BLOCK)[None, None, :]
    valid = valid[None] & ~first
    logits = jnp.where(valid[None, :, None, None], logits + gather_bias(bias_d, d), NEG)
    p = sink_softmax(logits, sink)
    o = jnp.einsum('bnkgqs,bnskd->bnqkgd', p.astype(vv.dtype), vv)
    return o.reshape(b, s, ATTN_WIDTH)


def window_cache_attention(q, k, v, ck, cv, sink, bias_d):
    w, t = ck.shape[1], k.shape[1]
    kk = jnp.concatenate([ck, k], axis=1)
    vv = jnp.concatenate([cv, v], axis=1)
    kpos = jnp.concatenate([jnp.arange(w) - w, jnp.arange(t)])
    d = jnp.arange(t)[:, None] - kpos[None, :]
    valid = (d >= 0) & (d < WINDOW)
    logits = jnp.einsum('btkgd,bskd->bkgts', q, kk).astype(jnp.float32) * SCALE
    logits = jnp.where(valid, logits + gather_bias(bias_d, d), NEG)
    p = sink_softmax(logits, sink)
    o = jnp.einsum('bkgts,bskd->btkgd', p.astype(vv.dtype), vv)
    return o.reshape(q.shape[0], t, ATTN_WIDTH), kk[:, -w:], vv[:, -w:]


def merge_and_ffn(x, attn_o, conv_o, mix_norm, w_out, ffn_norm, w_gate, w_up, w_down):
    m = jnp.concatenate([rms(attn_o), rms(conv_o)], axis=-1) * mix_norm
    x = x + m @ w_out
    h = rms_norm(x, ffn_norm)
    return x + (jax.nn.silu(h @ w_gate) * (h @ w_up)) @ w_down


def setup_inputs(seed: int = 0) -> dict:
    key = jax.random.key(seed)
    ks = jax.random.split(key, 20)
    f32 = jnp.float32
    w_buf = min(WINDOW, PAST_LEN)
    nrm = lambda k, shape: jax.random.normal(k, shape, f32)
    return {
        "x_prompt": nrm(ks[0], (BATCH, SEQ, D_MODEL)),
        "x_sample": nrm(ks[1], (DEC_BATCH, DEC_SEQ, D_MODEL)),
        "cache_k": nrm(ks[2], (DEPTH, DEC_BATCH, w_buf, N_KV_HEADS, HEAD_DIM)),
        "cache_v": nrm(ks[3], (DEPTH, DEC_BATCH, w_buf, N_KV_HEADS, HEAD_DIM)),
        "state_conv": nrm(ks[4], (DEPTH, DEC_BATCH, CONV_WIDTH - 1, CONV_DIM)),
        "rel_bias": 0.5 * nrm(ks[5], (N_BUCKETS, N_Q_HEADS)),
        "attn_norm": 1.0 + 0.05 * nrm(ks[6], (DEPTH, D_MODEL)),
        "w_in": nrm(ks[7], (DEPTH, D_MODEL, IN_WIDTH)) * D_MODEL ** -0.5,
        "sinks": 0.5 * nrm(ks[8], (DEPTH, N_Q_HEADS)),
        "conv_w": nrm(ks[9], (DEPTH, CONV_WIDTH, CONV_DIM)) * CONV_WIDTH ** -0.5,
        "mix_norm": 1.0 + 0.05 * nrm(ks[10], (DEPTH, MIX_WIDTH)),
        "w_out": nrm(ks[11], (DEPTH, MIX_WIDTH, D_MODEL)) * MIX_WIDTH ** -0.5,
        "ffn_norm": 1.0 + 0.05 * nrm(ks[12], (DEPTH, D_MODEL)),
        "w_gate": nrm(ks[13], (DEPTH, D_MODEL, D_FF)) * D_MODEL ** -0.5,
        "w_up": nrm(ks[14], (DEPTH, D_MODEL, D_FF)) * D_MODEL ** -0.5,
        "w_down": nrm(ks[15], (DEPTH, D_FF, D_MODEL)) * D_FF ** -0.5,
        "final_norm": 1.0 + 0.05 * nrm(ks[16], (D_MODEL,)),
    }


def reference(x_prompt, x_sample, cache_k, cache_v, state_conv, rel_bias, attn_norm, w_in, sinks,
              conv_w, mix_norm, w_out, ffn_norm, w_gate, w_up, w_down, final_norm):
    bias_d = rel_bias.astype(jnp.float32)[t5_bucket(jnp.arange(WINDOW))].T
    xp, xs = x_prompt, x_sample
    bp, sp = xp.shape[0], xp.shape[1]
    tp = xs.shape[1]
    w_p = min(WINDOW, sp)
    nkp, nvp, ncp, nks, nvs, ncs = [], [], [], [], [], []
    for l in range(DEPTH):
        sink = sinks[l].astype(jnp.float32).reshape(N_KV_HEADS, GQA_GROUP)
        ffn_args = (mix_norm[l], w_out[l], ffn_norm[l], w_gate[l], w_up[l], w_down[l])

        q, k, v, gb, cu = project(rms_norm(xp, attn_norm[l]), w_in[l])
        a = band_attention(q, k, v, sink, bias_d)
        ext = jnp.concatenate([jnp.zeros((bp, CONV_WIDTH - 1, CONV_DIM), cu.dtype), cu], axis=1)
        c = gb * short_conv(ext, conv_w[l], sp)
        xp = merge_and_ffn(xp, a, c, *ffn_args)
        nkp.append(k[:, -w_p:])
        nvp.append(v[:, -w_p:])
        ncp.append(ext[:, -(CONV_WIDTH - 1):])

        q, k, v, gb, cu = project(rms_norm(xs, attn_norm[l]), w_in[l])
        a, k_buf, v_buf = window_cache_attention(q, k, v, cache_k[l], cache_v[l], sink, bias_d)
        ext = jnp.concatenate([state_conv[l].astype(cu.dtype), cu], axis=1)
        c = gb * short_conv(ext, conv_w[l], tp)
        xs = merge_and_ffn(xs, a, c, *ffn_args)
        nks.append(k_buf)
        nvs.append(v_buf)
        ncs.append(ext[:, -(CONV_WIDTH - 1):])

    y_prompt = rms_norm(xp, final_norm)
    y_sample = rms_norm(xs, final_norm)
    return (y_prompt, y_sample, jnp.stack(nkp), jnp.stack(nvp), jnp.stack(ncp),
            jnp.stack(nks), jnp.stack(nvs), jnp.stack(ncs))
```

```cpp
#include <hip/hip_runtime.h>
#include <cstdint>
#include <cstdio>

namespace sv {
constexpr int D = 1024, SEQ = 8192, NB = 2, DB = 128, DT = 4, MP = NB * SEQ, MS = DB * DT, M = MP + MS;
constexpr int NIN = 2304, DFF = 2816, WIN = 128;
constexpr int ZQ = 0, ZK = 512, ZV = 640, ZGB = 768, ZGC = 1280, ZU = 1792;
constexpr float EPS = 1e-6f, SCALE = 0.125f;

__device__ const unsigned char BUCKET[128] = {0, 1, 2, 3, 4, 5, 6, 7, 8, 9, 10, 11, 12, 13, 14, 15, 16, 16, 16, 17, 17, 18, 18, 18, 19, 19, 19, 20, 20, 20, 20, 21, 21, 21, 21, 22, 22, 22, 22, 22, 23, 23, 23, 23, 23, 23, 24, 24, 24, 24, 24, 24, 25, 25, 25, 25, 25, 25, 25, 26, 26, 26, 26, 26, 26, 26, 26, 27, 27, 27, 27, 27, 27, 27, 27, 27, 27, 28, 28, 28, 28, 28, 28, 28, 28, 28, 28, 29, 29, 29, 29, 29, 29, 29, 29, 29, 29, 29, 29, 30, 30, 30, 30, 30, 30, 30, 30, 30, 30, 30, 30, 30, 30, 31, 31, 31, 31, 31, 31, 31, 31, 31, 31, 31, 31, 31, 31, 31};

__device__ __forceinline__ float wave_sum(float v) {
#pragma unroll
    for (int o = 1; o < 64; o <<= 1) v += __shfl_xor(v, o);
    return v;
}
__device__ __forceinline__ float wave_max(float v) {
#pragma unroll
    for (int o = 1; o < 64; o <<= 1) v = fmaxf(v, __shfl_xor(v, o));
    return v;
}

__global__ void k_rmsnorm(const float* x, const float* g, float* out, int rows) {
    const int wave = (blockIdx.x * blockDim.x + threadIdx.x) >> 6, lane = threadIdx.x & 63;
    if (wave >= rows) return;
    const float* xr = x + (size_t)wave * D;
    float v[16]; float s = 0.f;
#pragma unroll
    for (int j = 0; j < 16; ++j) { v[j] = xr[lane + 64 * j]; s += v[j] * v[j]; }
    const float r = rsqrtf(wave_sum(s) * (1.f / D) + EPS);
#pragma unroll
    for (int j = 0; j < 16; ++j) out[(size_t)wave * D + lane + 64 * j] = v[j] * r * g[lane + 64 * j];
}

template <int MODE>
__global__ void __launch_bounds__(256) k_gemm(const float* A, const float* B, float* C, int Mm, int N, int K, int lda, int ldb, int ldc) {
    __shared__ float As[16][65], Bs[16][65];
    const int tx = threadIdx.x & 15, ty = threadIdx.x >> 4, m0 = blockIdx.y * 64, n0 = blockIdx.x * 64;
    float acc[4][4] = {};
    for (int k0 = 0; k0 < K; k0 += 16) {
        for (int i = threadIdx.x; i < 64 * 16; i += 256) { const int r = i >> 4, c = i & 15; As[c][r] = A[(size_t)(m0 + r) * lda + k0 + c]; }
        for (int i = threadIdx.x; i < 16 * 64; i += 256) { const int r = i >> 6, c = i & 63; Bs[r][c] = B[(size_t)(k0 + r) * ldb + n0 + c]; }
        __syncthreads();
#pragma unroll
        for (int k = 0; k < 16; ++k) {
            float a[4], b[4];
#pragma unroll
            for (int i = 0; i < 4; ++i) { a[i] = As[k][ty * 4 + i]; b[i] = Bs[k][tx * 4 + i]; }
#pragma unroll
            for (int i = 0; i < 4; ++i)
#pragma unroll
                for (int j = 0; j < 4; ++j) acc[i][j] += a[i] * b[j];
        }
        __syncthreads();
    }
#pragma unroll
    for (int i = 0; i < 4; ++i)
#pragma unroll
        for (int j = 0; j < 4; ++j) { float* p = C + (size_t)(m0 + ty * 4 + i) * ldc + n0 + tx * 4 + j; if (MODE == 1) *p += acc[i][j]; else *p = acc[i][j]; }
}

__global__ void k_attn(const float* z, const float* ck, const float* cv, const float* sinks, const float* rel_bias, float* a, int lda) {
    const int wave = (blockIdx.x * blockDim.x + threadIdx.x) >> 6, lane = threadIdx.x & 63;
    if (wave >= M * 8) return;
    const int row = wave >> 3, h = wave & 7, kv = h >> 2;
    const float* q = z + (size_t)row * NIN + ZQ + h * 64;
    const float sink = sinks[h];
    const bool samp = row >= MP;
    const int b = samp ? (row - MP) / DT : row / SEQ, t = samp ? (row - MP) % DT : row % SEQ;
    auto krow = [&](int d, bool isv, bool& valid) -> const float* {
        const int kp = t - d;
        if (!samp) { valid = kp >= 0; const size_t kr = (size_t)b * SEQ + (kp >= 0 ? kp : 0); return z + kr * NIN + (isv ? ZV : ZK) + kv * 64; }
        valid = true;
        if (kp >= 0) { const size_t kr = (size_t)MP + b * DT + kp; return z + kr * NIN + (isv ? ZV : ZK) + kv * 64; }
        const int w = 128 + kp; return (isv ? cv : ck) + (((size_t)b * WIN + w) * 2 + kv) * 64;
    };
    float logit[2]; bool valid[2];
#pragma unroll
    for (int i = 0; i < 2; ++i) {
        const int d = lane + 64 * i;
        const float* kp = krow(d, false, valid[i]);
        float s = 0.f;
        for (int e = 0; e < 64; ++e) s += q[e] * kp[e];
        logit[i] = valid[i] ? s * SCALE + rel_bias[BUCKET[d] * 8 + h] : -1e30f;
    }
    const float m = fmaxf(wave_max(fmaxf(logit[0], logit[1])), sink);
    const float e0 = valid[0] ? __expf(logit[0] - m) : 0.f, e1 = valid[1] ? __expf(logit[1] - m) : 0.f;
    const float den = wave_sum(e0 + e1) + __expf(sink - m);
    const float p0 = e0 / den, p1 = e1 / den;
    float o = 0.f;
    for (int j = 0; j < 64; ++j) {
        const float pj0 = __shfl(p0, j), pj1 = __shfl(p1, j);
        bool v0, v1; const float* va = krow(j, true, v0); const float* vb = krow(j + 64, true, v1);
        o += pj0 * va[lane] + pj1 * vb[lane];
    }
    a[(size_t)row * lda + h * 64 + lane] = o;
}

__global__ void k_conv(const float* z, const float* conv_w, const float* state, float* c, int ldc) {
    const size_t idx = (size_t)blockIdx.x * blockDim.x + threadIdx.x;
    if (idx >= (size_t)M * 512) return;
    const int row = (int)(idx >> 9), ch = (int)(idx & 511);
    const bool samp = row >= MP;
    const int b = samp ? (row - MP) / DT : row / SEQ, t = samp ? (row - MP) % DT : row % SEQ;
    auto cu = [&](int tt) -> float {
        if (tt >= 0) { const size_t r = (size_t)row - (t - tt); return z[r * NIN + ZGC + ch] * z[r * NIN + ZU + ch]; }
        if (!samp) return 0.f;
        return state[((size_t)b * 2 + (2 + tt)) * 512 + ch];
    };
    const float v = conv_w[0 * 512 + ch] * cu(t - 2) + conv_w[1 * 512 + ch] * cu(t - 1) + conv_w[2 * 512 + ch] * cu(t);
    c[(size_t)row * ldc + ch] = z[(size_t)row * NIN + ZGB + ch] * v;
}

__global__ void k_merge(float* mm, const float* mixn) {
    const int wave = (blockIdx.x * blockDim.x + threadIdx.x) >> 6, lane = threadIdx.x & 63;
    if (wave >= M) return;
    float va[8], vc[8], sa = 0.f, sc = 0.f;
#pragma unroll
    for (int j = 0; j < 8; ++j) { va[j] = mm[(size_t)wave * D + lane + 64 * j]; vc[j] = mm[(size_t)wave * D + 512 + lane + 64 * j]; sa += va[j] * va[j]; sc += vc[j] * vc[j]; }
    const float ra = rsqrtf(wave_sum(sa) * (1.f / 512) + EPS), rc = rsqrtf(wave_sum(sc) * (1.f / 512) + EPS);
#pragma unroll
    for (int j = 0; j < 8; ++j) { mm[(size_t)wave * D + lane + 64 * j] = va[j] * ra * mixn[lane + 64 * j]; mm[(size_t)wave * D + 512 + lane + 64 * j] = vc[j] * rc * mixn[512 + lane + 64 * j]; }
}

__global__ void k_swiglu(const float* g, const float* u, float* h, size_t n) {
    const size_t i = (size_t)blockIdx.x * blockDim.x + threadIdx.x;
    if (i < n) { const float x = g[i]; h[i] = x / (1.f + __expf(-x)) * u[i]; }
}

__global__ void k_state_out(const float* z, const float* ck, const float* cv, int layer, float* out) {
    float* nkp = out + (size_t)MP * D + (size_t)MS * D;
    float* nvp = nkp + 2 * NB * WIN * 128;
    float* ncp = nvp + 2 * NB * WIN * 128;
    float* nks = ncp + 2 * NB * 2 * 512;
    float* nvs = nks + (size_t)2 * DB * WIN * 128;
    float* ncs = nvs + (size_t)2 * DB * WIN * 128;
    const size_t i = (size_t)blockIdx.x * blockDim.x + threadIdx.x;
    if (i < (size_t)NB * WIN * 128) { const int b = i / (WIN * 128), w = (i / 128) % WIN, c = i % 128; const size_t r = (size_t)b * SEQ + SEQ - WIN + w;
        nkp[(size_t)layer * NB * WIN * 128 + i] = z[r * NIN + ZK + c]; nvp[(size_t)layer * NB * WIN * 128 + i] = z[r * NIN + ZV + c]; }
    if (i < (size_t)NB * 2 * 512) { const int b = i / 1024, j = (i / 512) % 2, ch = i % 512; const size_t r = (size_t)b * SEQ + SEQ - 2 + j;
        ncp[(size_t)layer * NB * 1024 + i] = z[r * NIN + ZGC + ch] * z[r * NIN + ZU + ch]; }
    if (i < (size_t)DB * WIN * 128) { const int b = i / (WIN * 128), w = (i / 128) % WIN, c = i % 128;
        float kk, vv;
        if (w < WIN - DT) { kk = ck[((size_t)b * WIN + w + DT) * 128 + c]; vv = cv[((size_t)b * WIN + w + DT) * 128 + c]; }
        else { const size_t r = (size_t)MP + b * DT + (w - (WIN - DT)); kk = z[r * NIN + ZK + c]; vv = z[r * NIN + ZV + c]; }
        nks[(size_t)layer * DB * WIN * 128 + i] = kk; nvs[(size_t)layer * DB * WIN * 128 + i] = vv; }
    if (i < (size_t)DB * 2 * 512) { const int b = i / 1024, j = (i / 512) % 2, ch = i % 512; const size_t r = (size_t)MP + b * DT + 2 + j;
        ncs[(size_t)layer * DB * 1024 + i] = z[r * NIN + ZGC + ch] * z[r * NIN + ZU + ch]; }
}
}

extern "C" void kernel_launch(void* const* d_in, const int* in_sizes, int n_in, void* d_out, int out_size, void* d_ws, size_t ws_size, hipStream_t stream) {
    using namespace sv;
    const float* x_prompt = (const float*)d_in[0]; const float* x_sample = (const float*)d_in[1];
    const float* cache_k = (const float*)d_in[2]; const float* cache_v = (const float*)d_in[3]; const float* state_conv = (const float*)d_in[4];
    const float* rel_bias = (const float*)d_in[5]; const float* attn_norm = (const float*)d_in[6]; const float* w_in = (const float*)d_in[7];
    const float* sinks = (const float*)d_in[8]; const float* conv_w = (const float*)d_in[9]; const float* mix_norm = (const float*)d_in[10];
    const float* w_out = (const float*)d_in[11]; const float* ffn_norm = (const float*)d_in[12]; const float* w_gate = (const float*)d_in[13];
    const float* w_up = (const float*)d_in[14]; const float* w_down = (const float*)d_in[15]; const float* final_norm = (const float*)d_in[16];
    float* out = (float*)d_out;
    float* ws = (float*)d_ws;
    constexpr int CH = M / 8;
    float* X = out;
    float* Z = ws;
    float* MMb = Z + (size_t)M * NIN;
    float* Hc = MMb + (size_t)M * D;
    float* G = Z;
    float* U = G + (size_t)CH * DFF;
    hipMemcpyAsync(X, x_prompt, (size_t)MP * D * 4, hipMemcpyDeviceToDevice, stream);
    hipMemcpyAsync(X + (size_t)MP * D, x_sample, (size_t)MS * D * 4, hipMemcpyDeviceToDevice, stream);
    for (int l = 0; l < 2; ++l) {
        for (int c = 0; c < 8; ++c) {
            k_rmsnorm<<<CH / 4, 256, 0, stream>>>(X + (size_t)c * CH * D, attn_norm + l * D, Hc, CH);
            k_gemm<0><<<dim3(NIN / 64, CH / 64), 256, 0, stream>>>(Hc, w_in + (size_t)l * D * NIN, Z + (size_t)c * CH * NIN, CH, NIN, D, D, NIN, NIN);
        }
        const float* ck = cache_k + (size_t)l * DB * WIN * 128; const float* cv = cache_v + (size_t)l * DB * WIN * 128;
        k_attn<<<M * 8 / 4, 256, 0, stream>>>(Z, ck, cv, sinks + l * 8, rel_bias, MMb, D);
        k_conv<<<(M * 512) / 256, 256, 0, stream>>>(Z, conv_w + l * 3 * 512, state_conv + (size_t)l * DB * 2 * 512, MMb + 512, D);
        k_state_out<<<(DB * WIN * 128) / 256, 256, 0, stream>>>(Z, ck, cv, l, out);
        k_merge<<<M / 4, 256, 0, stream>>>(MMb, mix_norm + l * D);
        k_gemm<1><<<dim3(D / 64, M / 64), 256, 0, stream>>>(MMb, w_out + (size_t)l * D * D, X, M, D, D, D, D, D);
        for (int c = 0; c < 8; ++c) {
            float* Xc = X + (size_t)c * CH * D;
            k_rmsnorm<<<CH / 4, 256, 0, stream>>>(Xc, ffn_norm + l * D, Hc, CH);
            k_gemm<0><<<dim3(DFF / 64, CH / 64), 256, 0, stream>>>(Hc, w_gate + (size_t)l * D * DFF, G, CH, DFF, D, D, DFF, DFF);
            k_gemm<0><<<dim3(DFF / 64, CH / 64), 256, 0, stream>>>(Hc, w_up + (size_t)l * D * DFF, U, CH, DFF, D, D, DFF, DFF);
            k_swiglu<<<(unsigned)(((size_t)CH * DFF + 255) / 256), 256, 0, stream>>>(G, U, G, (size_t)CH * DFF);
            k_gemm<1><<<dim3(D / 64, CH / 64), 256, 0, stream>>>(G, w_down + (size_t)l * DFF * D, Xc, CH, D, DFF, DFF, D, D);
        }
    }
    k_rmsnorm<<<M / 4, 256, 0, stream>>>(X, final_norm, out, M);
}
```

```cpp
#include <hip/hip_runtime.h>
#include <cstdio>
#include <cstdint>
namespace pg8 {
#define PG8_LAS __attribute__((address_space(3)))
typedef unsigned short bf16_t;
typedef short bf16x8 __attribute__((ext_vector_type(8)));
typedef float f32x4 __attribute__((ext_vector_type(4)));
typedef unsigned u32x4 __attribute__((ext_vector_type(4)));
constexpr int BM = 256, BK = 64, HALF = 128, HTB = HALF * BK * 2  , STAGE_BYTES = 8 * HTB, NXCD = 8, WGM = 8;

__host__ __device__ __forceinline__ int lds_byte(int r, int c) { const int st = (r >> 4) * 2 + (c >> 5), rr = r & 15, cc = c & 31, ob = rr * 64 + cc * 2; return st * 1024 + (ob ^ (((ob >> 9) & 1) << 5)); }
__host__ __device__ __forceinline__ void stage_rc(int b, int& R, int& C) { const int st = b / 1024, sb = b % 1024, swz = sb ^ (((sb >> 9) & 1) << 5); R = (st >> 1) * 16 + swz / 64; C = (st & 1) * 32 + (swz % 64) / 2; }
__host__ __device__ __forceinline__ int perm32(int rho) { const int n = rho >> 4, i = rho & 15; return 8 * (i >> 2) + 4 * n + (i & 3); }

struct Unit { int pm, pn; };
struct Gemm { const bf16_t* A; const bf16_t* Bt; int M, N, K; };

struct StaticOrder {
    int nM, nN, nwg, G, c; bool rev;
    __host__ __device__ void init(int M, int N, int G_, int c_, bool rev_ = false) { nM = M / BM; nN = N / BM; nwg = nM * nN; G = G_; c = c_; rev = rev_; }
    __host__ __device__ bool next(int i, Unit& u) const {
        const long L = (long)i * G + c; if (L >= nwg) return false;
        int wgid = rev ? nwg - 1 - (int)L : (int)L;
        const int nig = WGM * nN, gid = wgid / nig, fm = gid * WGM, gsz = (nM - fm) < WGM ? (nM - fm) : WGM;
        u.pm = fm + ((wgid % nig) % gsz); u.pn = (wgid % nig) / gsz; return true;
    }
    __device__ __forceinline__ void a_ready(const Unit&) const {}
    __device__ __forceinline__ void done(const Unit&) const {}
};

typedef float f32x2_t __attribute__((ext_vector_type(2))); typedef __bf16 bf16x2_t __attribute__((ext_vector_type(2)));
__device__ __forceinline__ unsigned cvt_pk_bf16(float lo, float hi) { const f32x2_t v = {lo, hi}; const bf16x2_t b = __builtin_convertvector(v, bf16x2_t); return __builtin_bit_cast(unsigned, b); }
template <int OFF> __device__ __forceinline__ void store16_wt(void* p, u32x4 v) { asm volatile("global_store_dwordx4 %0, %1, off offset:%2 sc1\n\ts_nop 1" :: "v"(p), "v"(v), "i"(OFF) : "memory"); }
constexpr int SSQ_SLOTS = 16;
constexpr float RMS_EPS = 1e-6f;
struct RstdState { float rs[2]; };
__device__ __forceinline__ void rstd_issue(const float* ssq, int nslots, int mrows, int pm, int wr, int lane, float (&v)[2][16]) {
    if (nslots == 16) {
#pragma unroll
        for (int ai = 0; ai < 2; ++ai) { const float* p = ssq + (size_t)(pm * BM + ai * HALF + wr * 64 + lane);
#pragma unroll
            for (int k = 0; k < 16; ++k) v[ai][k] = p[(size_t)k * mrows]; }
    } else {
#pragma unroll
        for (int ai = 0; ai < 2; ++ai) { v[ai][0] = ssq[(size_t)(pm * BM + ai * HALF + wr * 64 + lane)];
#pragma unroll
            for (int k = 1; k < 16; ++k) v[ai][k] = 0.f; }
    }
}
__device__ __forceinline__ void rstd_finish(const float (&v)[2][16], float (&rs)[2]) {
#pragma unroll
    for (int ai = 0; ai < 2; ++ai) { float s = 0.f;
#pragma unroll
        for (int k = 0; k < 16; ++k) s += v[ai][k];
        rs[ai] = rsqrtf(s * (1.0f / 1024.0f) + RMS_EPS); }
}
struct EpiScaleBf16 {
    static constexpr bool PERM = true, AFTER_DRAIN = false;
    typedef RstdState State;
    bf16_t* O; int ldc; const float* ssq; int nslots, mrows;
    __device__ __forceinline__ void init(State& st, const Unit& u, int wr, int lane) const { float v[2][16]; rstd_issue(ssq, nslots, mrows, u.pm, wr, lane, v); rstd_finish(v, st.rs); asm volatile("" : "+v"(st.rs[0]), "+v"(st.rs[1])); }
    __device__ __forceinline__ void acc_init(f32x4 (&)[2][2][4][2], const Unit&, int, int, int, int) const {}
    __device__ __forceinline__ void operator()(const f32x4 (&acc)[2][2][4][2], const Unit& u, int wr, int wc, int fr, int fq, State& st, bool has_next, const Unit& nxt) const {
        float v[2][16]; rstd_issue(ssq, nslots, mrows, has_next ? nxt.pm : u.pm, wr, fq * 16 + fr, v);
        const int row0 = u.pm * BM + wr * 64 + fr;
        if (u.pn < 5) {
            const int col0 = u.pn * BM + wc * 32 + 8 * fq;
#pragma unroll
            for (int ai = 0; ai < 2; ++ai)
#pragma unroll
                for (int m = 0; m < 4; ++m) { const float sc = __shfl(st.rs[ai], 16 * m + fr); bf16_t* rowp = O + (size_t)(row0 + ai * HALF + m * 16) * ldc + col0;
#pragma unroll
                    for (int bj = 0; bj < 2; ++bj) { const f32x4 v0 = acc[ai][bj][m][0] * sc, v1 = acc[ai][bj][m][1] * sc;
                        u32x4 w; w.x = cvt_pk_bf16(v0[0], v0[1]); w.y = cvt_pk_bf16(v0[2], v0[3]); w.z = cvt_pk_bf16(v1[0], v1[1]); w.w = cvt_pk_bf16(v1[2], v1[3]);
                        if (bj == 0) store16_wt<0>(rowp, w); else store16_wt<HALF * 2>(rowp, w); } }
        } else {
            const int col0 = 1280 + (u.pn - 5) * HALF + wc * 32 + 8 * fq;
#pragma unroll
            for (int ai = 0; ai < 2; ++ai)
#pragma unroll
                for (int m = 0; m < 4; ++m) { const float sc = __shfl(st.rs[ai], 16 * m + fr), s2 = sc * sc; bf16_t* rowp = O + (size_t)(row0 + ai * HALF + m * 16) * ldc + col0;
                    const f32x4 v0 = acc[ai][0][m][0] * acc[ai][1][m][0] * s2, v1 = acc[ai][0][m][1] * acc[ai][1][m][1] * s2;
                    u32x4 w; w.x = cvt_pk_bf16(v0[0], v0[1]); w.y = cvt_pk_bf16(v0[2], v0[3]); w.z = cvt_pk_bf16(v1[0], v1[1]); w.w = cvt_pk_bf16(v1[2], v1[3]);
                    store16_wt<0>(rowp, w); }
        }
        { rstd_finish(v, st.rs); asm volatile("" : "+v"(st.rs[0]), "+v"(st.rs[1])); }
    }
};
struct EpiSwiGLU {
    static constexpr bool PERM = true, AFTER_DRAIN = false;
    typedef RstdState State;
    bf16_t* O; int ldc; const float* ssq; int nslots, mrows;
    __device__ __forceinline__ void init(State& st, const Unit& u, int wr, int lane) const { float v[2][16]; rstd_issue(ssq, nslots, mrows, u.pm, wr, lane, v); rstd_finish(v, st.rs); asm volatile("" : "+v"(st.rs[0]), "+v"(st.rs[1])); }
    __device__ __forceinline__ void acc_init(f32x4 (&)[2][2][4][2], const Unit&, int, int, int, int) const {}
    __device__ __forceinline__ void operator()(const f32x4 (&acc)[2][2][4][2], const Unit& u, int wr, int wc, int fr, int fq, State& st, bool has_next, const Unit& nxt) const {
        float v[2][16]; rstd_issue(ssq, nslots, mrows, has_next ? nxt.pm : u.pm, wr, fq * 16 + fr, v);
        const int row0 = u.pm * BM + wr * 64 + fr, col0 = u.pn * HALF + wc * 32 + 8 * fq;
#pragma unroll
        for (int ai = 0; ai < 2; ++ai)
#pragma unroll
            for (int m = 0; m < 4; ++m) { const float sc = __shfl(st.rs[ai], 16 * m + fr); bf16_t* rowp = O + (size_t)(row0 + ai * HALF + m * 16) * ldc + col0;
                const float k1 = -sc * 1.4426950408889634f, s2 = sc * sc;
                f32x4 hv[2];
#pragma unroll
                for (int n = 0; n < 2; ++n) { const f32x4 ag = acc[ai][0][m][n], au = acc[ai][1][m][n], t = ag * k1; f32x4 r;
#pragma unroll
                    for (int i = 0; i < 4; ++i) r[i] = __builtin_amdgcn_rcpf(1.0f + __builtin_amdgcn_exp2f(t[i]));
                    hv[n] = (ag * au) * (r * s2); }
                u32x4 w; w.x = cvt_pk_bf16(hv[0][0], hv[0][1]); w.y = cvt_pk_bf16(hv[0][2], hv[0][3]); w.z = cvt_pk_bf16(hv[1][0], hv[1][1]); w.w = cvt_pk_bf16(hv[1][2], hv[1][3]);
                store16_wt<0>(rowp, w); }
        { rstd_finish(v, st.rs); asm volatile("" : "+v"(st.rs[0]), "+v"(st.rs[1])); }
    }
};
__device__ __forceinline__ float bf_lo(unsigned w) { return __uint_as_float(w << 16); }
__device__ __forceinline__ float bf_hi(unsigned w) { return __uint_as_float(w & 0xffff0000u); }
template <bool LAST> struct EpiResid {
    static constexpr bool PERM = true, AFTER_DRAIN = false;
    struct State {};
    bf16_t* xb; float* out; float* ssq_out; int mrows;
    __device__ __forceinline__ void init(State&, const Unit&, int, int) const {}
    __device__ __forceinline__ void acc_init(f32x4 (&acc)[2][2][4][2], const Unit& u, int wr, int wc, int fr, int fq) const {
        const int lrow0 = wr * 64 + fr, col0 = u.pn * BM + wc * 32 + 8 * fq;
        u32x4 b[2][4][2];
#pragma unroll
        for (int ai = 0; ai < 2; ++ai)
#pragma unroll
            for (int m = 0; m < 4; ++m)
#pragma unroll
                for (int bj = 0; bj < 2; ++bj) b[ai][m][bj] = *(const u32x4*)(xb + ((size_t)u.pm * BM + lrow0 + ai * HALF + m * 16) * 1024 + col0 + bj * HALF);
#pragma unroll
        for (int ai = 0; ai < 2; ++ai)
#pragma unroll
            for (int m = 0; m < 4; ++m)
#pragma unroll
                for (int bj = 0; bj < 2; ++bj) { const u32x4 w = b[ai][m][bj];
                    acc[ai][bj][m][0] = (f32x4){bf_lo(w.x), bf_hi(w.x), bf_lo(w.y), bf_hi(w.y)}; acc[ai][bj][m][1] = (f32x4){bf_lo(w.z), bf_hi(w.z), bf_lo(w.w), bf_hi(w.w)}; }
    }
    __device__ __forceinline__ void operator()(const f32x4 (&acc)[2][2][4][2], const Unit& u, int wr, int wc, int fr, int fq, State&, bool, const Unit&) const {
        const int lrow0 = wr * 64 + fr, col0 = u.pn * BM + wc * 32 + 8 * fq;
#pragma unroll
        for (int ai = 0; ai < 2; ++ai)
#pragma unroll
            for (int m = 0; m < 4; ++m) { const size_t grow = (size_t)u.pm * BM + lrow0 + ai * HALF + m * 16; float q = 0.f;
#pragma unroll
                for (int bj = 0; bj < 2; ++bj) { const f32x4 v0 = acc[ai][bj][m][0], v1 = acc[ai][bj][m][1];
                    if (LAST) { float* op = out + grow * 1024 + col0 + bj * HALF; *(f32x4*)op = v0; *(f32x4*)(op + 4) = v1; }
                    else { u32x4 w; w.x = cvt_pk_bf16(v0[0], v0[1]); w.y = cvt_pk_bf16(v0[2], v0[3]); w.z = cvt_pk_bf16(v1[0], v1[1]); w.w = cvt_pk_bf16(v1[2], v1[3]); if (bj == 0) store16_wt<0>(xb + grow * 1024 + col0, w); else store16_wt<HALF * 2>(xb + grow * 1024 + col0, w); }
                    q += ((v0[0] * v0[0] + v0[1] * v0[1]) + (v0[2] * v0[2] + v0[3] * v0[3])) + ((v1[0] * v1[0] + v1[1] * v1[1]) + (v1[2] * v1[2] + v1[3] * v1[3])); }
                q += __shfl_xor(q, 16); q += __shfl_xor(q, 32);
                if (fq == 0) ssq_out[(size_t)(u.pn * 4 + wc) * mrows + grow] = q; }
    }
};
template <class Epi, class Sched, bool ALIGN_EPI = false, bool SP2 = false>
__device__ __forceinline__ void gemm_phase(PG8_LAS unsigned char* lds, const Gemm g, const Sched& S, const Epi& E) {
    int tid_ = threadIdx.x; asm volatile("" : "+v"(tid_));
    const int tid = tid_, wid = __builtin_amdgcn_readfirstlane(tid >> 6), lane = tid & 63, wr = wid >> 2, wc = wid & 3, fr = lane & 15, fq = lane >> 4;
    const int K = g.K, nt = K / BK;
    unsigned voffA[2], voffB[2];
#pragma unroll
    for (int i = 0; i < 2; ++i) { int R, C; stage_rc(tid * 16 + i * 8192, R, C); const int Rb = Epi::PERM ? ((R & ~31) + perm32(R & 31)) : R;
        voffA[i] = (unsigned)(R * K + C) * 2u; voffB[i] = (unsigned)(Rb * K + C) * 2u; }
    const size_t kstep = (size_t)(BK * 2);
    const size_t hstep = (size_t)HALF * K * 2;
    const size_t tstep = 2 * hstep;
    const unsigned ldsw = (unsigned)wid * 1024u;
    const int aoff = lds_byte(wr * 64 + fr, fq * 8), boff = lds_byte(wc * 32 + fr, fq * 8);
#define PG8_SA(b, h) (((b) * 2 + (h)) * HTB)
#define PG8_SB(b, h) ((4 + (b) * 2 + (h)) * HTB)
#define PG8_STAGE(bufoff, gbase, voff) do { _Pragma("unroll") for (int _i = 0; _i < 2; ++_i) \
        __builtin_amdgcn_global_load_lds((const unsigned*)((const char*)(gbase) + (voff)[_i]), (PG8_LAS unsigned*)(lds + (bufoff) + ldsw + _i * 8192), 16, 0, 0); } while (0)
#define PG8_LDA(dst, b, h) do { _Pragma("unroll") for (int m = 0; m < 4; ++m) _Pragma("unroll") for (int k = 0; k < 2; ++k) dst[m][k] = *(const PG8_LAS bf16x8*)(lds + PG8_SA(b, h) + aoff + m * 2048 + k * 1024); } while (0)
#define PG8_LDB(dst, b, h) do { _Pragma("unroll") for (int n = 0; n < 2; ++n) _Pragma("unroll") for (int k = 0; k < 2; ++k) dst[n][k] = *(const PG8_LAS bf16x8*)(lds + PG8_SB(b, h) + boff + n * 2048 + k * 1024); } while (0)
#define PG8_MMA(ai, bj, At, Bt) do { __builtin_amdgcn_s_setprio(1); _Pragma("unroll") for (int m = 0; m < 4; ++m) _Pragma("unroll") for (int n = 0; n < 2; ++n) _Pragma("unroll") for (int k = 0; k < 2; ++k) \
        acc[ai][bj][m][n] = __builtin_amdgcn_mfma_f32_16x16x32_bf16(Bt[n][k], At[m][k], acc[ai][bj][m][n], 0, 0, 0); __builtin_amdgcn_s_setprio(0); } while (0)
#define PG8_WAIT_V(n) asm volatile("s_waitcnt vmcnt(" #n ")" ::: "memory")
#define PG8_WAIT_L(n) asm volatile("s_waitcnt lgkmcnt(" #n ")" ::: "memory")
#define PG8_BAR __builtin_amdgcn_s_barrier()
#define PG8_SCHED __builtin_amdgcn_sched_barrier(0)
    Unit cur, nxt; int ui = 0;
    if (!S.next(0, cur)) return;
    f32x4 acc[2][2][4][2];
#pragma unroll
    for (int a = 0; a < 2; ++a)
#pragma unroll
        for (int b = 0; b < 2; ++b)
#pragma unroll
            for (int m = 0; m < 4; ++m)
#pragma unroll
                for (int n = 0; n < 2; ++n) acc[a][b][m][n] = (f32x4){0.f, 0.f, 0.f, 0.f};
    bf16x8 At[4][2], B0[2][2], B1[2][2];
    const char* cA = (const char*)g.A + (size_t)cur.pm * tstep; const char* cB = (const char*)g.Bt + (size_t)cur.pn * tstep;
    S.a_ready(cur);
    typename Epi::State est;
    if constexpr (SP2) {
        PG8_STAGE(PG8_SB(0, 0), cB, voffB); PG8_STAGE(PG8_SB(0, 1), cB + hstep, voffB); PG8_STAGE(PG8_SA(0, 0), cA, voffA); PG8_STAGE(PG8_SA(0, 1), cA + hstep, voffA);
        E.init(est, cur, wr, lane); E.acc_init(acc, cur, wr, wc, fr, fq);
        if (wr == 1) PG8_BAR;
        PG8_WAIT_V(2); PG8_BAR;
        PG8_STAGE(PG8_SB(1, 0), cB + kstep, voffB); PG8_STAGE(PG8_SA(1, 0), cA + kstep, voffA); PG8_STAGE(PG8_SB(1, 1), cB + hstep + kstep, voffB);
        PG8_WAIT_V(6); PG8_BAR;
    } else {
        PG8_STAGE(PG8_SB(0, 0), cB, voffB); PG8_STAGE(PG8_SA(0, 0), cA, voffA); PG8_STAGE(PG8_SB(0, 1), cB + hstep, voffB); PG8_STAGE(PG8_SA(0, 1), cA + hstep, voffA);
        E.init(est, cur, wr, lane); E.acc_init(acc, cur, wr, wc, fr, fq);
        if (wr == 1) PG8_BAR;
        PG8_WAIT_V(4); PG8_BAR;
        PG8_STAGE(PG8_SB(1, 0), cB + kstep, voffB); PG8_STAGE(PG8_SA(1, 0), cA + kstep, voffA); PG8_STAGE(PG8_SB(1, 1), cB + hstep + kstep, voffB);
        PG8_WAIT_V(6); PG8_BAR;
    }
    for (;;) {
        const bool has_next = S.next(ui + 1, nxt);
        const char* nA = has_next ? (const char*)g.A + (size_t)nxt.pm * tstep : cA; const char* nB = has_next ? (const char*)g.Bt + (size_t)nxt.pn * tstep : cB;
        for (int t = 0; t < nt; t += 2) {
            const bool last = (t == nt - 2);
            const char* a1 = cA + (size_t)(t + 1) * kstep;
            const char* a2 = last ? nA : cA + (size_t)(t + 2) * kstep; const char* b2 = last ? nB : cB + (size_t)(t + 2) * kstep;
            const char* a3 = a2 + kstep; const char* b3 = b2 + kstep;
            if (last && has_next) S.a_ready(nxt);
            if constexpr (SP2) {
            PG8_LDB(B0, 0, 0); PG8_LDB(B1, 0, 1); PG8_SCHED; PG8_LDA(At, 0, 0); PG8_STAGE(PG8_SA(1, 1), a1 + hstep, voffA);
            PG8_WAIT_V(8); PG8_WAIT_L(0); PG8_BAR; PG8_MMA(0, 0, At, B0); PG8_MMA(0, 1, At, B1); PG8_BAR; PG8_SCHED;
            PG8_LDA(At, 0, 1); PG8_STAGE(PG8_SB(0, 0), b2, voffB); PG8_STAGE(PG8_SB(0, 1), b2 + hstep, voffB); PG8_STAGE(PG8_SA(0, 0), a2, voffA);
            PG8_WAIT_V(8); PG8_WAIT_L(0); PG8_BAR; PG8_MMA(1, 0, At, B0); PG8_MMA(1, 1, At, B1); PG8_BAR; PG8_SCHED;
            PG8_LDB(B0, 1, 0); PG8_LDB(B1, 1, 1); PG8_SCHED; PG8_LDA(At, 1, 0); PG8_STAGE(PG8_SA(0, 1), a2 + hstep, voffA);
            PG8_WAIT_V(8); PG8_WAIT_L(0); PG8_BAR; PG8_MMA(0, 0, At, B0); PG8_MMA(0, 1, At, B1); PG8_BAR; PG8_SCHED;
            PG8_LDA(At, 1, 1); PG8_STAGE(PG8_SB(1, 0), b3, voffB); PG8_STAGE(PG8_SB(1, 1), b3 + hstep, voffB); PG8_STAGE(PG8_SA(1, 0), a3, voffA);
            PG8_WAIT_V(8); PG8_WAIT_L(0); PG8_BAR; PG8_MMA(1, 0, At, B0); PG8_MMA(1, 1, At, B1); PG8_BAR; PG8_SCHED;
            } else {
            PG8_LDB(B0, 0, 0); PG8_SCHED; PG8_LDA(At, 0, 0); PG8_STAGE(PG8_SA(1, 1), a1 + hstep, voffA);
            PG8_WAIT_L(8); PG8_BAR; PG8_WAIT_L(0); PG8_MMA(0, 0, At, B0); PG8_BAR; PG8_SCHED;
            PG8_LDB(B1, 0, 1); PG8_STAGE(PG8_SB(0, 0), b2, voffB);
            PG8_BAR; PG8_WAIT_L(0); PG8_MMA(0, 1, At, B1); PG8_BAR;
            PG8_LDA(At, 0, 1); PG8_STAGE(PG8_SA(0, 0), a2, voffA);
            PG8_BAR; PG8_WAIT_L(0); PG8_MMA(1, 0, At, B0); PG8_BAR; PG8_SCHED;
            PG8_STAGE(PG8_SB(0, 1), b2 + hstep, voffB);
            PG8_WAIT_V(6); PG8_BAR; PG8_MMA(1, 1, At, B1); PG8_BAR;
            PG8_LDB(B0, 1, 0); PG8_SCHED; PG8_LDA(At, 1, 0); PG8_STAGE(PG8_SA(0, 1), a2 + hstep, voffA);
            PG8_WAIT_L(8); PG8_BAR; PG8_WAIT_L(0); PG8_MMA(0, 0, At, B0); PG8_BAR; PG8_SCHED;
            PG8_LDB(B1, 1, 1); PG8_STAGE(PG8_SB(1, 0), b3, voffB);
            PG8_BAR; PG8_WAIT_L(0); PG8_MMA(0, 1, At, B1); PG8_BAR;
            PG8_LDA(At, 1, 1); PG8_STAGE(PG8_SA(1, 0), a3, voffA);
            PG8_BAR; PG8_WAIT_L(0); PG8_MMA(1, 0, At, B0); PG8_BAR; PG8_SCHED;
            PG8_STAGE(PG8_SB(1, 1), b3 + hstep, voffB);
            PG8_WAIT_V(6); PG8_BAR; PG8_MMA(1, 1, At, B1); PG8_BAR;
            }
        }
        if constexpr (ALIGN_EPI) { if (wr == 0) PG8_BAR; }
        if constexpr (!Epi::AFTER_DRAIN) { E(acc, cur, wr, wc, fr, fq, est, has_next, nxt); S.done(cur); }
        if (!has_next) break;
#pragma unroll
        for (int a = 0; a < 2; ++a)
#pragma unroll
            for (int b = 0; b < 2; ++b)
#pragma unroll
                for (int m = 0; m < 4; ++m)
#pragma unroll
                    for (int n = 0; n < 2; ++n) acc[a][b][m][n] = (f32x4){0.f, 0.f, 0.f, 0.f};
        cur = nxt; cA = nA; cB = nB; ++ui;
        E.acc_init(acc, cur, wr, wc, fr, fq);
        if constexpr (ALIGN_EPI) { if (wr == 1) PG8_BAR; }
    }
    PG8_WAIT_V(0);
    if constexpr (!ALIGN_EPI) { if (wr == 0) PG8_BAR; }
    PG8_BAR;
    if constexpr (Epi::AFTER_DRAIN) { E.fused(acc, cur, wr, wc, fr, fq, lds, wid, lane); S.done(cur); }
#undef PG8_SA
#undef PG8_SB
#undef PG8_STAGE
#undef PG8_LDA
#undef PG8_LDB
#undef PG8_MMA
#undef PG8_WAIT_V
#undef PG8_WAIT_L
#undef PG8_BAR
#undef PG8_SCHED
}
}

#ifndef PROBE_TS
#define PROBE_TS 0
#endif
#ifndef PROBE_PH
#define PROBE_PH 0
#endif
constexpr int NWAVES = 8;
constexpr int DM = 1024, SEQ = 8192, NBATCH = 2, DBATCH = 128, DT = 4, MP = NBATCH * SEQ, MS = DBATCH * DT, M = MP + MS;
constexpr int NIN = 2304, DFF = 2816, NGU = 2 * DFF, WIN = 128, NLAYER = 2;
constexpr int ZP = 1792;
constexpr int ZQ = 0, ZK = 512, ZV = 640, ZGB = 768, ZCU = 1280;
constexpr float ATT_SCALE = 0.125f, EPS = 1e-6f;
constexpr size_t OUT_Y = 0, OUT_NKP = (size_t)M * DM, OUT_NVP = OUT_NKP + (size_t)NLAYER * NBATCH * WIN * 128, OUT_NCP = OUT_NVP + (size_t)NLAYER * NBATCH * WIN * 128,
                 OUT_NKS = OUT_NCP + (size_t)NLAYER * NBATCH * 2 * 512, OUT_NVS = OUT_NKS + (size_t)NLAYER * DBATCH * WIN * 128, OUT_NCS = OUT_NVS + (size_t)NLAYER * DBATCH * WIN * 128,
                 OUT_END = OUT_NCS + (size_t)NLAYER * DBATCH * 2 * 512;
static_assert(OUT_END == 26087424, "output size");
constexpr size_t MiB = 1u << 20;
constexpr size_t WS_CTL = 0, CTL_ZERO_BYTES = 32 * 1024;
constexpr size_t WS_WIN = 2 * MiB, WS_WOUT = 11 * MiB, WS_WGU = 15 * MiB, WS_WDN = 37 * MiB;
constexpr size_t WS_SSQA = 48 * MiB, WS_SSQD = 50 * MiB;
constexpr size_t WS_XB = 52 * MiB;
constexpr size_t WS_Z = 86 * MiB;
constexpr size_t WS_MB = 161 * MiB;
constexpr size_t WS_HB = 86 * MiB;
constexpr size_t WS_END = 194 * MiB;
static_assert(WS_WIN + (size_t)NLAYER * NIN * DM * 2 <= WS_WOUT && WS_WOUT + (size_t)NLAYER * DM * DM * 2 <= WS_WGU && WS_WGU + (size_t)NLAYER * NGU * DM * 2 <= WS_WDN && WS_WDN + (size_t)NLAYER * DM * DFF * 2 <= WS_SSQA, "ws weights");
static_assert(WS_SSQA + (size_t)M * 64 <= WS_SSQD && WS_SSQD + (size_t)M * 64 <= WS_XB && WS_XB + (size_t)M * DM * 2 <= WS_Z && WS_Z + (size_t)M * ZP * 2 <= WS_MB && WS_MB + (size_t)M * DM * 2 <= WS_END && WS_HB + (size_t)M * DFF * 2 <= WS_END, "ws activations");
constexpr int CW_TMO = 0, CW_CODE = 1, CW_BAR = 4096;
static_assert((CW_BAR + 3456) * 4 <= (int)CTL_ZERO_BYTES, "barrier words inside the zeroed region");
constexpr int RING_OFF = 0, RING_BYTES = 131072;
constexpr int LDS_BYTES = 163840;
constexpr int LDSCTL_BYTES = 512, LDSCTL_OFF = LDS_BYTES - LDSCTL_BYTES, MISC_OFF = LDSCTL_OFF + 320;
static_assert(MISC_OFF + 128 <= LDS_BYTES, "LDS map");
#define GAS __attribute__((address_space(1)))
#define LAS __attribute__((address_space(3)))
typedef unsigned short bf16;
typedef unsigned v4u __attribute__((ext_vector_type(4)));
typedef float f32x4 __attribute__((ext_vector_type(4)));
typedef short bf16x8 __attribute__((ext_vector_type(8)));
typedef GAS unsigned gu32;
typedef GAS unsigned long long gu64;
#define RLX_AGENT __ATOMIC_RELAXED, __HIP_MEMORY_SCOPE_AGENT
#define LDS_WAIT() asm volatile("s_waitcnt lgkmcnt(0)" ::: "memory")
#define VM_WAIT() asm volatile("s_waitcnt vmcnt(0)" ::: "memory")
__device__ __forceinline__ unsigned long long rt() { return __builtin_amdgcn_s_memrealtime(); }
__device__ __forceinline__ unsigned f2bf(float f) { unsigned u = __builtin_bit_cast(unsigned, f); return (u + 0x7fffu + ((u >> 16) & 1u)) >> 16; }
__device__ __forceinline__ unsigned pk2(float lo, float hi) { return f2bf(lo) | (f2bf(hi) << 16); }

#define XB_TMO      128
#define XB_XCNT(j)  (256  + 64 * (j))
#define XB_XSUB(j)  (1280 + 64 * (j))
#define XB_XGEN(j)  (2304 + 64 * (j))
#define XB_TOP      3328
#define XB_TOPGEN   3392
#define XCD_BAR_WORDS 3456
#define XB_SPIN_CAP (1u << 18)

__device__ __forceinline__ unsigned xb_ld(unsigned* p)              { return __hip_atomic_load(p, __ATOMIC_RELAXED, __HIP_MEMORY_SCOPE_AGENT); }
__device__ __forceinline__ unsigned xb_add(unsigned* p, unsigned v) { return __hip_atomic_fetch_add(p, v, __ATOMIC_RELAXED, __HIP_MEMORY_SCOPE_AGENT); }
__device__ __forceinline__ unsigned xb_xcc_id() { return (unsigned)__builtin_amdgcn_s_getreg((3 << 11) | 20) & 0xFu; }
#define XB_SPIN(cond, bar) do { unsigned _sp = 0; while (cond) { __builtin_amdgcn_s_sleep(1); \
    if ((++_sp & 255u) == 0u) { if (xb_ld(&(bar)[XB_TMO])) break; if (_sp > XB_SPIN_CAP) { atomicAdd(&(bar)[XB_TMO], 1u); break; } } } } while (0)

struct XcdBarrier {
    unsigned* bar; unsigned x;
    volatile LAS unsigned* st;
};

__device__ __forceinline__ XcdBarrier xcd_barrier_post(unsigned* bar, volatile LAS unsigned* st) {
    XcdBarrier b; b.bar = bar; b.x = xb_xcc_id(); b.st = st;
    if (threadIdx.x == 0) (void)xb_add(&bar[XB_XCNT(b.x)], 1u);
    return b;
}
__device__ __forceinline__ void xcd_barrier_complete(unsigned* bar, unsigned x, unsigned& nloc, unsigned& nx) {
    const unsigned G = gridDim.x * gridDim.y * gridDim.z;
    unsigned sum, cnt, mine, sp = 0u;
    for (;;) {
        sum = 0u; cnt = 0u; mine = 0u;
#pragma unroll
        for (unsigned j = 0; j < 16; ++j) { const unsigned c = xb_ld(&bar[XB_XCNT(j)]); sum += c; cnt += (c > 0u) ? 1u : 0u; mine = (j == x) ? c : mine; }
        if (sum == G) break;
        __builtin_amdgcn_s_sleep(1);
        if ((++sp & 255u) == 0u) { if (xb_ld(&bar[XB_TMO])) break; if (sp > XB_SPIN_CAP) { atomicAdd(&bar[XB_TMO], 1u); break; } }
    }
    nloc = mine > 0u ? mine : 1u; nx = cnt > 0u ? cnt : 1u;
}

__device__ __forceinline__ void xcd_barrier(const XcdBarrier& b) {
    asm volatile("s_waitcnt vmcnt(0)" ::: "memory");
    __syncthreads();
    if (threadIdx.x == 0) {
        unsigned* bar = b.bar;
        __builtin_amdgcn_s_waitcnt(0);
        asm volatile("buffer_inv sc1" ::: "memory");
        unsigned nloc = b.st[0], nx = b.st[1];
        if (nloc == 0u) { xcd_barrier_complete(bar, b.x, nloc, nx); b.st[0] = nloc; b.st[1] = nx; }
        const unsigned old = xb_add(&bar[XB_XSUB(b.x)], 1u);
        const unsigned gen = old / nloc;
        if (old + 1u == (gen + 1u) * nloc) {
            __builtin_amdgcn_fence(__ATOMIC_RELEASE, "agent");
            asm volatile("s_waitcnt vmcnt(0)" ::: "memory");
            const unsigned og = xb_add(&bar[XB_TOP], 1u);
            const unsigned tg = og / nx;
            if (og + 1u == (tg + 1u) * nx) xb_add(&bar[XB_TOPGEN], 1u);
            else XB_SPIN(xb_ld(&bar[XB_TOPGEN]) == tg, bar);
            asm volatile("" ::: "memory");
            xb_add(&bar[XB_XGEN(b.x)], 1u);
            asm volatile("s_waitcnt vmcnt(0)" ::: "memory");
        } else {
            XB_SPIN(xb_ld(&bar[XB_XGEN(b.x)]) == gen, bar);
            asm volatile("" ::: "memory");
            asm volatile("s_waitcnt vmcnt(0)" ::: "memory");
        }
    }
    __syncthreads();
}

struct Frame {
    LAS unsigned char* lds;
    volatile LAS unsigned* MISC;
    gu32* ctl;
    int tid, lane, wave;
    int vcu, G;
};
__device__ const unsigned char BUCKET[128] = {0, 1, 2, 3, 4, 5, 6, 7, 8, 9, 10, 11, 12, 13, 14, 15, 16, 16, 16, 17, 17, 18, 18, 18, 19, 19, 19, 20, 20, 20, 20, 21, 21, 21, 21, 22, 22, 22, 22, 22, 23, 23, 23, 23, 23, 23, 24, 24, 24, 24, 24, 24, 25, 25, 25, 25, 25, 25, 25, 26, 26, 26, 26, 26, 26, 26, 26, 27, 27, 27, 27, 27, 27, 27, 27, 27, 27, 28, 28, 28, 28, 28, 28, 28, 28, 28, 28, 29, 29, 29, 29, 29, 29, 29, 29, 29, 29, 29, 29, 30, 30, 30, 30, 30, 30, 30, 30, 30, 30, 30, 30, 30, 30, 31, 31, 31, 31, 31, 31, 31, 31, 31, 31, 31, 31, 31, 31, 31};

__device__ __forceinline__ float wave_sum(float v) {
#pragma unroll
    for (int o = 1; o < 64; o <<= 1) v += __shfl_xor(v, o);
    return v;
}
__device__ __forceinline__ float wave_max(float v) {
#pragma unroll
    for (int o = 1; o < 64; o <<= 1) v = fmaxf(v, __shfl_xor(v, o));
    return v;
}
__device__ __forceinline__ float bf2f(bf16 u) { return __uint_as_float((unsigned)u << 16); }
__device__ __forceinline__ float bflo(unsigned w) { return __uint_as_float(w << 16); }
__device__ __forceinline__ float bfhi(unsigned w) { return __uint_as_float(w & 0xffff0000u); }

__device__ __forceinline__ void st16_wt(void* p, v4u v) { asm volatile("global_store_dwordx4 %0, %1, off sc1\n\ts_nop 1" :: "v"(p), "v"(v) : "memory"); }
__device__ __forceinline__ void st8_wt(void* p, unsigned long long v) { asm volatile("global_store_dwordx2 %0, %1, off sc1\n\ts_nop 1" :: "v"(p), "v"(v) : "memory"); }
struct Args { const float* in[17]; float* out; unsigned char* ws; };
typedef const __attribute__((address_space(4))) Args* KArgs;
enum { I_XP = 0, I_XS = 1, I_CK = 2, I_CV = 3, I_ST = 4, I_RB = 5, I_AN = 6, I_WIN = 7, I_SK = 8, I_CW = 9, I_MN = 10, I_WOUT = 11, I_FN = 12, I_WG = 13, I_WU = 14, I_WD = 15, I_FIN = 16 };
#define WSP(T, off) ((T*)(args->ws + (off)))
__device__ __forceinline__ void cvt_item(const float* W, const float* gain, int K, int N, bf16* WT, int kb, int n0, int dst_row0, int lane) {
    const int k0 = 32 * kb; const float* wp = W + (size_t)k0 * N + n0 + lane;
    float v[32];
#pragma unroll
    for (int j = 0; j < 32; ++j) v[j] = __builtin_nontemporal_load(wp + (size_t)j * N);
    if (gain) {
#pragma unroll
        for (int j = 0; j < 32; ++j) v[j] *= gain[k0 + j]; }
    bf16* op = WT + (size_t)(dst_row0 + lane) * K + k0;
#pragma unroll
    for (int c = 0; c < 4; ++c) { v4u o; o.x = pk2(v[8 * c], v[8 * c + 1]); o.y = pk2(v[8 * c + 2], v[8 * c + 3]); o.z = pk2(v[8 * c + 4], v[8 * c + 5]); o.w = pk2(v[8 * c + 6], v[8 * c + 7]); *(GAS v4u*)(op + 8 * c) = o; }
}
constexpr int CI_IN = 0, CI_OUT = 1152, CI_G = 1664, CI_U = 3072, CI_D = 4480, CI_END = 5888;
__device__ __forceinline__ void cvt_layer_item(KArgs args, int l, int r, int lane) {
    if (r < CI_OUT) { const int nb = r % (NIN / 64), kb = r / (NIN / 64), n0 = 64 * nb;
        const int d0 = n0 < 1280 ? n0 : (n0 < 1792 ? 1280 + ((n0 - 1280) / 128) * 256 + (n0 - 1280) % 128 : 1280 + ((n0 - 1792) / 128) * 256 + 128 + (n0 - 1792) % 128);
        cvt_item(args->in[I_WIN] + (size_t)l * DM * NIN, args->in[I_AN] + l * DM, DM, NIN, WSP(bf16, WS_WIN) + (size_t)l * NIN * DM, kb, n0, d0, lane); return; }
    if (r < CI_G) { r -= CI_OUT; const int nb = r % (DM / 64), kb = r / (DM / 64); cvt_item(args->in[I_WOUT] + (size_t)l * DM * DM, args->in[I_MN] + l * DM, DM, DM, WSP(bf16, WS_WOUT) + (size_t)l * DM * DM, kb, 64 * nb, 64 * nb, lane); return; }
    if (r < CI_D) { r -= CI_G; const int up = r >= (CI_U - CI_G); if (up) r -= (CI_U - CI_G); const int nb = r % (DFF / 64), kb = r / (DFF / 64), n0 = 64 * nb;
        cvt_item((up ? args->in[I_WU] : args->in[I_WG]) + (size_t)l * DM * DFF, args->in[I_FN] + l * DM, DM, DFF, WSP(bf16, WS_WGU) + (size_t)l * NGU * DM, kb, n0, (n0 / 128) * 256 + (n0 % 128) + (up ? 128 : 0), lane); return; }
    { r -= CI_D; const int nb = r % (DM / 64), kb = r / (DM / 64); cvt_item(args->in[I_WD] + (size_t)l * DFF * DM, nullptr, DFF, DM, WSP(bf16, WS_WDN) + (size_t)l * DM * DFF, kb, 64 * nb, 64 * nb, lane); }
}
__device__ __forceinline__ void cvt_range(KArgs args, int l, int lo, int hi, int worker, int nworkers, int lane) {
    for (int r = lo + worker; r < hi; r += nworkers) cvt_layer_item(args, l, r, lane);
}
__device__ __forceinline__ void cache_copy(KArgs args, int l, int worker, int nworkers, int lane, int part, int nparts) {
    constexpr int PER_B = (WIN - DT) * 128 / 4;
    constexpr int NP = 2 * DBATCH * PER_B;
    const int lo = (int)((long)NP * part / nparts), hi = (int)((long)NP * (part + 1) / nparts);
    const int stride = nworkers * 64;
    for (int i0 = lo + worker * 64 + lane; i0 < hi; i0 += 8 * stride) {
        f32x4 x[8];
#pragma unroll
        for (int k = 0; k < 8; ++k) { const int i = i0 + k * stride; if (i < hi) { const int isv = i / (DBATCH * PER_B), rem = i % (DBATCH * PER_B), b = rem / PER_B, p = rem % PER_B;
            x[k] = __builtin_nontemporal_load((const f32x4*)((isv ? args->in[I_CV] : args->in[I_CK]) + (size_t)l * DBATCH * WIN * 128 + (size_t)b * WIN * 128 + DT * 128 + 4 * p)); } }
#pragma unroll
        for (int k = 0; k < 8; ++k) { const int i = i0 + k * stride; if (i < hi) { const int isv = i / (DBATCH * PER_B), rem = i % (DBATCH * PER_B), b = rem / PER_B, p = rem % PER_B;
            __builtin_nontemporal_store(x[k], (f32x4*)(args->out + (isv ? OUT_NVS : OUT_NKS) + (size_t)l * DBATCH * WIN * 128 + (size_t)b * WIN * 128 + 4 * p)); } }
    }
}
__device__ __forceinline__ void p0_prologue(const Frame& F0, KArgs args) {
    Frame F = F0; asm volatile("" : "+v"(F.tid), "+v"(F.lane));
    const int gw = F.vcu * NWAVES + F.wave, NGW = F.G * NWAVES;
    bf16* XB = WSP(bf16, WS_XB); float* SSQA = WSP(float, WS_SSQA);
    for (int m0 = gw; m0 < M; m0 += 2 * NGW) {
        f32x4 v[2][4]; float s[2];
#pragma unroll
        for (int r = 0; r < 2; ++r) { const int m = m0 + r * NGW; const int mm = m < M ? m : m0;
            const float* xrow = mm < MP ? args->in[I_XP] + (size_t)mm * DM : args->in[I_XS] + (size_t)(mm - MP) * DM;
#pragma unroll
            for (int j = 0; j < 2; ++j) { v[r][2 * j] = __builtin_nontemporal_load((const f32x4*)(xrow + 512 * j + 8 * F.lane)); v[r][2 * j + 1] = __builtin_nontemporal_load((const f32x4*)(xrow + 512 * j + 8 * F.lane + 4)); } }
#pragma unroll
        for (int r = 0; r < 2; ++r) { s[r] = 0.f;
#pragma unroll
            for (int j = 0; j < 4; ++j) s[r] += (v[r][j].x * v[r][j].x + v[r][j].y * v[r][j].y) + (v[r][j].z * v[r][j].z + v[r][j].w * v[r][j].w); }
#pragma unroll
        for (int o = 1; o < 64; o <<= 1) { s[0] += __shfl_xor(s[0], o); s[1] += __shfl_xor(s[1], o); }
#pragma unroll
        for (int r = 0; r < 2; ++r) { const int m = m0 + r * NGW; if (m < M) {
#pragma unroll
            for (int j = 0; j < 2; ++j) { v4u w; w.x = pk2(v[r][2 * j].x, v[r][2 * j].y); w.y = pk2(v[r][2 * j].z, v[r][2 * j].w); w.z = pk2(v[r][2 * j + 1].x, v[r][2 * j + 1].y); w.w = pk2(v[r][2 * j + 1].z, v[r][2 * j + 1].w);
                st16_wt(XB + (size_t)m * DM + 512 * j + 8 * F.lane, w); }
            if (F.lane == 0) SSQA[m] = s[r]; } }
    }
    cvt_range(args, 0, CI_IN, CI_G, gw, NGW, F.lane);
}

typedef float f32x16 __attribute__((ext_vector_type(16)));
typedef short s16x4 __attribute__((ext_vector_type(4)));
constexpr int ARS = 144;
constexpr int AKR = 192;
constexpr int LB_K = 0, LB_V = 2 * AKR * ARS, LB_TAB = 2 * LB_V, LB_SSQ = LB_TAB + 8 * 192 * 4, LB_END = LB_SSQ + 2048;
constexpr int LB_ST0 = LB_END;
constexpr int OST0 = 144;
static_assert(LB_ST0 + 8 * 32 * OST0 <= LDSCTL_OFF, "mixer LDS");
constexpr float LOG2E = 1.4426950408889634f;
__device__ __forceinline__ s16x4 vtr(const LAS unsigned char* p) { return __builtin_bit_cast(s16x4, __builtin_amdgcn_ds_read_tr16_b64_v4i16((LAS s16x4*)p)); }
__device__ __forceinline__ void attn_qtile(const bf16x8 (&qf)[4], const LAS unsigned char* kimg, const LAS unsigned char* vimg, int tile0, const LAS float* tab_lane, float sink2, unsigned tilemask, int lane, f32x16 (&o)[2]) {
    const int q = lane & 31, hi = lane >> 5;
    f32x16 S[5];
    const LAS unsigned char* kb = kimg + (tile0 * 32 + q) * ARS + hi * 16;
#pragma unroll
    for (int jj = 0; jj < 5; ++jj) {
        f32x16 acc = {};
#pragma unroll
        for (int ds = 0; ds < 4; ++ds) { const bf16x8 kf = *(const LAS bf16x8*)(kb + jj * 32 * ARS + ds * 32); acc = __builtin_amdgcn_mfma_f32_32x32x16_bf16(kf, qf[ds], acc, 0, 0, 0); }
        S[jj] = acc;
    }
    const float c2 = 0.125f * LOG2E;
    float mx = sink2;
#pragma unroll
    for (int jj = 0; jj < 5; ++jj) { const bool tm = (tilemask >> jj) & 1u;
#pragma unroll
        for (int r = 0; r < 16; ++r) { const float bv = tab_lane[159 - 32 * jj - (r & 3) - 8 * (r >> 2)]; float s = fmaf(S[jj][r], c2, bv); s = tm ? -1e30f : s; S[jj][r] = s; mx = fmaxf(mx, s); } }
    mx = fmaxf(mx, __shfl_xor(mx, 32));
    float lsum = 0.f;
#pragma unroll
    for (int jj = 0; jj < 5; ++jj)
#pragma unroll
        for (int r = 0; r < 16; ++r) { const float p = __builtin_amdgcn_exp2f(S[jj][r] - mx); lsum += p; S[jj][r] = p; }
    lsum += __shfl_xor(lsum, 32); lsum += __builtin_amdgcn_exp2f(sink2 - mx);
    bf16x8 pf[5][2];
#pragma unroll
    for (int jj = 0; jj < 5; ++jj)
#pragma unroll
        for (int s = 0; s < 2; ++s) { v4u w; w.x = pg8::cvt_pk_bf16(S[jj][8 * s + 0], S[jj][8 * s + 1]); w.y = pg8::cvt_pk_bf16(S[jj][8 * s + 2], S[jj][8 * s + 3]); w.z = pg8::cvt_pk_bf16(S[jj][8 * s + 4], S[jj][8 * s + 5]); w.w = pg8::cvt_pk_bf16(S[jj][8 * s + 6], S[jj][8 * s + 7]);
            pf[jj][s] = __builtin_bit_cast(bf16x8, w); }
    const LAS unsigned char* vb = vimg + (tile0 * 32 + 4 * hi + ((lane & 15) >> 2)) * ARS + (16 * ((lane >> 4) & 1) + 4 * (lane & 3)) * 2;
    const float rl = 1.0f / lsum;
#pragma unroll
    for (int db = 0; db < 2; ++db) {
        f32x16 acc = {};
#pragma unroll
        for (int jj = 0; jj < 5; ++jj)
#pragma unroll
            for (int s = 0; s < 2; ++s) { const LAS unsigned char* a = vb + (jj * 32 + 16 * s) * ARS + db * 64;
                const s16x4 lo = vtr(a), hh = vtr(a + 8 * ARS);
                const bf16x8 vf = {lo[0], lo[1], lo[2], lo[3], hh[0], hh[1], hh[2], hh[3]};
                acc = __builtin_amdgcn_mfma_f32_32x32x16_bf16(vf, pf[jj][s], acc, 0, 0, 0); }
        o[db] = acc * rl;
    }
}
__device__ __forceinline__ void load_qf(const bf16* qptr, bf16x8 (&qf)[4]) {
#pragma unroll
    for (int ds = 0; ds < 4; ++ds) qf[ds] = *(const bf16x8*)(qptr + 16 * ds);
}
__device__ __forceinline__ float sumsq32(const f32x16 (&o)[2]) { float s = 0.f;
#pragma unroll
    for (int db = 0; db < 2; ++db)
#pragma unroll
        for (int r = 0; r < 16; ++r) s += o[db][r] * o[db][r];
    return s; }
__device__ __forceinline__ void store_o(bf16* mrow_head, const f32x16 (&o)[2], float ra, int hi) {
#pragma unroll
    for (int db = 0; db < 2; ++db)
#pragma unroll
        for (int g = 0; g < 4; ++g) { const unsigned w0 = pg8::cvt_pk_bf16(o[db][4 * g] * ra, o[db][4 * g + 1] * ra), w1 = pg8::cvt_pk_bf16(o[db][4 * g + 2] * ra, o[db][4 * g + 3] * ra);
            *(unsigned long long*)(mrow_head + 32 * db + 8 * g + 4 * hi) = (unsigned long long)w0 | ((unsigned long long)w1 << 32); }
}
__device__ __forceinline__ void unpack8(const v4u w, float (&f)[8]) { f[0] = bflo(w.x); f[1] = bfhi(w.x); f[2] = bflo(w.y); f[3] = bfhi(w.y); f[4] = bflo(w.z); f[5] = bfhi(w.z); f[6] = bflo(w.w); f[7] = bfhi(w.w); }
__device__ __forceinline__ void cu8(const bf16* Z, size_t row, int lane, float (&c)[8]) { unpack8(*(const v4u*)(Z + row * ZP + ZCU + 8 * lane), c); }
__device__ __forceinline__ void conv_row_out(const bf16* Z, bf16* MB, size_t row, int lane, const float (&cw)[3][8], const float (&c2)[8], const float (&c1)[8], const float (&c0)[8]) {
    float gb[8]; unpack8(*(const v4u*)(Z + row * ZP + ZGB + 8 * lane), gb);
    float v[8]; float ss = 0.f;
#pragma unroll
    for (int i = 0; i < 8; ++i) { v[i] = gb[i] * (cw[0][i] * c2[i] + cw[1][i] * c1[i] + cw[2][i] * c0[i]); ss += v[i] * v[i]; }
    const float rc = rsqrtf(wave_sum(ss) * (1.f / 512.f) + EPS);
    v4u w; w.x = pg8::cvt_pk_bf16(v[0] * rc, v[1] * rc); w.y = pg8::cvt_pk_bf16(v[2] * rc, v[3] * rc); w.z = pg8::cvt_pk_bf16(v[4] * rc, v[5] * rc); w.w = pg8::cvt_pk_bf16(v[6] * rc, v[7] * rc);
    *(v4u*)(MB + row * DM + 512 + 8 * lane) = w;
}
__device__ __forceinline__ void load_cw(const float* cwp, int lane, float (&cw)[3][8]) {
#pragma unroll
    for (int k = 0; k < 3; ++k) { const f32x4 a = *(const f32x4*)(cwp + k * 512 + 8 * lane), b = *(const f32x4*)(cwp + k * 512 + 8 * lane + 4);
        cw[k][0] = a[0]; cw[k][1] = a[1]; cw[k][2] = a[2]; cw[k][3] = a[3]; cw[k][4] = b[0]; cw[k][5] = b[1]; cw[k][6] = b[2]; cw[k][7] = b[3]; }
}
template <int NR>
__device__ __forceinline__ void conv_rows(const bf16* Z, bf16* MB, const float* cwp, size_t r0, long t0, int lane) {
    v4u cuw[NR + 2], gbw[NR];
#pragma unroll
    for (int j = 0; j < NR + 2; ++j) { const size_t rr = (t0 - 2 + j >= 0) ? r0 - 2 + j : r0; cuw[j] = *(const v4u*)(Z + rr * ZP + ZCU + 8 * lane); }
#pragma unroll
    for (int k = 0; k < NR; ++k) gbw[k] = *(const v4u*)(Z + (r0 + k) * ZP + ZGB + 8 * lane);
    float cw[3][8]; load_cw(cwp, lane, cw);
    float cu[NR + 2][8];
#pragma unroll
    for (int j = 0; j < NR + 2; ++j) { float a[8]; unpack8(cuw[j], a); const float keep = (t0 - 2 + j >= 0) ? 1.f : 0.f;
#pragma unroll
        for (int i = 0; i < 8; ++i) cu[j][i] = a[i] * keep; }
    float v[NR][8], ss[NR];
#pragma unroll
    for (int k = 0; k < NR; ++k) { float gb[8]; unpack8(gbw[k], gb); ss[k] = 0.f;
#pragma unroll
        for (int i = 0; i < 8; ++i) { v[k][i] = gb[i] * (cw[0][i] * cu[k][i] + cw[1][i] * cu[k + 1][i] + cw[2][i] * cu[k + 2][i]); ss[k] += v[k][i] * v[k][i]; } }
#pragma unroll
    for (int o = 1; o < 64; o <<= 1)
#pragma unroll
        for (int k = 0; k < NR; ++k) ss[k] += __shfl_xor(ss[k], o);
#pragma unroll
    for (int k = 0; k < NR; ++k) { const float rc = rsqrtf(ss[k] * (1.f / 512.f) + EPS);
        v4u w; w.x = pg8::cvt_pk_bf16(v[k][0] * rc, v[k][1] * rc); w.y = pg8::cvt_pk_bf16(v[k][2] * rc, v[k][3] * rc); w.z = pg8::cvt_pk_bf16(v[k][4] * rc, v[k][5] * rc); w.w = pg8::cvt_pk_bf16(v[k][6] * rc, v[k][7] * rc);
        st16_wt(MB + (r0 + k) * DM + 512 + 8 * lane, w); }
}
#define WG_BAR() do { asm volatile("s_waitcnt vmcnt(0) lgkmcnt(0)" ::: "memory"); __builtin_amdgcn_s_barrier(); asm volatile("" ::: "memory"); } while (0)
__device__ __forceinline__ void pack_o(const f32x16 (&o)[2], float s, unsigned (&p)[16]) {
#pragma unroll
    for (int db = 0; db < 2; ++db)
#pragma unroll
        for (int g = 0; g < 4; ++g) { p[db * 8 + g * 2] = pg8::cvt_pk_bf16(o[db][4 * g] * s, o[db][4 * g + 1] * s); p[db * 8 + g * 2 + 1] = pg8::cvt_pk_bf16(o[db][4 * g + 2] * s, o[db][4 * g + 3] * s); }
}
constexpr int OST = 144;
__device__ __forceinline__ void mixer_prompt_unit(const Frame& F, KArgs args, int l, int unit, bool build_tab) {
    const int tid = F.tid, lane = F.lane, wave = F.wave, q = lane & 31, hi = lane >> 5;
    const int b = unit >> 7, n = (unit >> 1) & 63, qh = unit & 1;
    const size_t R0 = (size_t)b * SEQ + 128 * n + 64 * qh;
    const long W0 = (long)R0 - 128, B0 = (long)b * SEQ;
    const bf16* Z = WSP(bf16, WS_Z); bf16* MB = WSP(bf16, WS_MB);
    LAS unsigned char* lds = F.lds + RING_OFF;
    const int h = wave, kv = h >> 2;
#pragma unroll 6
    for (int k = 0; k < 12; ++k) { const int idx = tid + 512 * k, piece = idx & 31, wrow = idx >> 5; long gr = W0 + wrow; gr = gr < B0 ? B0 : gr;
        const v4u d = *(const v4u*)(Z + (size_t)gr * ZP + ZK + piece * 8);
        *(LAS v4u*)(lds + ((piece >> 4) ? LB_V : LB_K) + (((piece >> 3) & 1) * AKR + wrow) * ARS + (piece & 7) * 16) = d; }
    conv_rows<4>(Z, MB, args->in[I_CW] + (size_t)l * 3 * 512, R0 + 8 * wave, (long)(R0 + 8 * wave) - B0, lane);
    conv_rows<4>(Z, MB, args->in[I_CW] + (size_t)l * 3 * 512, R0 + 8 * wave + 4, (long)(R0 + 8 * wave + 4) - B0, lane);
    if (build_tab) { LAS float* tab = (LAS float*)(lds + LB_TAB);
        for (int i = tid; i < 8 * 192; i += 512) { const int hh = i / 192, d = i % 192 - 32; tab[i] = (d >= 0 && d < 128) ? args->in[I_RB][BUCKET[d] * 8 + hh] * LOG2E : -1e30f; } }
    bf16x8 qf0[4]; load_qf(Z + (R0 + q) * ZP + h * 64 + 8 * hi, qf0);
    WG_BAR();
    const float sink2 = args->in[I_SK][l * 8 + h] * LOG2E;
    const LAS float* tab_lane = (const LAS float*)(lds + LB_TAB) + h * 192 + (1 + q - 4 * hi);
    LAS float* ssqx = (LAS float*)(lds + LB_SSQ);
    const unsigned tm0 = (n == 0) ? ((1u << (4 - 2 * qh)) - 1u) : 0u;
    f32x16 o1[2];
    LAS unsigned char* st0 = lds + LB_ST0 + wave * (32 * OST0);
    {   f32x16 o[2];
        attn_qtile(qf0, lds + LB_K + kv * AKR * ARS, lds + LB_V + kv * AKR * ARS, 0, tab_lane, sink2, tm0, lane, o);
        float ss = sumsq32(o); ss += __shfl_xor(ss, 32); if (hi == 0) ssqx[q * 8 + h] = ss;
        unsigned p0[16]; pack_o(o, 1.0f, p0);
#pragma unroll
        for (int i = 0; i < 8; ++i) *(LAS unsigned long long*)(st0 + q * OST0 + (i >> 2) * 64 + (i & 3) * 16 + hi * 8) = (unsigned long long)p0[2 * i] | ((unsigned long long)p0[2 * i + 1] << 32); }
    {   bf16x8 qf1[4]; load_qf(Z + (R0 + 32 + q) * ZP + h * 64 + 8 * hi, qf1);
        attn_qtile(qf1, lds + LB_K + kv * AKR * ARS, lds + LB_V + kv * AKR * ARS, 1, tab_lane, sink2, tm0 >> 1, lane, o1);
        float ss = sumsq32(o1); ss += __shfl_xor(ss, 32); if (hi == 0) ssqx[(32 + q) * 8 + h] = ss; }
    WG_BAR();
    LAS unsigned char* st1 = lds + wave * (32 * OST);
    {   const LAS f32x4* sp = (const LAS f32x4*)(ssqx + (32 + q) * 8); const f32x4 a = sp[0], c = sp[1];
        const float ra = rsqrtf((((a[0] + a[1]) + (a[2] + a[3])) + ((c[0] + c[1]) + (c[2] + c[3]))) * (1.f / 512.f) + EPS);
        unsigned p1[16]; pack_o(o1, ra, p1);
#pragma unroll
        for (int i = 0; i < 8; ++i) *(LAS unsigned long long*)(st1 + q * OST + (i >> 2) * 64 + (i & 3) * 16 + hi * 8) = (unsigned long long)p1[2 * i] | ((unsigned long long)p1[2 * i + 1] << 32); }
    asm volatile("s_waitcnt lgkmcnt(0)" ::: "memory");
#pragma unroll
    for (int i = 0; i < 4; ++i) { const int row = 8 * i + (lane >> 3), ch = lane & 7;
        const LAS f32x4* sp = (const LAS f32x4*)(ssqx + row * 8); const f32x4 a = sp[0], c = sp[1];
        const float ra = rsqrtf((((a[0] + a[1]) + (a[2] + a[3])) + ((c[0] + c[1]) + (c[2] + c[3]))) * (1.f / 512.f) + EPS);
        const v4u d = *(const LAS v4u*)(st0 + row * OST0 + ch * 16);
        v4u w; w.x = pg8::cvt_pk_bf16(bflo(d.x) * ra, bfhi(d.x) * ra); w.y = pg8::cvt_pk_bf16(bflo(d.y) * ra, bfhi(d.y) * ra); w.z = pg8::cvt_pk_bf16(bflo(d.z) * ra, bfhi(d.z) * ra); w.w = pg8::cvt_pk_bf16(bflo(d.w) * ra, bfhi(d.w) * ra);
        st16_wt(MB + (R0 + row) * DM + h * 64 + 8 * ch, w); }
#pragma unroll
    for (int i = 0; i < 4; ++i) { const int row = 8 * i + (lane >> 3), ch = lane & 7;
        const v4u d = *(const LAS v4u*)(st1 + row * OST + ch * 16);
        st16_wt(MB + (R0 + 32 + row) * DM + h * 64 + 8 * ch, d); }
}
__device__ __forceinline__ void mixer_sample_unit(const Frame& F, KArgs args, int l, int b) {
    const int tid = F.tid, lane = F.lane, wave = F.wave, hi = lane >> 5;
    const size_t RS0 = (size_t)MP + 4 * b;
    const bf16* Z = WSP(bf16, WS_Z); bf16* MB = WSP(bf16, WS_MB);
    LAS unsigned char* lds = F.lds + RING_OFF;
    float* out = args->out;
#if PROBE_TS
#pragma unroll 2
#else
#pragma unroll
#endif
    for (int k = 0; k < 8; ++k) { const int idx = tid + 512 * k, isv = idx >> 11, rem = idx & 2047, w = rem >> 4, pc = rem & 15;
        const float* src = (isv ? args->in[I_CV] : args->in[I_CK]) + (size_t)l * DBATCH * WIN * 128 + ((size_t)b * WIN + w) * 128 + pc * 8;
        const f32x4 x0 = __builtin_nontemporal_load((const f32x4*)src), x1 = __builtin_nontemporal_load((const f32x4*)(src + 4));
        v4u pk; pk.x = pg8::cvt_pk_bf16(x0[0], x0[1]); pk.y = pg8::cvt_pk_bf16(x0[2], x0[3]); pk.z = pg8::cvt_pk_bf16(x1[0], x1[1]); pk.w = pg8::cvt_pk_bf16(x1[2], x1[3]);
        *(LAS v4u*)(lds + (isv ? LB_V : LB_K) + ((pc >> 3) * AKR + w) * ARS + (pc & 7) * 16) = pk; }
    if (tid < 128) { const int t = tid >> 5, piece = tid & 31;
        const v4u d = *(const v4u*)(Z + (RS0 + t) * ZP + ZK + piece * 8);
        *(LAS v4u*)(lds + ((piece >> 4) ? LB_V : LB_K) + (((piece >> 3) & 1) * AKR + 128 + t) * ARS + (piece & 7) * 16) = d;
        float f[8]; unpack8(d, f);
        float* dst = out + ((piece >> 4) ? OUT_NVS : OUT_NKS) + (size_t)l * DBATCH * WIN * 128 + ((size_t)b * WIN + (WIN - DT) + t) * 128 + (piece & 15) * 8;
        *(f32x4*)dst = (f32x4){f[0], f[1], f[2], f[3]}; *(f32x4*)(dst + 4) = (f32x4){f[4], f[5], f[6], f[7]}; }
    for (int idx = tid; idx < 28 * 32; idx += 512) { const int zr = idx >> 5, piece = idx & 31;
        *(LAS v4u*)(lds + ((piece >> 4) ? LB_V : LB_K) + (((piece >> 3) & 1) * AKR + 132 + zr) * ARS + (piece & 7) * 16) = (v4u){0u, 0u, 0u, 0u}; }
    WG_BAR();
    LAS float* ssqx = (LAS float*)(lds + LB_SSQ);
    f32x16 o[2]; const int qc = lane & 31, t = (qc >> 2) & 3, g = qc & 3;
    if (wave < 2) {
        const int kv = wave, head = 4 * kv + g;
        const float sink2 = args->in[I_SK][l * 8 + head] * LOG2E;
        const LAS float* tab_lane = (const LAS float*)(lds + LB_TAB) + head * 192 + (1 + t - 4 * hi);
        bf16x8 qf[4]; load_qf(Z + (RS0 + t) * ZP + head * 64 + 8 * hi, qf);
        attn_qtile(qf, lds + LB_K + kv * AKR * ARS, lds + LB_V + kv * AKR * ARS, 0, tab_lane, sink2, 0u, lane, o);
        float ss = sumsq32(o); ss += __shfl_xor(ss, 32); ss += __shfl_xor(ss, 1); ss += __shfl_xor(ss, 2);
        if (lane < 16 && g == 0) ssqx[t * 2 + kv] = ss;
    } else if (wave < 6) {
        const int tt = wave - 2; float cw[3][8]; load_cw(args->in[I_CW] + (size_t)l * 3 * 512, lane, cw);
        const float* st = args->in[I_ST] + (size_t)l * DBATCH * 2 * 512 + (size_t)b * 2 * 512;
        float c2[8], c1[8], c0[8];
        if (tt >= 2) cu8(Z, RS0 + tt - 2, lane, c2); else { const f32x4 a = *(const f32x4*)(st + tt * 512 + 8 * lane), c = *(const f32x4*)(st + tt * 512 + 8 * lane + 4); c2[0] = a[0]; c2[1] = a[1]; c2[2] = a[2]; c2[3] = a[3]; c2[4] = c[0]; c2[5] = c[1]; c2[6] = c[2]; c2[7] = c[3]; }
        if (tt >= 1) cu8(Z, RS0 + tt - 1, lane, c1); else { const f32x4 a = *(const f32x4*)(st + 512 + 8 * lane), c = *(const f32x4*)(st + 512 + 8 * lane + 4); c1[0] = a[0]; c1[1] = a[1]; c1[2] = a[2]; c1[3] = a[3]; c1[4] = c[0]; c1[5] = c[1]; c1[6] = c[2]; c1[7] = c[3]; }
        cu8(Z, RS0 + tt, lane, c0);
        conv_row_out(Z, MB, RS0 + tt, lane, cw, c2, c1, c0);
    }
    WG_BAR();
    if (wave < 2) { const int head = 4 * wave + g;
        const float ra = rsqrtf((ssqx[t * 2] + ssqx[t * 2 + 1]) * (1.f / 512.f) + EPS);
        if (qc < 16) store_o(MB + (RS0 + t) * DM + head * 64, o, ra, hi); }
}
__device__ __forceinline__ void state_outputs(const Frame& F, KArgs args, int l, int wg, int nwg) {
    const bf16* Z = WSP(bf16, WS_Z); float* out = args->out;
    const size_t gt = (size_t)wg * 512 + F.tid, NT = (size_t)nwg * 512;
    for (size_t i = gt; i < (size_t)DBATCH * 2 * 512; i += NT) {
        if (i < (size_t)NBATCH * WIN * 128) { const int b = i / (WIN * 128), w = (i / 128) % WIN, c = i % 128; const size_t r = (size_t)b * SEQ + SEQ - WIN + w;
            out[OUT_NKP + (size_t)l * NBATCH * WIN * 128 + i] = bf2f(Z[r * ZP + ZK + c]); out[OUT_NVP + (size_t)l * NBATCH * WIN * 128 + i] = bf2f(Z[r * ZP + ZV + c]); }
        if (i < (size_t)NBATCH * 2 * 512) { const int b = i / 1024, j = (i / 512) % 2, ch = i % 512; const size_t r = (size_t)b * SEQ + SEQ - 2 + j;
            out[OUT_NCP + (size_t)l * NBATCH * 1024 + i] = bf2f(Z[r * ZP + ZCU + ch]); }
        { const int b = i / 1024, j = (i / 512) % 2, ch = i % 512; const size_t r = (size_t)MP + b * DT + 2 + j;
            out[OUT_NCS + (size_t)l * DBATCH * 1024 + i] = bf2f(Z[r * ZP + ZCU + ch]); }
    }
}
__device__ __forceinline__ void phaseB1(const Frame& F0, KArgs args, int l) {
    Frame F = F0; asm volatile("" : "+v"(F.tid), "+v"(F.lane));
    bool first = true;
    for (int u = F.vcu; u < NBATCH * 64 * 2; u += F.G) { WG_BAR(); mixer_prompt_unit(F, args, l, u, first); first = false; }
}
__device__ __forceinline__ void phaseB2(const Frame& F0, KArgs args, int l) {
    Frame F = F0; asm volatile("" : "+v"(F.tid), "+v"(F.lane));
    for (int b = F.vcu; b < DBATCH; b += F.G) { WG_BAR(); mixer_sample_unit(F, args, l, b); }
    if (F.G > DBATCH) { if (F.vcu >= DBATCH) { cache_copy(args, l, (F.vcu - DBATCH) * NWAVES + F.wave, (F.G - DBATCH) * NWAVES, F.lane, 0, 2); state_outputs(F, args, l, F.vcu - DBATCH, F.G - DBATCH); } }
    else { cache_copy(args, l, F.vcu * NWAVES + F.wave, F.G * NWAVES, F.lane, 0, 2); state_outputs(F, args, l, F.vcu, F.G); }
    WG_BAR();
}
template <int K, bool LAST>
__device__ __forceinline__ void tail_gemm_resid(const Frame& F, const bf16* A, const bf16* Bt, bf16* xb, float* out, float* ssq_rows  , int tile) {
    const int lane = F.lane, wave = F.wave, fr = lane & 15, fq = lane >> 4;
    const int row0 = (tile >> 4) * 32, col0 = (tile & 15) * 64, tc = tile & 15;
    constexpr int KW = K / 8, STEPS = KW / 32; static_assert(KW % 32 == 0, "K split");
    f32x4 acc[2][4];
#pragma unroll
    for (int m = 0; m < 2; ++m)
#pragma unroll
        for (int n = 0; n < 4; ++n) acc[m][n] = (f32x4){0.f, 0.f, 0.f, 0.f};
    const bf16* ap = A + (size_t)(row0 + fr) * K + wave * KW + 8 * fq;
    const bf16* bp = Bt + (size_t)(col0 + fr) * K + wave * KW + 8 * fq;
#pragma unroll 2
    for (int s = 0; s < STEPS; ++s) {
        bf16x8 a[2], b[4];
#pragma unroll
        for (int m = 0; m < 2; ++m) a[m] = *(const bf16x8*)(ap + (size_t)(16 * m) * K + 32 * s);
#pragma unroll
        for (int n = 0; n < 4; ++n) b[n] = *(const bf16x8*)(bp + (size_t)(16 * n) * K + 32 * s);
#pragma unroll
        for (int m = 0; m < 2; ++m)
#pragma unroll
            for (int n = 0; n < 4; ++n) acc[m][n] = __builtin_amdgcn_mfma_f32_16x16x32_bf16(b[n], a[m], acc[m][n], 0, 0, 0);
    }
    LAS float* red = (LAS float*)(F.lds + RING_OFF);
#pragma unroll
    for (int m = 0; m < 2; ++m)
#pragma unroll
        for (int n = 0; n < 4; ++n) *(LAS f32x4*)(red + ((wave * 32 + 16 * m + fr) * 64 + 16 * n + 4 * fq)) = acc[m][n];
    WG_BAR();
    const int t = F.tid, r = t >> 4, c4 = (t & 15) * 4;
    bf16* xp = xb + (size_t)(row0 + r) * DM + col0 + c4;
    const unsigned long long bw = *(const unsigned long long*)xp;
    f32x4 v = (f32x4){bflo((unsigned)bw), bfhi((unsigned)bw), bflo((unsigned)(bw >> 32)), bfhi((unsigned)(bw >> 32))};
#pragma unroll
    for (int w = 0; w < 8; ++w) v += *(const LAS f32x4*)(red + ((w * 32 + r) * 64 + c4));
    if (LAST) *(f32x4*)(out + (size_t)(row0 + r) * DM + col0 + c4) = v;
    else *(unsigned long long*)xp = (unsigned long long)pg8::cvt_pk_bf16(v[0], v[1]) | ((unsigned long long)pg8::cvt_pk_bf16(v[2], v[3]) << 32);
    float q = (v[0] * v[0] + v[1] * v[1]) + (v[2] * v[2] + v[3] * v[3]);
    q += __shfl_xor(q, 1); q += __shfl_xor(q, 2); q += __shfl_xor(q, 4); q += __shfl_xor(q, 8);
    if ((t & 15) == 0) ssq_rows[(size_t)tc * M + row0 + r] = q;
    WG_BAR();
}
__device__ __forceinline__ void phase_final(const Frame& F0, KArgs args) {
    Frame F = F0; asm volatile("" : "+v"(F.tid), "+v"(F.lane));
    const int gw = F.vcu * NWAVES + F.wave, NGW = F.G * NWAVES;
    const float* SSQA = WSP(float, WS_SSQA);
    const bf16* XB = WSP(bf16, WS_XB);
    for (int m = gw; m < M; m += NGW) {
        float part = F.lane < 16 ? SSQA[(size_t)F.lane * M + m] : 0.f;
        const float rstd = rsqrtf(wave_sum(part) * (1.f / DM) + EPS);
        const GAS unsigned long long* xr = (const GAS unsigned long long*)(XB + (size_t)m * DM) + F.lane; const GAS f32x4* g = (const GAS f32x4*)args->in[I_FIN] + F.lane;
        GAS f32x4* yr = (GAS f32x4*)(args->out + (size_t)m * DM) + F.lane;
#pragma unroll
        for (int j = 0; j < 4; ++j) { const unsigned long long w = xr[64 * j]; const f32x4 gg = g[64 * j];
            f32x4 v = (f32x4){bflo((unsigned)w), bfhi((unsigned)w), bflo((unsigned)(w >> 32)), bfhi((unsigned)(w >> 32))}; v = v * rstd * gg; __builtin_nontemporal_store(v, (f32x4*)(yr + 64 * j)); }
    }
}

#ifndef REP_A
#define REP_A 1
#endif
#ifndef REP_D
#define REP_D 1
#endif
#ifndef REP_T
#define REP_T 1
#endif
#ifndef REP_BAR
#define REP_BAR 0
#endif
#ifndef REP_P0
#define REP_P0 1
#endif
#ifndef REP_B
#define REP_B 1
#endif
__global__ void __launch_bounds__(NWAVES * 64, 2) mega_fwd(Args args_) {
    extern __shared__ __attribute__((aligned(16))) unsigned char lds[];
    Frame F;
    F.lds = (LAS unsigned char*)lds;
    F.MISC = (volatile LAS unsigned*)(F.lds + MISC_OFF);
    F.tid = threadIdx.x; F.lane = F.tid & 63; F.wave = __builtin_amdgcn_readfirstlane(F.tid >> 6);
    F.G = gridDim.x; { const int bx = blockIdx.x; F.vcu = (F.G % 8 == 0) ? (bx % 8) * (F.G / 8) + bx / 8 : bx; }
    F.ctl = (gu32*)(args_.ws + WS_CTL);
    for (int u = F.tid; u < (LDS_BYTES - LDSCTL_OFF) / 4; u += NWAVES * 64) ((LAS unsigned*)(F.lds + LDSCTL_OFF))[u] = 0u;
    __syncthreads();
    XcdBarrier bar = xcd_barrier_post((unsigned*)(F.ctl + CW_BAR), F.MISC + 8);
#if PROBE_TS
#define PROBE_HIT(i_) (((i_) == 0) ? false : ((i_) == 100 ? PROBE_PH == 7 : ((i_) == 1 ? PROBE_PH == 0 : (((i_) - 2) % 5 + 1 == PROBE_PH || (PROBE_PH == 8 && ((i_) - 2) % 5 == 1)))))
#define BAR_STAMP(i) do { const int i_ = (i); const bool hit_ = PROBE_HIT(i_); \
    for (int rb_ = 0; rb_ < (hit_ ? 2 : 1); ++rb_) { GRID_BAR(); \
        if (blockIdx.x == 0 && F.tid == 0) { const unsigned long long now_ = __builtin_amdgcn_s_memrealtime(); \
            if (hit_ && rb_ == 0) { const unsigned long long t0_ = ((unsigned long long)F.MISC[17] << 32) | F.MISC[16]; const unsigned long long d_ = now_ - t0_; while (__builtin_amdgcn_s_memrealtime() < now_ + 4 * d_) __builtin_amdgcn_s_sleep(20); } \
            if (PROBE_PH == 9 && i_ == 5 && rb_ == 0) { const unsigned long long t0_ = ((unsigned long long)F.MISC[17] << 32) | F.MISC[16], m0_ = ((unsigned long long)F.MISC[19] << 32) | F.MISC[18]; \
                const unsigned long long drt_ = now_ - t0_, dmt_ = __builtin_amdgcn_s_memtime() - m0_; const unsigned long long sp_ = dmt_ * 1000ull / drt_; while (__builtin_amdgcn_s_memrealtime() < now_ + sp_) __builtin_amdgcn_s_sleep(20); } \
            const unsigned long long n2_ = __builtin_amdgcn_s_memrealtime(); F.MISC[16] = (unsigned)n2_; F.MISC[17] = (unsigned)(n2_ >> 32); const unsigned long long m2_ = __builtin_amdgcn_s_memtime(); F.MISC[18] = (unsigned)m2_; F.MISC[19] = (unsigned)(m2_ >> 32); } } } while (0)
#define STAMP0() do { if (blockIdx.x == 0 && F.tid == 0) { const unsigned long long n2_ = __builtin_amdgcn_s_memrealtime(); F.MISC[16] = (unsigned)n2_; F.MISC[17] = (unsigned)(n2_ >> 32); } } while (0)
#else
#define BAR_STAMP(i) GRID_BAR()
#define STAMP0() do {} while (0)
#endif
#define GRID_BAR() do { XcdBarrier bb_ = bar; asm volatile("" : "+s"(bb_.x)); xcd_barrier(bb_); } while (0)
#define PHASE_ARGS() KArgs args = (KArgs)__builtin_amdgcn_kernarg_segment_ptr(); asm volatile("" : "+s"(args))
#define LAYER() int l = l_; asm volatile("" : "+s"(l))

    STAMP0();
    for (int rep_ = 0; rep_ < REP_P0; ++rep_) { PHASE_ARGS(); p0_prologue(F, args); }
    BAR_STAMP(1);
    for (int l_ = 0; l_ < NLAYER; ++l_) {
        {   PHASE_ARGS(); LAYER();
            pg8::Gemm g{WSP(bf16, WS_XB), WSP(bf16, WS_WIN) + (size_t)l * NIN * DM, M, NIN, DM}; pg8::StaticOrder S; S.init(M, NIN, F.G, (int)blockIdx.x);
            pg8::EpiScaleBf16 E{WSP(bf16, WS_Z), ZP, WSP(float, WS_SSQA), l == 0 ? 1 : 16, M};
            for (int rep_ = 0; rep_ < REP_A; ++rep_) pg8::gemm_phase<pg8::EpiScaleBf16, pg8::StaticOrder, true, true>(F.lds + RING_OFF, g, S, E);
            const int full = ((M / 256) * (NIN / 256)) % F.G;
            if ((int)blockIdx.x >= full) { Frame F2 = F; asm volatile("" : "+v"(F2.tid), "+v"(F2.lane)); cvt_range(args, l, CI_G, CI_END, ((int)blockIdx.x - full) * NWAVES + F2.wave, (F.G - full) * NWAVES, F2.lane); }
        }
        BAR_STAMP(2 + 5 * l_);
        for (int rep_ = 0; rep_ < REP_B; ++rep_) { { PHASE_ARGS(); LAYER(); phaseB1(F, args, l); }
#if PROBE_TS
            if (PROBE_PH == 7 || PROBE_PH == 8) { BAR_STAMP(100); }
#endif
            { PHASE_ARGS(); LAYER(); phaseB2(F, args, l); } }
        BAR_STAMP(3 + 5 * l_);
        {   PHASE_ARGS(); LAYER();
            pg8::Gemm g{WSP(bf16, WS_MB), WSP(bf16, WS_WOUT) + (size_t)l * DM * DM, MP, DM, DM}; pg8::StaticOrder S; S.init(MP, DM, F.G, (int)blockIdx.x);
            pg8::EpiResid<false> E{WSP(bf16, WS_XB), args->out, WSP(float, WS_SSQD), M};
            pg8::gemm_phase<pg8::EpiResid<false>, pg8::StaticOrder, true, true>(F.lds + RING_OFF, g, S, E);
            Frame F2 = F; asm volatile("" : "+v"(F2.tid), "+v"(F2.lane));
            for (int tile = F.vcu; tile < 256; tile += F.G)
                tail_gemm_resid<DM, false>(F2, WSP(bf16, WS_MB) + (size_t)MP * DM, WSP(bf16, WS_WOUT) + (size_t)l * DM * DM, WSP(bf16, WS_XB) + (size_t)MP * DM, args->out + (size_t)MP * DM, WSP(float, WS_SSQD) + MP, tile);
        }
        BAR_STAMP(4 + 5 * l_);
        {   PHASE_ARGS(); LAYER();
            pg8::Gemm g{WSP(bf16, WS_XB), WSP(bf16, WS_WGU) + (size_t)l * NGU * DM, M, NGU, DM}; pg8::StaticOrder S; S.init(M, NGU, F.G, (int)blockIdx.x);
            pg8::EpiSwiGLU E{WSP(bf16, WS_HB), DFF, WSP(float, WS_SSQD), 16, M};
            for (int rep_ = 0; rep_ < REP_D; ++rep_) pg8::gemm_phase<pg8::EpiSwiGLU, pg8::StaticOrder, true, true>(F.lds + RING_OFF, g, S, E);
            const int full = ((M / 256) * (NGU / 256)) % F.G;
            if ((int)blockIdx.x >= full) { Frame F2 = F; asm volatile("" : "+v"(F2.tid), "+v"(F2.lane));
                if (l + 1 < NLAYER) cvt_range(args, l + 1, CI_IN, CI_G, ((int)blockIdx.x - full) * NWAVES + F2.wave, (F.G - full) * NWAVES, F2.lane);
                else for (int ll = 0; ll < NLAYER; ++ll) cache_copy(args, ll, ((int)blockIdx.x - full) * NWAVES + F2.wave, (F.G - full) * NWAVES, F2.lane, 1, 2); }
        }
        BAR_STAMP(5 + 5 * l_);
        {   PHASE_ARGS(); LAYER();
            pg8::Gemm g{WSP(bf16, WS_HB), WSP(bf16, WS_WDN) + (size_t)l * DM * DFF, MP, DM, DFF}; pg8::StaticOrder S; S.init(MP, DM, F.G, (int)blockIdx.x);
            pg8::EpiResid<false> E{WSP(bf16, WS_XB), args->out, WSP(float, WS_SSQA), M};
            pg8::gemm_phase<pg8::EpiResid<false>, pg8::StaticOrder, true, true>(F.lds + RING_OFF, g, S, E);
            Frame F2 = F; asm volatile("" : "+v"(F2.tid), "+v"(F2.lane));
            for (int tile = F.vcu; tile < 256; tile += F.G)
                tail_gemm_resid<DFF, false>(F2, WSP(bf16, WS_HB) + (size_t)MP * DFF, WSP(bf16, WS_WDN) + (size_t)l * DM * DFF, WSP(bf16, WS_XB) + (size_t)MP * DM, args->out + (size_t)MP * DM, WSP(float, WS_SSQA) + MP, tile);
        }
        BAR_STAMP(6 + 5 * l_);
    }
    for (int rep_ = 0; rep_ < REP_BAR; ++rep_) GRID_BAR();
    { PHASE_ARGS(); phase_final(F, args); }
#if PROBE_TS
    if (PROBE_PH == 6 && blockIdx.x == 0) { __syncthreads(); if (F.tid == 0) { const unsigned long long now_ = __builtin_amdgcn_s_memrealtime(); const unsigned long long t0_ = ((unsigned long long)F.MISC[17] << 32) | F.MISC[16]; const unsigned long long d_ = now_ - t0_; while (__builtin_amdgcn_s_memrealtime() < now_ + 4 * d_) __builtin_amdgcn_s_sleep(20); } }
#endif
}

extern "C" void kernel_launch(void* const* d_in, const int* in_sizes, int n_in, void* d_out, int out_size, void* d_ws, size_t ws_size, hipStream_t stream) {
    static int grid = 0;
    if (grid == 0) {
        if (n_in != 17 || (size_t)out_size != OUT_END || ws_size < WS_END) { fprintf(stderr, "kernel_launch: unexpected shapes: n_in %d out %d ws %zu\n", n_in, out_size, ws_size); grid = -1; return; }
        int dev = 0, cus = 0, per_cu = 0;
        if (hipGetDevice(&dev) != hipSuccess || hipDeviceGetAttribute(&cus, hipDeviceAttributeMultiprocessorCount, dev) != hipSuccess) { grid = -1; return; }
        if (hipFuncSetAttribute((const void*)mega_fwd, hipFuncAttributeMaxDynamicSharedMemorySize, LDS_BYTES) != hipSuccess) { fprintf(stderr, "kernel_launch: hipFuncSetAttribute failed\n"); grid = -1; return; }
        if (hipOccupancyMaxActiveBlocksPerMultiprocessor(&per_cu, (const void*)mega_fwd, NWAVES * 64, LDS_BYTES) != hipSuccess || per_cu < 1) { fprintf(stderr, "kernel_launch: occupancy query says %d blocks per CU\n", per_cu); grid = -1; (void)hipGetLastError(); return; }
        grid = cus;
        if (grid > 256) grid = 256;
        grid &= ~7;
    }
    if (grid <= 0) return;
    if (hipMemsetAsync((char*)d_ws + WS_CTL, 0, CTL_ZERO_BYTES, stream) != hipSuccess) return;
    Args a{};
    for (int i = 0; i < 17; ++i) a.in[i] = (const float*)d_in[i];
    a.out = (float*)d_out; a.ws = (unsigned char*)d_ws;
    hipLaunchKernelGGL(mega_fwd, dim3(grid), dim3(NWAVES * 64), LDS_BYTES, stream, a);
}
```

```cpp
#include <hip/hip_runtime.h>
#include <cstdio>
#include <cstdint>
namespace pg8 {
#define PG8_LAS __attribute__((address_space(3)))
typedef unsigned short bf16_t;
typedef short bf16x8 __attribute__((ext_vector_type(8)));
typedef float f32x4 __attribute__((ext_vector_type(4)));
typedef unsigned u32x4 __attribute__((ext_vector_type(4)));
constexpr int BM = 256, BK = 64, HALF = 128, HTB = HALF * BK * 2  , STAGE_BYTES = 8 * HTB, NXCD = 8, WGM = 8;

__host__ __device__ __forceinline__ int lds_byte(int r, int c) { const int st = (r >> 4) * 2 + (c >> 5), rr = r & 15, cc = c & 31, ob = rr * 64 + cc * 2; return st * 1024 + (ob ^ (((ob >> 9) & 1) << 5)); }
__host__ __device__ __forceinline__ void stage_rc(int b, int& R, int& C) { const int st = b / 1024, sb = b % 1024, swz = sb ^ (((sb >> 9) & 1) << 5); R = (st >> 1) * 16 + swz / 64; C = (st & 1) * 32 + (swz % 64) / 2; }
__host__ __device__ __forceinline__ int perm32(int rho) { const int n = rho >> 4, i = rho & 15; return 8 * (i >> 2) + 4 * n + (i & 3); }

struct Unit { int pm, pn; };
struct Gemm { const bf16_t* A; const bf16_t* Bt; int M, N, K; };

struct StaticOrder {
    int nM, nN, nwg, G, c; bool rev;
    __host__ __device__ void init(int M, int N, int G_, int c_, bool rev_ = false) { nM = M / BM; nN = N / BM; nwg = nM * nN; G = G_; c = c_; rev = rev_; }
    __host__ __device__ bool next(int i, Unit& u) const {
        const long L = (long)i * G + c; if (L >= nwg) return false;
        int wgid = rev ? nwg - 1 - (int)L : (int)L;
        const int nig = WGM * nN, gid = wgid / nig, fm = gid * WGM, gsz = (nM - fm) < WGM ? (nM - fm) : WGM;
        u.pm = fm + ((wgid % nig) % gsz); u.pn = (wgid % nig) / gsz; return true;
    }
    __device__ __forceinline__ void a_ready(const Unit&) const {}
    __device__ __forceinline__ void done(const Unit&) const {}
};

typedef float f32x2_t __attribute__((ext_vector_type(2))); typedef __bf16 bf16x2_t __attribute__((ext_vector_type(2)));
__device__ __forceinline__ unsigned cvt_pk_bf16(float lo, float hi) { const f32x2_t v = {lo, hi}; const bf16x2_t b = __builtin_convertvector(v, bf16x2_t); return __builtin_bit_cast(unsigned, b); }
template <int OFF> __device__ __forceinline__ void store16_wt(void* p, u32x4 v) { asm volatile("global_store_dwordx4 %0, %1, off offset:%2 sc1\n\ts_nop 1" :: "v"(p), "v"(v), "i"(OFF) : "memory"); }
constexpr int SSQ_SLOTS = 16;
constexpr float RMS_EPS = 1e-6f;
struct RstdState { float rs[2]; };
__device__ __forceinline__ void rstd_issue(const float* ssq, int nslots, int mrows, int pm, int wr, int lane, float (&v)[2][16]) {
    if (nslots == 16) {
#pragma unroll
        for (int ai = 0; ai < 2; ++ai) { const float* p = ssq + (size_t)(pm * BM + ai * HALF + wr * 64 + lane);
#pragma unroll
            for (int k = 0; k < 16; ++k) v[ai][k] = p[(size_t)k * mrows]; }
    } else {
#pragma unroll
        for (int ai = 0; ai < 2; ++ai) { v[ai][0] = ssq[(size_t)(pm * BM + ai * HALF + wr * 64 + lane)];
#pragma unroll
            for (int k = 1; k < 16; ++k) v[ai][k] = 0.f; }
    }
}
__device__ __forceinline__ void rstd_finish(const float (&v)[2][16], float (&rs)[2]) {
#pragma unroll
    for (int ai = 0; ai < 2; ++ai) { float s = 0.f;
#pragma unroll
        for (int k = 0; k < 16; ++k) s += v[ai][k];
        rs[ai] = rsqrtf(s * (1.0f / 1024.0f) + RMS_EPS); }
}
struct EpiScaleBf16 {
    static constexpr bool PERM = true, AFTER_DRAIN = false;
    typedef RstdState State;
    bf16_t* O; int ldc; const float* ssq; int nslots, mrows;
    __device__ __forceinline__ void init(State& st, const Unit& u, int wr, int lane) const { float v[2][16]; rstd_issue(ssq, nslots, mrows, u.pm, wr, lane, v); rstd_finish(v, st.rs); asm volatile("" : "+v"(st.rs[0]), "+v"(st.rs[1])); }
    __device__ __forceinline__ void acc_init(f32x4 (&)[2][2][4][2], const Unit&, int, int, int, int) const {}
    __device__ __forceinline__ void operator()(const f32x4 (&acc)[2][2][4][2], const Unit& u, int wr, int wc, int fr, int fq, State& st, bool has_next, const Unit& nxt) const {
        float v[2][16]; rstd_issue(ssq, nslots, mrows, has_next ? nxt.pm : u.pm, wr, fq * 16 + fr, v);
        const int row0 = u.pm * BM + wr * 64 + fr;
        if (u.pn < 5) {
            const int col0 = u.pn * BM + wc * 32 + 8 * fq;
#pragma unroll
            for (int ai = 0; ai < 2; ++ai)
#pragma unroll
                for (int m = 0; m < 4; ++m) { const float sc = __shfl(st.rs[ai], 16 * m + fr); bf16_t* rowp = O + (size_t)(row0 + ai * HALF + m * 16) * ldc + col0;
#pragma unroll
                    for (int bj = 0; bj < 2; ++bj) { const f32x4 v0 = acc[ai][bj][m][0] * sc, v1 = acc[ai][bj][m][1] * sc;
                        u32x4 w; w.x = cvt_pk_bf16(v0[0], v0[1]); w.y = cvt_pk_bf16(v0[2], v0[3]); w.z = cvt_pk_bf16(v1[0], v1[1]); w.w = cvt_pk_bf16(v1[2], v1[3]);
                        if (bj == 0) store16_wt<0>(rowp, w); else store16_wt<HALF * 2>(rowp, w); } }
        } else {
            const int col0 = 1280 + (u.pn - 5) * HALF + wc * 32 + 8 * fq;
#pragma unroll
            for (int ai = 0; ai < 2; ++ai)
#pragma unroll
                for (int m = 0; m < 4; ++m) { const float sc = __shfl(st.rs[ai], 16 * m + fr), s2 = sc * sc; bf16_t* rowp = O + (size_t)(row0 + ai * HALF + m * 16) * ldc + col0;
                    const f32x4 v0 = acc[ai][0][m][0] * acc[ai][1][m][0] * s2, v1 = acc[ai][0][m][1] * acc[ai][1][m][1] * s2;
                    u32x4 w; w.x = cvt_pk_bf16(v0[0], v0[1]); w.y = cvt_pk_bf16(v0[2], v0[3]); w.z = cvt_pk_bf16(v1[0], v1[1]); w.w = cvt_pk_bf16(v1[2], v1[3]);
                    store16_wt<0>(rowp, w); }
        }
        { rstd_finish(v, st.rs); asm volatile("" : "+v"(st.rs[0]), "+v"(st.rs[1])); }
    }
};
struct EpiSwiGLU {
    static constexpr bool PERM = true, AFTER_DRAIN = false;
    typedef RstdState State;
    bf16_t* O; int ldc; const float* ssq; int nslots, mrows;
    __device__ __forceinline__ void init(State& st, const Unit& u, int wr, int lane) const { float v[2][16]; rstd_issue(ssq, nslots, mrows, u.pm, wr, lane, v); rstd_finish(v, st.rs); asm volatile("" : "+v"(st.rs[0]), "+v"(st.rs[1])); }
    __device__ __forceinline__ void acc_init(f32x4 (&)[2][2][4][2], const Unit&, int, int, int, int) const {}
    __device__ __forceinline__ void operator()(const f32x4 (&acc)[2][2][4][2], const Unit& u, int wr, int wc, int fr, int fq, State& st, bool has_next, const Unit& nxt) const {
        float v[2][16]; rstd_issue(ssq, nslots, mrows, has_next ? nxt.pm : u.pm, wr, fq * 16 + fr, v);
        const int row0 = u.pm * BM + wr * 64 + fr, col0 = u.pn * HALF + wc * 32 + 8 * fq;
#pragma unroll
        for (int ai = 0; ai < 2; ++ai)
#pragma unroll
            for (int m = 0; m < 4; ++m) { const float sc = __shfl(st.rs[ai], 16 * m + fr); bf16_t* rowp = O + (size_t)(row0 + ai * HALF + m * 16) * ldc + col0;
                const float k1 = -sc * 1.4426950408889634f, s2 = sc * sc;
                f32x4 hv[2];
#pragma unroll
                for (int n = 0; n < 2; ++n) { const f32x4 ag = acc[ai][0][m][n], au = acc[ai][1][m][n], t = ag * k1; f32x4 r;
#pragma unroll
                    for (int i = 0; i < 4; ++i) r[i] = __builtin_amdgcn_rcpf(1.0f + __builtin_amdgcn_exp2f(t[i]));
                    hv[n] = (ag * au) * (r * s2); }
                u32x4 w; w.x = cvt_pk_bf16(hv[0][0], hv[0][1]); w.y = cvt_pk_bf16(hv[0][2], hv[0][3]); w.z = cvt_pk_bf16(hv[1][0], hv[1][1]); w.w = cvt_pk_bf16(hv[1][2], hv[1][3]);
                store16_wt<0>(rowp, w); }
        { rstd_finish(v, st.rs); asm volatile("" : "+v"(st.rs[0]), "+v"(st.rs[1])); }
    }
};
__device__ __forceinline__ float bf_lo(unsigned w) { return __uint_as_float(w << 16); }
__device__ __forceinline__ float bf_hi(unsigned w) { return __uint_as_float(w & 0xffff0000u); }
template <bool LAST> struct EpiResid {
    static constexpr bool PERM = true, AFTER_DRAIN = false;
    struct State {};
    bf16_t* xb; float* out; float* ssq_out; int mrows;
    __device__ __forceinline__ void init(State&, const Unit&, int, int) const {}
    __device__ __forceinline__ void acc_init(f32x4 (&acc)[2][2][4][2], const Unit& u, int wr, int wc, int fr, int fq) const {
        const int lrow0 = wr * 64 + fr, col0 = u.pn * BM + wc * 32 + 8 * fq;
        u32x4 b[2][4][2];
#pragma unroll
        for (int ai = 0; ai < 2; ++ai)
#pragma unroll
            for (int m = 0; m < 4; ++m)
#pragma unroll
                for (int bj = 0; bj < 2; ++bj) b[ai][m][bj] = *(const u32x4*)(xb + ((size_t)u.pm * BM + lrow0 + ai * HALF + m * 16) * 1024 + col0 + bj * HALF);
#pragma unroll
        for (int ai = 0; ai < 2; ++ai)
#pragma unroll
            for (int m = 0; m < 4; ++m)
#pragma unroll
                for (int bj = 0; bj < 2; ++bj) { const u32x4 w = b[ai][m][bj];
                    acc[ai][bj][m][0] = (f32x4){bf_lo(w.x), bf_hi(w.x), bf_lo(w.y), bf_hi(w.y)}; acc[ai][bj][m][1] = (f32x4){bf_lo(w.z), bf_hi(w.z), bf_lo(w.w), bf_hi(w.w)}; }
    }
    __device__ __forceinline__ void operator()(const f32x4 (&acc)[2][2][4][2], const Unit& u, int wr, int wc, int fr, int fq, State&, bool, const Unit&) const {
        const int lrow0 = wr * 64 + fr, col0 = u.pn * BM + wc * 32 + 8 * fq;
#pragma unroll
        for (int ai = 0; ai < 2; ++ai)
#pragma unroll
            for (int m = 0; m < 4; ++m) { const size_t grow = (size_t)u.pm * BM + lrow0 + ai * HALF + m * 16; float q = 0.f;
#pragma unroll
                for (int bj = 0; bj < 2; ++bj) { const f32x4 v0 = acc[ai][bj][m][0], v1 = acc[ai][bj][m][1];
                    if (LAST) { float* op = out + grow * 1024 + col0 + bj * HALF; *(f32x4*)op = v0; *(f32x4*)(op + 4) = v1; }
                    else { u32x4 w; w.x = cvt_pk_bf16(v0[0], v0[1]); w.y = cvt_pk_bf16(v0[2], v0[3]); w.z = cvt_pk_bf16(v1[0], v1[1]); w.w = cvt_pk_bf16(v1[2], v1[3]); if (bj == 0) store16_wt<0>(xb + grow * 1024 + col0, w); else store16_wt<HALF * 2>(xb + grow * 1024 + col0, w); }
                    q += ((v0[0] * v0[0] + v0[1] * v0[1]) + (v0[2] * v0[2] + v0[3] * v0[3])) + ((v1[0] * v1[0] + v1[1] * v1[1]) + (v1[2] * v1[2] + v1[3] * v1[3])); }
                q += __shfl_xor(q, 16); q += __shfl_xor(q, 32);
                if (fq == 0) ssq_out[(size_t)(u.pn * 4 + wc) * mrows + grow] = q; }
    }
};

template <int K> struct EpiResidTail {
    static constexpr bool PERM = true, AFTER_DRAIN = true;
    struct State {};
    bf16_t* xb; float* ssq_out; int mrows;
    const bf16_t* As; const bf16_t* Bt; int tile;
    bf16_t* xbs; float* ssq_rows;
    __device__ __forceinline__ void init(State&, const Unit&, int, int) const {}
    __device__ __forceinline__ void acc_init(f32x4 (&acc)[2][2][4][2], const Unit& u, int wr, int wc, int fr, int fq) const {
        const int lrow0 = wr * 64 + fr, col0 = u.pn * BM + wc * 32 + 8 * fq;
        u32x4 b[2][4][2];
#pragma unroll
        for (int ai = 0; ai < 2; ++ai)
#pragma unroll
            for (int m = 0; m < 4; ++m)
#pragma unroll
                for (int bj = 0; bj < 2; ++bj) b[ai][m][bj] = *(const u32x4*)(xb + ((size_t)u.pm * BM + lrow0 + ai * HALF + m * 16) * 1024 + col0 + bj * HALF);
#pragma unroll
        for (int ai = 0; ai < 2; ++ai)
#pragma unroll
            for (int m = 0; m < 4; ++m)
#pragma unroll
                for (int bj = 0; bj < 2; ++bj) { const u32x4 w = b[ai][m][bj];
                    acc[ai][bj][m][0] = (f32x4){bf_lo(w.x), bf_hi(w.x), bf_lo(w.y), bf_hi(w.y)}; acc[ai][bj][m][1] = (f32x4){bf_lo(w.z), bf_hi(w.z), bf_lo(w.w), bf_hi(w.w)}; }
    }
    __device__ __forceinline__ void main_group(const f32x4 (&acc)[2][2][4][2], const Unit& u, int g, int wr, int wc, int fr, int fq) const {
        const int ai = g >> 2, m = g & 3;
        const size_t grow = (size_t)u.pm * BM + wr * 64 + fr + ai * HALF + m * 16; const int col0 = u.pn * BM + wc * 32 + 8 * fq; float q = 0.f;
#pragma unroll
        for (int bj = 0; bj < 2; ++bj) { const f32x4 v0 = acc[ai][bj][m][0], v1 = acc[ai][bj][m][1];
            u32x4 w; w.x = cvt_pk_bf16(v0[0], v0[1]); w.y = cvt_pk_bf16(v0[2], v0[3]); w.z = cvt_pk_bf16(v1[0], v1[1]); w.w = cvt_pk_bf16(v1[2], v1[3]);
            if (bj == 0) store16_wt<0>(xb + grow * 1024 + col0, w); else store16_wt<HALF * 2>(xb + grow * 1024 + col0, w);
            q += ((v0[0] * v0[0] + v0[1] * v0[1]) + (v0[2] * v0[2] + v0[3] * v0[3])) + ((v1[0] * v1[0] + v1[1] * v1[1]) + (v1[2] * v1[2] + v1[3] * v1[3])); }
        q += __shfl_xor(q, 16); q += __shfl_xor(q, 32);
        if (fq == 0) ssq_out[(size_t)(u.pn * 4 + wc) * mrows + grow] = q;
    }
    __device__ __forceinline__ void fused(f32x4 (&acc)[2][2][4][2], const Unit& u, int wr, int wc, int fr, int fq, PG8_LAS unsigned char* lds, int wave, int lane) const {
        const int tid = wave * 64 + lane; PG8_LAS float* red = (PG8_LAS float*)lds;
        const int row0 = (tile >> 4) * 32, col0t = (tile & 15) * 64, tc = tile & 15;
        constexpr int KW = K / 8, STEPS = KW / 32; static_assert(KW % 32 == 0, "K split");
        constexpr int GPS = (8 + STEPS - 1) / STEPS;
        f32x4 at[2][4];
#pragma unroll
        for (int m = 0; m < 2; ++m)
#pragma unroll
            for (int n = 0; n < 4; ++n) at[m][n] = (f32x4){0.f, 0.f, 0.f, 0.f};
        const bf16_t* ap = As + (size_t)(row0 + fr) * K + wave * KW + 8 * fq;
        const bf16_t* bp = Bt + (size_t)(col0t + fr) * K + wave * KW + 8 * fq;
        bf16x8 a[2][2], b[2][4];
#pragma unroll
        for (int m = 0; m < 2; ++m) a[0][m] = *(const bf16x8*)(ap + (size_t)(16 * m) * K);
#pragma unroll
        for (int n = 0; n < 4; ++n) b[0][n] = *(const bf16x8*)(bp + (size_t)(16 * n) * K);
#pragma unroll
        for (int s = 0; s < STEPS; ++s) {
            if (s + 1 < STEPS) {
#pragma unroll
                for (int m = 0; m < 2; ++m) a[(s + 1) & 1][m] = *(const bf16x8*)(ap + (size_t)(16 * m) * K + 32 * (s + 1));
#pragma unroll
                for (int n = 0; n < 4; ++n) b[(s + 1) & 1][n] = *(const bf16x8*)(bp + (size_t)(16 * n) * K + 32 * (s + 1));
            }
#pragma unroll
            for (int gg = 0; gg < GPS; ++gg) if (s * GPS + gg < 8) main_group(acc, u, s * GPS + gg, wr, wc, fr, fq);
#pragma unroll
            for (int m = 0; m < 2; ++m)
#pragma unroll
                for (int n = 0; n < 4; ++n) at[m][n] = __builtin_amdgcn_mfma_f32_16x16x32_bf16(b[s & 1][n], a[s & 1][m], at[m][n], 0, 0, 0);
        }
#pragma unroll
        for (int m = 0; m < 2; ++m)
#pragma unroll
            for (int n = 0; n < 4; ++n) *(PG8_LAS f32x4*)(red + ((wave * 32 + 16 * m + fr) * 64 + 16 * n + 4 * fq)) = at[m][n];
        asm volatile("s_waitcnt lgkmcnt(0)" ::: "memory"); __builtin_amdgcn_s_barrier(); asm volatile("" ::: "memory");
        const int r = tid >> 4, c4 = (tid & 15) * 4;
        bf16_t* xp = xbs + (size_t)(row0 + r) * 1024 + col0t + c4;
        const unsigned long long bw = *(const unsigned long long*)xp;
        f32x4 v = (f32x4){bf_lo((unsigned)bw), bf_hi((unsigned)bw), bf_lo((unsigned)(bw >> 32)), bf_hi((unsigned)(bw >> 32))};
#pragma unroll
        for (int w = 0; w < 8; ++w) v += *(const PG8_LAS f32x4*)(red + ((w * 32 + r) * 64 + c4));
        *(unsigned long long*)xp = (unsigned long long)cvt_pk_bf16(v[0], v[1]) | ((unsigned long long)cvt_pk_bf16(v[2], v[3]) << 32);
        float q = (v[0] * v[0] + v[1] * v[1]) + (v[2] * v[2] + v[3] * v[3]);
        q += __shfl_xor(q, 1); q += __shfl_xor(q, 2); q += __shfl_xor(q, 4); q += __shfl_xor(q, 8);
        if ((tid & 15) == 0) ssq_rows[(size_t)tc * mrows + row0 + r] = q;
    }
};
template <class Epi, class Sched, bool ALIGN_EPI = false, bool SP2 = false>
__device__ __forceinline__ void gemm_phase(PG8_LAS unsigned char* lds, const Gemm g, const Sched& S, const Epi& E) {
    int tid_ = threadIdx.x; asm volatile("" : "+v"(tid_));
    const int tid = tid_, wid = __builtin_amdgcn_readfirstlane(tid >> 6), lane = tid & 63, wr = wid >> 2, wc = wid & 3, fr = lane & 15, fq = lane >> 4;
    const int K = g.K, nt = K / BK;
    unsigned voffA[2], voffB[2];
#pragma unroll
    for (int i = 0; i < 2; ++i) { int R, C; stage_rc(tid * 16 + i * 8192, R, C); const int Rb = Epi::PERM ? ((R & ~31) + perm32(R & 31)) : R;
        voffA[i] = (unsigned)(R * K + C) * 2u; voffB[i] = (unsigned)(Rb * K + C) * 2u; }
    const size_t kstep = (size_t)(BK * 2);
    const size_t hstep = (size_t)HALF * K * 2;
    const size_t tstep = 2 * hstep;
    const unsigned ldsw = (unsigned)wid * 1024u;
    const int aoff = lds_byte(wr * 64 + fr, fq * 8), boff = lds_byte(wc * 32 + fr, fq * 8);
#define PG8_SA(b, h) (((b) * 2 + (h)) * HTB)
#define PG8_SB(b, h) ((4 + (b) * 2 + (h)) * HTB)
#define PG8_STAGE(bufoff, gbase, voff) do { _Pragma("unroll") for (int _i = 0; _i < 2; ++_i) \
        __builtin_amdgcn_global_load_lds((const unsigned*)((const char*)(gbase) + (voff)[_i]), (PG8_LAS unsigned*)(lds + (bufoff) + ldsw + _i * 8192), 16, 0, 0); } while (0)
#define PG8_LDA(dst, b, h) do { _Pragma("unroll") for (int m = 0; m < 4; ++m) _Pragma("unroll") for (int k = 0; k < 2; ++k) dst[m][k] = *(const PG8_LAS bf16x8*)(lds + PG8_SA(b, h) + aoff + m * 2048 + k * 1024); } while (0)
#define PG8_LDB(dst, b, h) do { _Pragma("unroll") for (int n = 0; n < 2; ++n) _Pragma("unroll") for (int k = 0; k < 2; ++k) dst[n][k] = *(const PG8_LAS bf16x8*)(lds + PG8_SB(b, h) + boff + n * 2048 + k * 1024); } while (0)
#define PG8_MMA(ai, bj, At, Bt) do { __builtin_amdgcn_s_setprio(1); _Pragma("unroll") for (int m = 0; m < 4; ++m) _Pragma("unroll") for (int n = 0; n < 2; ++n) _Pragma("unroll") for (int k = 0; k < 2; ++k) \
        acc[ai][bj][m][n] = __builtin_amdgcn_mfma_f32_16x16x32_bf16(Bt[n][k], At[m][k], acc[ai][bj][m][n], 0, 0, 0); __builtin_amdgcn_s_setprio(0); } while (0)
#define PG8_WAIT_V(n) asm volatile("s_waitcnt vmcnt(" #n ")" ::: "memory")
#define PG8_WAIT_L(n) asm volatile("s_waitcnt lgkmcnt(" #n ")" ::: "memory")
#define PG8_BAR __builtin_amdgcn_s_barrier()
#define PG8_SCHED __builtin_amdgcn_sched_barrier(0)
    Unit cur, nxt; int ui = 0;
    if (!S.next(0, cur)) return;
    f32x4 acc[2][2][4][2];
#pragma unroll
    for (int a = 0; a < 2; ++a)
#pragma unroll
        for (int b = 0; b < 2; ++b)
#pragma unroll
            for (int m = 0; m < 4; ++m)
#pragma unroll
                for (int n = 0; n < 2; ++n) acc[a][b][m][n] = (f32x4){0.f, 0.f, 0.f, 0.f};
    bf16x8 At[4][2], B0[2][2], B1[2][2];
    const char* cA = (const char*)g.A + (size_t)cur.pm * tstep; const char* cB = (const char*)g.Bt + (size_t)cur.pn * tstep;
    S.a_ready(cur);
    typename Epi::State est;
    if constexpr (SP2) {
        PG8_STAGE(PG8_SB(0, 0), cB, voffB); PG8_STAGE(PG8_SB(0, 1), cB + hstep, voffB); PG8_STAGE(PG8_SA(0, 0), cA, voffA); PG8_STAGE(PG8_SA(0, 1), cA + hstep, voffA);
        E.init(est, cur, wr, lane); E.acc_init(acc, cur, wr, wc, fr, fq);
        if (wr == 1) PG8_BAR;
        PG8_WAIT_V(2); PG8_BAR;
        PG8_STAGE(PG8_SB(1, 0), cB + kstep, voffB); PG8_STAGE(PG8_SA(1, 0), cA + kstep, voffA); PG8_STAGE(PG8_SB(1, 1), cB + hstep + kstep, voffB);
        PG8_WAIT_V(6); PG8_BAR;
    } else {
        PG8_STAGE(PG8_SB(0, 0), cB, voffB); PG8_STAGE(PG8_SA(0, 0), cA, voffA); PG8_STAGE(PG8_SB(0, 1), cB + hstep, voffB); PG8_STAGE(PG8_SA(0, 1), cA + hstep, voffA);
        E.init(est, cur, wr, lane); E.acc_init(acc, cur, wr, wc, fr, fq);
        if (wr == 1) PG8_BAR;
        PG8_WAIT_V(4); PG8_BAR;
        PG8_STAGE(PG8_SB(1, 0), cB + kstep, voffB); PG8_STAGE(PG8_SA(1, 0), cA + kstep, voffA); PG8_STAGE(PG8_SB(1, 1), cB + hstep + kstep, voffB);
        PG8_WAIT_V(6); PG8_BAR;
    }
    for (;;) {
        const bool has_next = S.next(ui + 1, nxt);
        const char* nA = has_next ? (const char*)g.A + (size_t)nxt.pm * tstep : cA; const char* nB = has_next ? (const char*)g.Bt + (size_t)nxt.pn * tstep : cB;
        for (int t = 0; t < nt; t += 2) {
            const bool last = (t == nt - 2);
            const char* a1 = cA + (size_t)(t + 1) * kstep;
            const char* a2 = last ? nA : cA + (size_t)(t + 2) * kstep; const char* b2 = last ? nB : cB + (size_t)(t + 2) * kstep;
            const char* a3 = a2 + kstep; const char* b3 = b2 + kstep;
            if (last && has_next) S.a_ready(nxt);
            if constexpr (SP2) {
            PG8_LDB(B0, 0, 0); PG8_LDB(B1, 0, 1); PG8_SCHED; PG8_LDA(At, 0, 0); PG8_STAGE(PG8_SA(1, 1), a1 + hstep, voffA);
            PG8_WAIT_V(8); PG8_WAIT_L(0); PG8_BAR; PG8_MMA(0, 0, At, B0); PG8_MMA(0, 1, At, B1); PG8_BAR; PG8_SCHED;
            PG8_LDA(At, 0, 1); PG8_STAGE(PG8_SB(0, 0), b2, voffB); PG8_STAGE(PG8_SB(0, 1), b2 + hstep, voffB); PG8_STAGE(PG8_SA(0, 0), a2, voffA);
            PG8_WAIT_V(8); PG8_WAIT_L(0); PG8_BAR; PG8_MMA(1, 0, At, B0); PG8_MMA(1, 1, At, B1); PG8_BAR; PG8_SCHED;
            PG8_LDB(B0, 1, 0); PG8_LDB(B1, 1, 1); PG8_SCHED; PG8_LDA(At, 1, 0); PG8_STAGE(PG8_SA(0, 1), a2 + hstep, voffA);
            PG8_WAIT_V(8); PG8_WAIT_L(0); PG8_BAR; PG8_MMA(0, 0, At, B0); PG8_MMA(0, 1, At, B1); PG8_BAR; PG8_SCHED;
            PG8_LDA(At, 1, 1); PG8_STAGE(PG8_SB(1, 0), b3, voffB); PG8_STAGE(PG8_SB(1, 1), b3 + hstep, voffB); PG8_STAGE(PG8_SA(1, 0), a3, voffA);
            PG8_WAIT_V(8); PG8_WAIT_L(0); PG8_BAR; PG8_MMA(1, 0, At, B0); PG8_MMA(1, 1, At, B1); PG8_BAR; PG8_SCHED;
            } else {
            PG8_LDB(B0, 0, 0); PG8_SCHED; PG8_LDA(At, 0, 0); PG8_STAGE(PG8_SA(1, 1), a1 + hstep, voffA);
            PG8_WAIT_L(8); PG8_BAR; PG8_WAIT_L(0); PG8_MMA(0, 0, At, B0); PG8_BAR; PG8_SCHED;
            PG8_LDB(B1, 0, 1); PG8_STAGE(PG8_SB(0, 0), b2, voffB);
            PG8_BAR; PG8_WAIT_L(0); PG8_MMA(0, 1, At, B1); PG8_BAR;
            PG8_LDA(At, 0, 1); PG8_STAGE(PG8_SA(0, 0), a2, voffA);
            PG8_BAR; PG8_WAIT_L(0); PG8_MMA(1, 0, At, B0); PG8_BAR; PG8_SCHED;
            PG8_STAGE(PG8_SB(0, 1), b2 + hstep, voffB);
            PG8_WAIT_V(6); PG8_BAR; PG8_MMA(1, 1, At, B1); PG8_BAR;
            PG8_LDB(B0, 1, 0); PG8_SCHED; PG8_LDA(At, 1, 0); PG8_STAGE(PG8_SA(0, 1), a2 + hstep, voffA);
            PG8_WAIT_L(8); PG8_BAR; PG8_WAIT_L(0); PG8_MMA(0, 0, At, B0); PG8_BAR; PG8_SCHED;
            PG8_LDB(B1, 1, 1); PG8_STAGE(PG8_SB(1, 0), b3, voffB);
            PG8_BAR; PG8_WAIT_L(0); PG8_MMA(0, 1, At, B1); PG8_BAR;
            PG8_LDA(At, 1, 1); PG8_STAGE(PG8_SA(1, 0), a3, voffA);
            PG8_BAR; PG8_WAIT_L(0); PG8_MMA(1, 0, At, B0); PG8_BAR; PG8_SCHED;
            PG8_STAGE(PG8_SB(1, 1), b3 + hstep, voffB);
            PG8_WAIT_V(6); PG8_BAR; PG8_MMA(1, 1, At, B1); PG8_BAR;
            }
        }
        if constexpr (ALIGN_EPI) { if (wr == 0) PG8_BAR; }
        if constexpr (!Epi::AFTER_DRAIN) { E(acc, cur, wr, wc, fr, fq, est, has_next, nxt); S.done(cur); }
        if (!has_next) break;
#pragma unroll
        for (int a = 0; a < 2; ++a)
#pragma unroll
            for (int b = 0; b < 2; ++b)
#pragma unroll
                for (int m = 0; m < 4; ++m)
#pragma unroll
                    for (int n = 0; n < 2; ++n) acc[a][b][m][n] = (f32x4){0.f, 0.f, 0.f, 0.f};
        cur = nxt; cA = nA; cB = nB; ++ui;
        E.acc_init(acc, cur, wr, wc, fr, fq);
        if constexpr (ALIGN_EPI) { if (wr == 1) PG8_BAR; }
    }
    PG8_WAIT_V(0);
    if constexpr (!ALIGN_EPI) { if (wr == 0) PG8_BAR; }
    PG8_BAR;
    if constexpr (Epi::AFTER_DRAIN) { E.fused(acc, cur, wr, wc, fr, fq, lds, wid, lane); S.done(cur); }
#undef PG8_SA
#undef PG8_SB
#undef PG8_STAGE
#undef PG8_LDA
#undef PG8_LDB
#undef PG8_MMA
#undef PG8_WAIT_V
#undef PG8_WAIT_L
#undef PG8_BAR
#undef PG8_SCHED
}
}

#ifndef PROBE_TS
#define PROBE_TS 0
#endif
#ifndef PROBE_PH
#define PROBE_PH 0
#endif
constexpr int NWAVES = 8;
constexpr int DM = 1024, SEQ = 8192, NBATCH = 2, DBATCH = 128, DT = 4, MP = NBATCH * SEQ, MS = DBATCH * DT, M = MP + MS;
constexpr int NIN = 2304, DFF = 2816, NGU = 2 * DFF, WIN = 128, NLAYER = 2;
constexpr int ZP = 1792;
constexpr int ZQ = 0, ZK = 512, ZV = 640, ZGB = 768, ZCU = 1280;
constexpr float ATT_SCALE = 0.125f, EPS = 1e-6f;
constexpr size_t OUT_Y = 0, OUT_NKP = (size_t)M * DM, OUT_NVP = OUT_NKP + (size_t)NLAYER * NBATCH * WIN * 128, OUT_NCP = OUT_NVP + (size_t)NLAYER * NBATCH * WIN * 128,
                 OUT_NKS = OUT_NCP + (size_t)NLAYER * NBATCH * 2 * 512, OUT_NVS = OUT_NKS + (size_t)NLAYER * DBATCH * WIN * 128, OUT_NCS = OUT_NVS + (size_t)NLAYER * DBATCH * WIN * 128,
                 OUT_END = OUT_NCS + (size_t)NLAYER * DBATCH * 2 * 512;
static_assert(OUT_END == 26087424, "output size");
constexpr size_t MiB = 1u << 20;
constexpr size_t WS_CTL = 0, CTL_ZERO_BYTES = 32 * 1024;
constexpr size_t WS_WIN = 2 * MiB, WS_WOUT = 11 * MiB, WS_WGU = 15 * MiB, WS_WDN = 37 * MiB;
constexpr size_t WS_SSQA = 48 * MiB, WS_SSQD = 50 * MiB;
constexpr size_t WS_XB = 52 * MiB;
constexpr size_t WS_Z = 86 * MiB;
constexpr size_t WS_MB = 161 * MiB;
constexpr size_t WS_HB = 86 * MiB;
constexpr size_t WS_END = 194 * MiB;
static_assert(WS_WIN + (size_t)NLAYER * NIN * DM * 2 <= WS_WOUT && WS_WOUT + (size_t)NLAYER * DM * DM * 2 <= WS_WGU && WS_WGU + (size_t)NLAYER * NGU * DM * 2 <= WS_WDN && WS_WDN + (size_t)NLAYER * DM * DFF * 2 <= WS_SSQA, "ws weights");
static_assert(WS_SSQA + (size_t)M * 64 <= WS_SSQD && WS_SSQD + (size_t)M * 64 <= WS_XB && WS_XB + (size_t)M * DM * 2 <= WS_Z && WS_Z + (size_t)M * ZP * 2 <= WS_MB && WS_MB + (size_t)M * DM * 2 <= WS_END && WS_HB + (size_t)M * DFF * 2 <= WS_END, "ws activations");
constexpr int CW_TMO = 0, CW_CODE = 1, CW_BAR = 4096;
static_assert((CW_BAR + 3456) * 4 <= (int)CTL_ZERO_BYTES, "barrier words inside the zeroed region");
constexpr int RING_OFF = 0, RING_BYTES = 131072;
constexpr int LDS_BYTES = 163840;
constexpr int LDSCTL_BYTES = 512, LDSCTL_OFF = LDS_BYTES - LDSCTL_BYTES, MISC_OFF = LDSCTL_OFF + 320;
static_assert(MISC_OFF + 128 <= LDS_BYTES, "LDS map");
#define GAS __attribute__((address_space(1)))
#define LAS __attribute__((address_space(3)))
typedef unsigned short bf16;
typedef unsigned v4u __attribute__((ext_vector_type(4)));
typedef float f32x4 __attribute__((ext_vector_type(4)));
typedef short bf16x8 __attribute__((ext_vector_type(8)));
typedef GAS unsigned gu32;
typedef GAS unsigned long long gu64;
#define RLX_AGENT __ATOMIC_RELAXED, __HIP_MEMORY_SCOPE_AGENT
#define LDS_WAIT() asm volatile("s_waitcnt lgkmcnt(0)" ::: "memory")
#define VM_WAIT() asm volatile("s_waitcnt vmcnt(0)" ::: "memory")
__device__ __forceinline__ unsigned long long rt() { return __builtin_amdgcn_s_memrealtime(); }
__device__ __forceinline__ unsigned f2bf(float f) { unsigned u = __builtin_bit_cast(unsigned, f); return (u + 0x7fffu + ((u >> 16) & 1u)) >> 16; }
__device__ __forceinline__ unsigned pk2(float lo, float hi) { return f2bf(lo) | (f2bf(hi) << 16); }

#define XB_TMO      128
#define XB_XCNT(j)  (256  + 64 * (j))
#define XB_XSUB(j)  (1280 + 64 * (j))
#define XB_XGEN(j)  (2304 + 64 * (j))
#define XB_TOP      3328
#define XB_TOPGEN   3392
#define XCD_BAR_WORDS 3456
#define XB_SPIN_CAP (1u << 18)

__device__ __forceinline__ unsigned xb_ld(unsigned* p)              { return __hip_atomic_load(p, __ATOMIC_RELAXED, __HIP_MEMORY_SCOPE_AGENT); }
__device__ __forceinline__ unsigned xb_add(unsigned* p, unsigned v) { return __hip_atomic_fetch_add(p, v, __ATOMIC_RELAXED, __HIP_MEMORY_SCOPE_AGENT); }
__device__ __forceinline__ unsigned xb_xcc_id() { return (unsigned)__builtin_amdgcn_s_getreg((3 << 11) | 20) & 0xFu; }
#define XB_SPIN(cond, bar) do { unsigned _sp = 0; while (cond) { __builtin_amdgcn_s_sleep(1); \
    if ((++_sp & 255u) == 0u) { if (xb_ld(&(bar)[XB_TMO])) break; if (_sp > XB_SPIN_CAP) { atomicAdd(&(bar)[XB_TMO], 1u); break; } } } } while (0)

struct XcdBarrier {
    unsigned* bar; unsigned x;
    volatile LAS unsigned* st;
};

__device__ __forceinline__ XcdBarrier xcd_barrier_post(unsigned* bar, volatile LAS unsigned* st) {
    XcdBarrier b; b.bar = bar; b.x = xb_xcc_id(); b.st = st;
    if (threadIdx.x == 0) (void)xb_add(&bar[XB_XCNT(b.x)], 1u);
    return b;
}
__device__ __forceinline__ void xcd_barrier_complete(unsigned* bar, unsigned x, unsigned& nloc, unsigned& nx) {
    const unsigned G = gridDim.x * gridDim.y * gridDim.z;
    unsigned sum, cnt, mine, sp = 0u;
    for (;;) {
        sum = 0u; cnt = 0u; mine = 0u;
#pragma unroll
        for (unsigned j = 0; j < 16; ++j) { const unsigned c = xb_ld(&bar[XB_XCNT(j)]); sum += c; cnt += (c > 0u) ? 1u : 0u; mine = (j == x) ? c : mine; }
        if (sum == G) break;
        __builtin_amdgcn_s_sleep(1);
        if ((++sp & 255u) == 0u) { if (xb_ld(&bar[XB_TMO])) break; if (sp > XB_SPIN_CAP) { atomicAdd(&bar[XB_TMO], 1u); break; } }
    }
    nloc = mine > 0u ? mine : 1u; nx = cnt > 0u ? cnt : 1u;
}

__device__ __forceinline__ void xcd_barrier(const XcdBarrier& b) {
    asm volatile("s_waitcnt vmcnt(0)" ::: "memory");
    __syncthreads();
    if (threadIdx.x == 0) {
        unsigned* bar = b.bar;
        __builtin_amdgcn_s_waitcnt(0);
        asm volatile("buffer_inv sc1" ::: "memory");
        unsigned nloc = b.st[0], nx = b.st[1];
        if (nloc == 0u) { xcd_barrier_complete(bar, b.x, nloc, nx); b.st[0] = nloc; b.st[1] = nx; }
        const unsigned old = xb_add(&bar[XB_XSUB(b.x)], 1u);
        const unsigned gen = old / nloc;
        if (old + 1u == (gen + 1u) * nloc) {
            __builtin_amdgcn_fence(__ATOMIC_RELEASE, "agent");
            asm volatile("s_waitcnt vmcnt(0)" ::: "memory");
            const unsigned og = xb_add(&bar[XB_TOP], 1u);
            const unsigned tg = og / nx;
            if (og + 1u == (tg + 1u) * nx) xb_add(&bar[XB_TOPGEN], 1u);
            else XB_SPIN(xb_ld(&bar[XB_TOPGEN]) == tg, bar);
            asm volatile("" ::: "memory");
            xb_add(&bar[XB_XGEN(b.x)], 1u);
            asm volatile("s_waitcnt vmcnt(0)" ::: "memory");
        } else {
            XB_SPIN(xb_ld(&bar[XB_XGEN(b.x)]) == gen, bar);
            asm volatile("" ::: "memory");
            asm volatile("s_waitcnt vmcnt(0)" ::: "memory");
        }
    }
    __syncthreads();
}

struct Frame {
    LAS unsigned char* lds;
    volatile LAS unsigned* MISC;
    gu32* ctl;
    int tid, lane, wave;
    int vcu, G;
};
__device__ const unsigned char BUCKET[128] = {0, 1, 2, 3, 4, 5, 6, 7, 8, 9, 10, 11, 12, 13, 14, 15, 16, 16, 16, 17, 17, 18, 18, 18, 19, 19, 19, 20, 20, 20, 20, 21, 21, 21, 21, 22, 22, 22, 22, 22, 23, 23, 23, 23, 23, 23, 24, 24, 24, 24, 24, 24, 25, 25, 25, 25, 25, 25, 25, 26, 26, 26, 26, 26, 26, 26, 26, 27, 27, 27, 27, 27, 27, 27, 27, 27, 27, 28, 28, 28, 28, 28, 28, 28, 28, 28, 28, 29, 29, 29, 29, 29, 29, 29, 29, 29, 29, 29, 29, 30, 30, 30, 30, 30, 30, 30, 30, 30, 30, 30, 30, 30, 30, 31, 31, 31, 31, 31, 31, 31, 31, 31, 31, 31, 31, 31, 31, 31};

__device__ __forceinline__ float wave_sum(float v) {
#pragma unroll
    for (int o = 1; o < 64; o <<= 1) v += __shfl_xor(v, o);
    return v;
}
__device__ __forceinline__ float wave_max(float v) {
#pragma unroll
    for (int o = 1; o < 64; o <<= 1) v = fmaxf(v, __shfl_xor(v, o));
    return v;
}
__device__ __forceinline__ float bf2f(bf16 u) { return __uint_as_float((unsigned)u << 16); }
__device__ __forceinline__ float bflo(unsigned w) { return __uint_as_float(w << 16); }
__device__ __forceinline__ float bfhi(unsigned w) { return __uint_as_float(w & 0xffff0000u); }

__device__ __forceinline__ void st16_wt(void* p, v4u v) { asm volatile("global_store_dwordx4 %0, %1, off sc1\n\ts_nop 1" :: "v"(p), "v"(v) : "memory"); }
__device__ __forceinline__ void st8_wt(void* p, unsigned long long v) { asm volatile("global_store_dwordx2 %0, %1, off sc1\n\ts_nop 1" :: "v"(p), "v"(v) : "memory"); }
struct Args { const float* in[17]; float* out; unsigned char* ws; };
typedef const __attribute__((address_space(4))) Args* KArgs;
enum { I_XP = 0, I_XS = 1, I_CK = 2, I_CV = 3, I_ST = 4, I_RB = 5, I_AN = 6, I_WIN = 7, I_SK = 8, I_CW = 9, I_MN = 10, I_WOUT = 11, I_FN = 12, I_WG = 13, I_WU = 14, I_WD = 15, I_FIN = 16 };
#define WSP(T, off) ((T*)(args->ws + (off)))
__device__ __forceinline__ void cvt_item(const float* W, const float* gain, int K, int N, bf16* WT, int kb, int n0, int dst_row0, int lane) {
    const int k0 = 32 * kb; const float* wp = W + (size_t)k0 * N + n0 + lane;
    float v[32];
#pragma unroll
    for (int j = 0; j < 32; ++j) v[j] = __builtin_nontemporal_load(wp + (size_t)j * N);
    if (gain) {
#pragma unroll
        for (int j = 0; j < 32; ++j) v[j] *= gain[k0 + j]; }
    bf16* op = WT + (size_t)(dst_row0 + lane) * K + k0;
#pragma unroll
    for (int c = 0; c < 4; ++c) { v4u o; o.x = pk2(v[8 * c], v[8 * c + 1]); o.y = pk2(v[8 * c + 2], v[8 * c + 3]); o.z = pk2(v[8 * c + 4], v[8 * c + 5]); o.w = pk2(v[8 * c + 6], v[8 * c + 7]); *(GAS v4u*)(op + 8 * c) = o; }
}
constexpr int CI_IN = 0, CI_OUT = 1152, CI_G = 1664, CI_U = 3072, CI_D = 4480, CI_END = 5888;
__device__ __forceinline__ void cvt_layer_item(KArgs args, int l, int r, int lane) {
    if (r < CI_OUT) { const int nb = r % (NIN / 64), kb = r / (NIN / 64), n0 = 64 * nb;
        const int d0 = n0 < 1280 ? n0 : (n0 < 1792 ? 1280 + ((n0 - 1280) / 128) * 256 + (n0 - 1280) % 128 : 1280 + ((n0 - 1792) / 128) * 256 + 128 + (n0 - 1792) % 128);
        cvt_item(args->in[I_WIN] + (size_t)l * DM * NIN, args->in[I_AN] + l * DM, DM, NIN, WSP(bf16, WS_WIN) + (size_t)l * NIN * DM, kb, n0, d0, lane); return; }
    if (r < CI_G) { r -= CI_OUT; const int nb = r % (DM / 64), kb = r / (DM / 64); cvt_item(args->in[I_WOUT] + (size_t)l * DM * DM, args->in[I_MN] + l * DM, DM, DM, WSP(bf16, WS_WOUT) + (size_t)l * DM * DM, kb, 64 * nb, 64 * nb, lane); return; }
    if (r < CI_D) { r -= CI_G; const int up = r >= (CI_U - CI_G); if (up) r -= (CI_U - CI_G); const int nb = r % (DFF / 64), kb = r / (DFF / 64), n0 = 64 * nb;
        cvt_item((up ? args->in[I_WU] : args->in[I_WG]) + (size_t)l * DM * DFF, args->in[I_FN] + l * DM, DM, DFF, WSP(bf16, WS_WGU) + (size_t)l * NGU * DM, kb, n0, (n0 / 128) * 256 + (n0 % 128) + (up ? 128 : 0), lane); return; }
    { r -= CI_D; const int nb = r % (DM / 64), kb = r / (DM / 64); cvt_item(args->in[I_WD] + (size_t)l * DFF * DM, nullptr, DFF, DM, WSP(bf16, WS_WDN) + (size_t)l * DM * DFF, kb, 64 * nb, 64 * nb, lane); }
}
__device__ __forceinline__ void cvt_range(KArgs args, int l, int lo, int hi, int worker, int nworkers, int lane) {
    for (int r = lo + worker; r < hi; r += nworkers) cvt_layer_item(args, l, r, lane);
}
__device__ __forceinline__ void cache_copy(KArgs args, int l, int worker, int nworkers, int lane, int part, int nparts) {
    constexpr int PER_B = (WIN - DT) * 128 / 4;
    constexpr int NP = 2 * DBATCH * PER_B;
    const int lo = (int)((long)NP * part / nparts), hi = (int)((long)NP * (part + 1) / nparts);
    const int stride = nworkers * 64;
    for (int i0 = lo + worker * 64 + lane; i0 < hi; i0 += 8 * stride) {
        f32x4 x[8];
#pragma unroll
        for (int k = 0; k < 8; ++k) { const int i = i0 + k * stride; if (i < hi) { const int isv = i / (DBATCH * PER_B), rem = i % (DBATCH * PER_B), b = rem / PER_B, p = rem % PER_B;
            x[k] = __builtin_nontemporal_load((const f32x4*)((isv ? args->in[I_CV] : args->in[I_CK]) + (size_t)l * DBATCH * WIN * 128 + (size_t)b * WIN * 128 + DT * 128 + 4 * p)); } }
#pragma unroll
        for (int k = 0; k < 8; ++k) { const int i = i0 + k * stride; if (i < hi) { const int isv = i / (DBATCH * PER_B), rem = i % (DBATCH * PER_B), b = rem / PER_B, p = rem % PER_B;
            __builtin_nontemporal_store(x[k], (f32x4*)(args->out + (isv ? OUT_NVS : OUT_NKS) + (size_t)l * DBATCH * WIN * 128 + (size_t)b * WIN * 128 + 4 * p)); } }
    }
}
__device__ __forceinline__ void p0_prologue(const Frame& F0, KArgs args) {
    Frame F = F0; asm volatile("" : "+v"(F.tid), "+v"(F.lane));
    const int gw = F.vcu * NWAVES + F.wave, NGW = F.G * NWAVES;
    bf16* XB = WSP(bf16, WS_XB); float* SSQA = WSP(float, WS_SSQA);
    for (int m0 = gw; m0 < M; m0 += 2 * NGW) {
        f32x4 v[2][4]; float s[2];
#pragma unroll
        for (int r = 0; r < 2; ++r) { const int m = m0 + r * NGW; const int mm = m < M ? m : m0;
            const float* xrow = mm < MP ? args->in[I_XP] + (size_t)mm * DM : args->in[I_XS] + (size_t)(mm - MP) * DM;
#pragma unroll
            for (int j = 0; j < 2; ++j) { v[r][2 * j] = __builtin_nontemporal_load((const f32x4*)(xrow + 512 * j + 8 * F.lane)); v[r][2 * j + 1] = __builtin_nontemporal_load((const f32x4*)(xrow + 512 * j + 8 * F.lane + 4)); } }
#pragma unroll
        for (int r = 0; r < 2; ++r) { s[r] = 0.f;
#pragma unroll
            for (int j = 0; j < 4; ++j) s[r] += (v[r][j].x * v[r][j].x + v[r][j].y * v[r][j].y) + (v[r][j].z * v[r][j].z + v[r][j].w * v[r][j].w); }
#pragma unroll
        for (int o = 1; o < 64; o <<= 1) { s[0] += __shfl_xor(s[0], o); s[1] += __shfl_xor(s[1], o); }
#pragma unroll
        for (int r = 0; r < 2; ++r) { const int m = m0 + r * NGW; if (m < M) {
#pragma unroll
            for (int j = 0; j < 2; ++j) { v4u w; w.x = pk2(v[r][2 * j].x, v[r][2 * j].y); w.y = pk2(v[r][2 * j].z, v[r][2 * j].w); w.z = pk2(v[r][2 * j + 1].x, v[r][2 * j + 1].y); w.w = pk2(v[r][2 * j + 1].z, v[r][2 * j + 1].w);
                st16_wt(XB + (size_t)m * DM + 512 * j + 8 * F.lane, w); }
            if (F.lane == 0) SSQA[m] = s[r]; } }
    }
    cvt_range(args, 0, CI_IN, CI_G, gw, NGW, F.lane);
}

typedef float f32x16 __attribute__((ext_vector_type(16)));
typedef short s16x4 __attribute__((ext_vector_type(4)));
constexpr int ARS = 144;
constexpr int AKR = 192;
constexpr int LB_K = 0, LB_V = 2 * AKR * ARS, LB_TAB = 2 * LB_V, LB_SSQ = LB_TAB + 8 * 192 * 4, LB_END = LB_SSQ + 2048;
constexpr int LB_ST0 = LB_END;
constexpr int OST0 = 144;
static_assert(LB_ST0 + 8 * 32 * OST0 <= LDSCTL_OFF, "mixer LDS");
constexpr float LOG2E = 1.4426950408889634f;
__device__ __forceinline__ s16x4 vtr(const LAS unsigned char* p) { return __builtin_bit_cast(s16x4, __builtin_amdgcn_ds_read_tr16_b64_v4i16((LAS s16x4*)p)); }
__device__ __forceinline__ void attn_qtile(const bf16x8 (&qf)[4], const LAS unsigned char* kimg, const LAS unsigned char* vimg, int tile0, const LAS float* tab_lane, float sink2, unsigned tilemask, int lane, f32x16 (&o)[2]) {
    const int q = lane & 31, hi = lane >> 5;
    f32x16 S[5];
    const LAS unsigned char* kb = kimg + (tile0 * 32 + q) * ARS + hi * 16;
#pragma unroll
    for (int jj = 0; jj < 5; ++jj) {
        f32x16 acc = {};
#pragma unroll
        for (int ds = 0; ds < 4; ++ds) { const bf16x8 kf = *(const LAS bf16x8*)(kb + jj * 32 * ARS + ds * 32); acc = __builtin_amdgcn_mfma_f32_32x32x16_bf16(kf, qf[ds], acc, 0, 0, 0); }
        S[jj] = acc;
    }
    const float c2 = 0.125f * LOG2E;
    float mx = sink2;
#pragma unroll
    for (int jj = 0; jj < 5; ++jj) { const bool tm = (tilemask >> jj) & 1u;
#pragma unroll
        for (int r = 0; r < 16; ++r) { const float bv = tab_lane[159 - 32 * jj - (r & 3) - 8 * (r >> 2)]; float s = fmaf(S[jj][r], c2, bv); s = tm ? -1e30f : s; S[jj][r] = s; mx = fmaxf(mx, s); } }
    mx = fmaxf(mx, __shfl_xor(mx, 32));
    float lsum = 0.f;
#pragma unroll
    for (int jj = 0; jj < 5; ++jj)
#pragma unroll
        for (int r = 0; r < 16; ++r) { const float p = __builtin_amdgcn_exp2f(S[jj][r] - mx); lsum += p; S[jj][r] = p; }
    lsum += __shfl_xor(lsum, 32); lsum += __builtin_amdgcn_exp2f(sink2 - mx);
    bf16x8 pf[5][2];
#pragma unroll
    for (int jj = 0; jj < 5; ++jj)
#pragma unroll
        for (int s = 0; s < 2; ++s) { v4u w; w.x = pg8::cvt_pk_bf16(S[jj][8 * s + 0], S[jj][8 * s + 1]); w.y = pg8::cvt_pk_bf16(S[jj][8 * s + 2], S[jj][8 * s + 3]); w.z = pg8::cvt_pk_bf16(S[jj][8 * s + 4], S[jj][8 * s + 5]); w.w = pg8::cvt_pk_bf16(S[jj][8 * s + 6], S[jj][8 * s + 7]);
            pf[jj][s] = __builtin_bit_cast(bf16x8, w); }
    const LAS unsigned char* vb = vimg + (tile0 * 32 + 4 * hi + ((lane & 15) >> 2)) * ARS + (16 * ((lane >> 4) & 1) + 4 * (lane & 3)) * 2;
    const float rl = 1.0f / lsum;
#pragma unroll
    for (int db = 0; db < 2; ++db) {
        f32x16 acc = {};
#pragma unroll
        for (int jj = 0; jj < 5; ++jj)
#pragma unroll
            for (int s = 0; s < 2; ++s) { const LAS unsigned char* a = vb + (jj * 32 + 16 * s) * ARS + db * 64;
                const s16x4 lo = vtr(a), hh = vtr(a + 8 * ARS);
                const bf16x8 vf = {lo[0], lo[1], lo[2], lo[3], hh[0], hh[1], hh[2], hh[3]};
                acc = __builtin_amdgcn_mfma_f32_32x32x16_bf16(vf, pf[jj][s], acc, 0, 0, 0); }
        o[db] = acc * rl;
    }
}
__device__ __forceinline__ void load_qf(const bf16* qptr, bf16x8 (&qf)[4]) {
#pragma unroll
    for (int ds = 0; ds < 4; ++ds) qf[ds] = *(const bf16x8*)(qptr + 16 * ds);
}
__device__ __forceinline__ float sumsq32(const f32x16 (&o)[2]) { float s = 0.f;
#pragma unroll
    for (int db = 0; db < 2; ++db)
#pragma unroll
        for (int r = 0; r < 16; ++r) s += o[db][r] * o[db][r];
    return s; }
__device__ __forceinline__ void store_o(bf16* mrow_head, const f32x16 (&o)[2], float ra, int hi) {
#pragma unroll
    for (int db = 0; db < 2; ++db)
#pragma unroll
        for (int g = 0; g < 4; ++g) { const unsigned w0 = pg8::cvt_pk_bf16(o[db][4 * g] * ra, o[db][4 * g + 1] * ra), w1 = pg8::cvt_pk_bf16(o[db][4 * g + 2] * ra, o[db][4 * g + 3] * ra);
            *(unsigned long long*)(mrow_head + 32 * db + 8 * g + 4 * hi) = (unsigned long long)w0 | ((unsigned long long)w1 << 32); }
}
__device__ __forceinline__ void unpack8(const v4u w, float (&f)[8]) { f[0] = bflo(w.x); f[1] = bfhi(w.x); f[2] = bflo(w.y); f[3] = bfhi(w.y); f[4] = bflo(w.z); f[5] = bfhi(w.z); f[6] = bflo(w.w); f[7] = bfhi(w.w); }
__device__ __forceinline__ void cu8(const bf16* Z, size_t row, int lane, float (&c)[8]) { unpack8(*(const v4u*)(Z + row * ZP + ZCU + 8 * lane), c); }
__device__ __forceinline__ void conv_row_out(const bf16* Z, bf16* MB, size_t row, int lane, const float (&cw)[3][8], const float (&c2)[8], const float (&c1)[8], const float (&c0)[8]) {
    float gb[8]; unpack8(*(const v4u*)(Z + row * ZP + ZGB + 8 * lane), gb);
    float v[8]; float ss = 0.f;
#pragma unroll
    for (int i = 0; i < 8; ++i) { v[i] = gb[i] * (cw[0][i] * c2[i] + cw[1][i] * c1[i] + cw[2][i] * c0[i]); ss += v[i] * v[i]; }
    const float rc = rsqrtf(wave_sum(ss) * (1.f / 512.f) + EPS);
    v4u w; w.x = pg8::cvt_pk_bf16(v[0] * rc, v[1] * rc); w.y = pg8::cvt_pk_bf16(v[2] * rc, v[3] * rc); w.z = pg8::cvt_pk_bf16(v[4] * rc, v[5] * rc); w.w = pg8::cvt_pk_bf16(v[6] * rc, v[7] * rc);
    *(v4u*)(MB + row * DM + 512 + 8 * lane) = w;
}
__device__ __forceinline__ void load_cw(const float* cwp, int lane, float (&cw)[3][8]) {
#pragma unroll
    for (int k = 0; k < 3; ++k) { const f32x4 a = *(const f32x4*)(cwp + k * 512 + 8 * lane), b = *(const f32x4*)(cwp + k * 512 + 8 * lane + 4);
        cw[k][0] = a[0]; cw[k][1] = a[1]; cw[k][2] = a[2]; cw[k][3] = a[3]; cw[k][4] = b[0]; cw[k][5] = b[1]; cw[k][6] = b[2]; cw[k][7] = b[3]; }
}
template <int NR>
__device__ __forceinline__ void conv_rows(const bf16* Z, bf16* MB, const float* cwp, size_t r0, long t0, int lane) {
    v4u cuw[NR + 2], gbw[NR];
#pragma unroll
    for (int j = 0; j < NR + 2; ++j) { const size_t rr = (t0 - 2 + j >= 0) ? r0 - 2 + j : r0; cuw[j] = *(const v4u*)(Z + rr * ZP + ZCU + 8 * lane); }
#pragma unroll
    for (int k = 0; k < NR; ++k) gbw[k] = *(const v4u*)(Z + (r0 + k) * ZP + ZGB + 8 * lane);
    float cw[3][8]; load_cw(cwp, lane, cw);
    float cu[NR + 2][8];
#pragma unroll
    for (int j = 0; j < NR + 2; ++j) { float a[8]; unpack8(cuw[j], a); const float keep = (t0 - 2 + j >= 0) ? 1.f : 0.f;
#pragma unroll
        for (int i = 0; i < 8; ++i) cu[j][i] = a[i] * keep; }
    float v[NR][8], ss[NR];
#pragma unroll
    for (int k = 0; k < NR; ++k) { float gb[8]; unpack8(gbw[k], gb); ss[k] = 0.f;
#pragma unroll
        for (int i = 0; i < 8; ++i) { v[k][i] = gb[i] * (cw[0][i] * cu[k][i] + cw[1][i] * cu[k + 1][i] + cw[2][i] * cu[k + 2][i]); ss[k] += v[k][i] * v[k][i]; } }
#pragma unroll
    for (int o = 1; o < 64; o <<= 1)
#pragma unroll
        for (int k = 0; k < NR; ++k) ss[k] += __shfl_xor(ss[k], o);
#pragma unroll
    for (int k = 0; k < NR; ++k) { const float rc = rsqrtf(ss[k] * (1.f / 512.f) + EPS);
        v4u w; w.x = pg8::cvt_pk_bf16(v[k][0] * rc, v[k][1] * rc); w.y = pg8::cvt_pk_bf16(v[k][2] * rc, v[k][3] * rc); w.z = pg8::cvt_pk_bf16(v[k][4] * rc, v[k][5] * rc); w.w = pg8::cvt_pk_bf16(v[k][6] * rc, v[k][7] * rc);
        st16_wt(MB + (r0 + k) * DM + 512 + 8 * lane, w); }
}
#define WG_BAR() do { asm volatile("s_waitcnt vmcnt(0) lgkmcnt(0)" ::: "memory"); __builtin_amdgcn_s_barrier(); asm volatile("" ::: "memory"); } while (0)
__device__ __forceinline__ void pack_o(const f32x16 (&o)[2], float s, unsigned (&p)[16]) {
#pragma unroll
    for (int db = 0; db < 2; ++db)
#pragma unroll
        for (int g = 0; g < 4; ++g) { p[db * 8 + g * 2] = pg8::cvt_pk_bf16(o[db][4 * g] * s, o[db][4 * g + 1] * s); p[db * 8 + g * 2 + 1] = pg8::cvt_pk_bf16(o[db][4 * g + 2] * s, o[db][4 * g + 3] * s); }
}
constexpr int OST = 144;
__device__ __forceinline__ void mixer_prompt_unit(const Frame& F, KArgs args, int l, int unit, bool build_tab) {
    const int tid = F.tid, lane = F.lane, wave = F.wave, q = lane & 31, hi = lane >> 5;
    const int b = unit >> 7, n = (unit >> 1) & 63, qh = unit & 1;
    const size_t R0 = (size_t)b * SEQ + 128 * n + 64 * qh;
    const long W0 = (long)R0 - 128, B0 = (long)b * SEQ;
    const bf16* Z = WSP(bf16, WS_Z); bf16* MB = WSP(bf16, WS_MB);
    LAS unsigned char* lds = F.lds + RING_OFF;
    const int h = wave, kv = h >> 2;
#pragma unroll 6
    for (int k = 0; k < 12; ++k) { const int idx = tid + 512 * k, piece = idx & 31, wrow = idx >> 5; long gr = W0 + wrow; gr = gr < B0 ? B0 : gr;
        const v4u d = *(const v4u*)(Z + (size_t)gr * ZP + ZK + piece * 8);
        *(LAS v4u*)(lds + ((piece >> 4) ? LB_V : LB_K) + (((piece >> 3) & 1) * AKR + wrow) * ARS + (piece & 7) * 16) = d; }
    conv_rows<4>(Z, MB, args->in[I_CW] + (size_t)l * 3 * 512, R0 + 8 * wave, (long)(R0 + 8 * wave) - B0, lane);
    conv_rows<4>(Z, MB, args->in[I_CW] + (size_t)l * 3 * 512, R0 + 8 * wave + 4, (long)(R0 + 8 * wave + 4) - B0, lane);
    if (build_tab) { LAS float* tab = (LAS float*)(lds + LB_TAB);
        for (int i = tid; i < 8 * 192; i += 512) { const int hh = i / 192, d = i % 192 - 32; tab[i] = (d >= 0 && d < 128) ? args->in[I_RB][BUCKET[d] * 8 + hh] * LOG2E : -1e30f; } }
    bf16x8 qf0[4]; load_qf(Z + (R0 + q) * ZP + h * 64 + 8 * hi, qf0);
    WG_BAR();
    const float sink2 = args->in[I_SK][l * 8 + h] * LOG2E;
    const LAS float* tab_lane = (const LAS float*)(lds + LB_TAB) + h * 192 + (1 + q - 4 * hi);
    LAS float* ssqx = (LAS float*)(lds + LB_SSQ);
    const unsigned tm0 = (n == 0) ? ((1u << (4 - 2 * qh)) - 1u) : 0u;
    f32x16 o1[2];
    LAS unsigned char* st0 = lds + LB_ST0 + wave * (32 * OST0);
    {   f32x16 o[2];
        attn_qtile(qf0, lds + LB_K + kv * AKR * ARS, lds + LB_V + kv * AKR * ARS, 0, tab_lane, sink2, tm0, lane, o);
        float ss = sumsq32(o); ss += __shfl_xor(ss, 32); if (hi == 0) ssqx[q * 8 + h] = ss;
        unsigned p0[16]; pack_o(o, 1.0f, p0);
#pragma unroll
        for (int i = 0; i < 8; ++i) *(LAS unsigned long long*)(st0 + q * OST0 + (i >> 2) * 64 + (i & 3) * 16 + hi * 8) = (unsigned long long)p0[2 * i] | ((unsigned long long)p0[2 * i + 1] << 32); }
    {   bf16x8 qf1[4]; load_qf(Z + (R0 + 32 + q) * ZP + h * 64 + 8 * hi, qf1);
        attn_qtile(qf1, lds + LB_K + kv * AKR * ARS, lds + LB_V + kv * AKR * ARS, 1, tab_lane, sink2, tm0 >> 1, lane, o1);
        float ss = sumsq32(o1); ss += __shfl_xor(ss, 32); if (hi == 0) ssqx[(32 + q) * 8 + h] = ss; }
    WG_BAR();
    LAS unsigned char* st1 = lds + wave * (32 * OST);
    {   const LAS f32x4* sp = (const LAS f32x4*)(ssqx + (32 + q) * 8); const f32x4 a = sp[0], c = sp[1];
        const float ra = rsqrtf((((a[0] + a[1]) + (a[2] + a[3])) + ((c[0] + c[1]) + (c[2] + c[3]))) * (1.f / 512.f) + EPS);
        unsigned p1[16]; pack_o(o1, ra, p1);
#pragma unroll
        for (int i = 0; i < 8; ++i) *(LAS unsigned long long*)(st1 + q * OST + (i >> 2) * 64 + (i & 3) * 16 + hi * 8) = (unsigned long long)p1[2 * i] | ((unsigned long long)p1[2 * i + 1] << 32); }
    asm volatile("s_waitcnt lgkmcnt(0)" ::: "memory");
#pragma unroll
    for (int i = 0; i < 4; ++i) { const int row = 8 * i + (lane >> 3), ch = lane & 7;
        const LAS f32x4* sp = (const LAS f32x4*)(ssqx + row * 8); const f32x4 a = sp[0], c = sp[1];
        const float ra = rsqrtf((((a[0] + a[1]) + (a[2] + a[3])) + ((c[0] + c[1]) + (c[2] + c[3]))) * (1.f / 512.f) + EPS);
        const v4u d = *(const LAS v4u*)(st0 + row * OST0 + ch * 16);
        v4u w; w.x = pg8::cvt_pk_bf16(bflo(d.x) * ra, bfhi(d.x) * ra); w.y = pg8::cvt_pk_bf16(bflo(d.y) * ra, bfhi(d.y) * ra); w.z = pg8::cvt_pk_bf16(bflo(d.z) * ra, bfhi(d.z) * ra); w.w = pg8::cvt_pk_bf16(bflo(d.w) * ra, bfhi(d.w) * ra);
        st16_wt(MB + (R0 + row) * DM + h * 64 + 8 * ch, w); }
#pragma unroll
    for (int i = 0; i < 4; ++i) { const int row = 8 * i + (lane >> 3), ch = lane & 7;
        const v4u d = *(const LAS v4u*)(st1 + row * OST + ch * 16);
        st16_wt(MB + (R0 + 32 + row) * DM + h * 64 + 8 * ch, d); }
}
__device__ __forceinline__ void mixer_sample_unit(const Frame& F, KArgs args, int l, int b) {
    const int tid = F.tid, lane = F.lane, wave = F.wave, hi = lane >> 5;
    const size_t RS0 = (size_t)MP + 4 * b;
    const bf16* Z = WSP(bf16, WS_Z); bf16* MB = WSP(bf16, WS_MB);
    LAS unsigned char* lds = F.lds + RING_OFF;
    float* out = args->out;
#if PROBE_TS
#pragma unroll 2
#else
#pragma unroll
#endif
    for (int k = 0; k < 8; ++k) { const int idx = tid + 512 * k, isv = idx >> 11, rem = idx & 2047, w = rem >> 4, pc = rem & 15;
        const float* src = (isv ? args->in[I_CV] : args->in[I_CK]) + (size_t)l * DBATCH * WIN * 128 + ((size_t)b * WIN + w) * 128 + pc * 8;
        const f32x4 x0 = __builtin_nontemporal_load((const f32x4*)src), x1 = __builtin_nontemporal_load((const f32x4*)(src + 4));
        v4u pk; pk.x = pg8::cvt_pk_bf16(x0[0], x0[1]); pk.y = pg8::cvt_pk_bf16(x0[2], x0[3]); pk.z = pg8::cvt_pk_bf16(x1[0], x1[1]); pk.w = pg8::cvt_pk_bf16(x1[2], x1[3]);
        *(LAS v4u*)(lds + (isv ? LB_V : LB_K) + ((pc >> 3) * AKR + w) * ARS + (pc & 7) * 16) = pk; }
    if (tid < 128) { const int t = tid >> 5, piece = tid & 31;
        const v4u d = *(const v4u*)(Z + (RS0 + t) * ZP + ZK + piece * 8);
        *(LAS v4u*)(lds + ((piece >> 4) ? LB_V : LB_K) + (((piece >> 3) & 1) * AKR + 128 + t) * ARS + (piece & 7) * 16) = d;
        float f[8]; unpack8(d, f);
        float* dst = out + ((piece >> 4) ? OUT_NVS : OUT_NKS) + (size_t)l * DBATCH * WIN * 128 + ((size_t)b * WIN + (WIN - DT) + t) * 128 + (piece & 15) * 8;
        *(f32x4*)dst = (f32x4){f[0], f[1], f[2], f[3]}; *(f32x4*)(dst + 4) = (f32x4){f[4], f[5], f[6], f[7]}; }
    for (int idx = tid; idx < 28 * 32; idx += 512) { const int zr = idx >> 5, piece = idx & 31;
        *(LAS v4u*)(lds + ((piece >> 4) ? LB_V : LB_K) + (((piece >> 3) & 1) * AKR + 132 + zr) * ARS + (piece & 7) * 16) = (v4u){0u, 0u, 0u, 0u}; }
    WG_BAR();
    LAS float* ssqx = (LAS float*)(lds + LB_SSQ);
    f32x16 o[2]; const int qc = lane & 31, t = (qc >> 2) & 3, g = qc & 3;
    if (wave < 2) {
        const int kv = wave, head = 4 * kv + g;
        const float sink2 = args->in[I_SK][l * 8 + head] * LOG2E;
        const LAS float* tab_lane = (const LAS float*)(lds + LB_TAB) + head * 192 + (1 + t - 4 * hi);
        bf16x8 qf[4]; load_qf(Z + (RS0 + t) * ZP + head * 64 + 8 * hi, qf);
        attn_qtile(qf, lds + LB_K + kv * AKR * ARS, lds + LB_V + kv * AKR * ARS, 0, tab_lane, sink2, 0u, lane, o);
        float ss = sumsq32(o); ss += __shfl_xor(ss, 32); ss += __shfl_xor(ss, 1); ss += __shfl_xor(ss, 2);
        if (lane < 16 && g == 0) ssqx[t * 2 + kv] = ss;
    } else if (wave < 6) {
        const int tt = wave - 2; float cw[3][8]; load_cw(args->in[I_CW] + (size_t)l * 3 * 512, lane, cw);
        const float* st = args->in[I_ST] + (size_t)l * DBATCH * 2 * 512 + (size_t)b * 2 * 512;
        float c2[8], c1[8], c0[8];
        if (tt >= 2) cu8(Z, RS0 + tt - 2, lane, c2); else { const f32x4 a = *(const f32x4*)(st + tt * 512 + 8 * lane), c = *(const f32x4*)(st + tt * 512 + 8 * lane + 4); c2[0] = a[0]; c2[1] = a[1]; c2[2] = a[2]; c2[3] = a[3]; c2[4] = c[0]; c2[5] = c[1]; c2[6] = c[2]; c2[7] = c[3]; }
        if (tt >= 1) cu8(Z, RS0 + tt - 1, lane, c1); else { const f32x4 a = *(const f32x4*)(st + 512 + 8 * lane), c = *(const f32x4*)(st + 512 + 8 * lane + 4); c1[0] = a[0]; c1[1] = a[1]; c1[2] = a[2]; c1[3] = a[3]; c1[4] = c[0]; c1[5] = c[1]; c1[6] = c[2]; c1[7] = c[3]; }
        cu8(Z, RS0 + tt, lane, c0);
        conv_row_out(Z, MB, RS0 + tt, lane, cw, c2, c1, c0);
    }
    WG_BAR();
    if (wave < 2) { const int head = 4 * wave + g;
        const float ra = rsqrtf((ssqx[t * 2] + ssqx[t * 2 + 1]) * (1.f / 512.f) + EPS);
        if (qc < 16) store_o(MB + (RS0 + t) * DM + head * 64, o, ra, hi); }
}
__device__ __forceinline__ void state_outputs(const Frame& F, KArgs args, int l, int wg, int nwg) {
    const bf16* Z = WSP(bf16, WS_Z); float* out = args->out;
    const size_t gt = (size_t)wg * 512 + F.tid, NT = (size_t)nwg * 512;
    for (size_t i = gt; i < (size_t)DBATCH * 2 * 512; i += NT) {
        if (i < (size_t)NBATCH * WIN * 128) { const int b = i / (WIN * 128), w = (i / 128) % WIN, c = i % 128; const size_t r = (size_t)b * SEQ + SEQ - WIN + w;
            out[OUT_NKP + (size_t)l * NBATCH * WIN * 128 + i] = bf2f(Z[r * ZP + ZK + c]); out[OUT_NVP + (size_t)l * NBATCH * WIN * 128 + i] = bf2f(Z[r * ZP + ZV + c]); }
        if (i < (size_t)NBATCH * 2 * 512) { const int b = i / 1024, j = (i / 512) % 2, ch = i % 512; const size_t r = (size_t)b * SEQ + SEQ - 2 + j;
            out[OUT_NCP + (size_t)l * NBATCH * 1024 + i] = bf2f(Z[r * ZP + ZCU + ch]); }
        { const int b = i / 1024, j = (i / 512) % 2, ch = i % 512; const size_t r = (size_t)MP + b * DT + 2 + j;
            out[OUT_NCS + (size_t)l * DBATCH * 1024 + i] = bf2f(Z[r * ZP + ZCU + ch]); }
    }
}
__device__ __forceinline__ void phaseB1(const Frame& F0, KArgs args, int l) {
    Frame F = F0; asm volatile("" : "+v"(F.tid), "+v"(F.lane));
    bool first = true;
    for (int u = F.vcu; u < NBATCH * 64 * 2; u += F.G) { WG_BAR(); mixer_prompt_unit(F, args, l, u, first); first = false; }
}
__device__ __forceinline__ void phaseB2(const Frame& F0, KArgs args, int l) {
    Frame F = F0; asm volatile("" : "+v"(F.tid), "+v"(F.lane));
    for (int b = F.vcu; b < DBATCH; b += F.G) { WG_BAR(); mixer_sample_unit(F, args, l, b); }
    if (F.G > DBATCH) { if (F.vcu >= DBATCH) { cache_copy(args, l, (F.vcu - DBATCH) * NWAVES + F.wave, (F.G - DBATCH) * NWAVES, F.lane, 0, 2); state_outputs(F, args, l, F.vcu - DBATCH, F.G - DBATCH); } }
    else { cache_copy(args, l, F.vcu * NWAVES + F.wave, F.G * NWAVES, F.lane, 0, 2); state_outputs(F, args, l, F.vcu, F.G); }
    WG_BAR();
}
template <int K, bool LAST>
__device__ __forceinline__ void tail_gemm_resid(const Frame& F, const bf16* A, const bf16* Bt, bf16* xb, float* out, float* ssq_rows  , int tile) {
    const int lane = F.lane, wave = F.wave, fr = lane & 15, fq = lane >> 4;
    const int row0 = (tile >> 4) * 32, col0 = (tile & 15) * 64, tc = tile & 15;
    constexpr int KW = K / 8, STEPS = KW / 32; static_assert(KW % 32 == 0, "K split");
    f32x4 acc[2][4];
#pragma unroll
    for (int m = 0; m < 2; ++m)
#pragma unroll
        for (int n = 0; n < 4; ++n) acc[m][n] = (f32x4){0.f, 0.f, 0.f, 0.f};
    const bf16* ap = A + (size_t)(row0 + fr) * K + wave * KW + 8 * fq;
    const bf16* bp = Bt + (size_t)(col0 + fr) * K + wave * KW + 8 * fq;
#pragma unroll 2
    for (int s = 0; s < STEPS; ++s) {
        bf16x8 a[2], b[4];
#pragma unroll
        for (int m = 0; m < 2; ++m) a[m] = *(const bf16x8*)(ap + (size_t)(16 * m) * K + 32 * s);
#pragma unroll
        for (int n = 0; n < 4; ++n) b[n] = *(const bf16x8*)(bp + (size_t)(16 * n) * K + 32 * s);
#pragma unroll
        for (int m = 0; m < 2; ++m)
#pragma unroll
            for (int n = 0; n < 4; ++n) acc[m][n] = __builtin_amdgcn_mfma_f32_16x16x32_bf16(b[n], a[m], acc[m][n], 0, 0, 0);
    }
    LAS float* red = (LAS float*)(F.lds + RING_OFF);
#pragma unroll
    for (int m = 0; m < 2; ++m)
#pragma unroll
        for (int n = 0; n < 4; ++n) *(LAS f32x4*)(red + ((wave * 32 + 16 * m + fr) * 64 + 16 * n + 4 * fq)) = acc[m][n];
    WG_BAR();
    const int t = F.tid, r = t >> 4, c4 = (t & 15) * 4;
    bf16* xp = xb + (size_t)(row0 + r) * DM + col0 + c4;
    const unsigned long long bw = *(const unsigned long long*)xp;
    f32x4 v = (f32x4){bflo((unsigned)bw), bfhi((unsigned)bw), bflo((unsigned)(bw >> 32)), bfhi((unsigned)(bw >> 32))};
#pragma unroll
    for (int w = 0; w < 8; ++w) v += *(const LAS f32x4*)(red + ((w * 32 + r) * 64 + c4));
    if (LAST) *(f32x4*)(out + (size_t)(row0 + r) * DM + col0 + c4) = v;
    else *(unsigned long long*)xp = (unsigned long long)pg8::cvt_pk_bf16(v[0], v[1]) | ((unsigned long long)pg8::cvt_pk_bf16(v[2], v[3]) << 32);
    float q = (v[0] * v[0] + v[1] * v[1]) + (v[2] * v[2] + v[3] * v[3]);
    q += __shfl_xor(q, 1); q += __shfl_xor(q, 2); q += __shfl_xor(q, 4); q += __shfl_xor(q, 8);
    if ((t & 15) == 0) ssq_rows[(size_t)tc * M + row0 + r] = q;
    WG_BAR();
}
__device__ __forceinline__ void phase_final(const Frame& F0, KArgs args) {
    Frame F = F0; asm volatile("" : "+v"(F.tid), "+v"(F.lane));
    const int gw = F.vcu * NWAVES + F.wave, NGW = F.G * NWAVES;
    const float* SSQA = WSP(float, WS_SSQA);
    const bf16* XB = WSP(bf16, WS_XB);
    for (int m = gw; m < M; m += NGW) {
        float part = F.lane < 16 ? SSQA[(size_t)F.lane * M + m] : 0.f;
        const float rstd = rsqrtf(wave_sum(part) * (1.f / DM) + EPS);
        const GAS unsigned long long* xr = (const GAS unsigned long long*)(XB + (size_t)m * DM) + F.lane; const GAS f32x4* g = (const GAS f32x4*)args->in[I_FIN] + F.lane;
        GAS f32x4* yr = (GAS f32x4*)(args->out + (size_t)m * DM) + F.lane;
#pragma unroll
        for (int j = 0; j < 4; ++j) { const unsigned long long w = xr[64 * j]; const f32x4 gg = g[64 * j];
            f32x4 v = (f32x4){bflo((unsigned)w), bfhi((unsigned)w), bflo((unsigned)(w >> 32)), bfhi((unsigned)(w >> 32))}; v = v * rstd * gg; __builtin_nontemporal_store(v, (f32x4*)(yr + 64 * j)); }
    }
}

#ifndef REP_A
#define REP_A 1
#endif
#ifndef REP_D
#define REP_D 1
#endif
#ifndef REP_T
#define REP_T 1
#endif
#ifndef REP_BAR
#define REP_BAR 0
#endif
#ifndef REP_P0
#define REP_P0 1
#endif
#ifndef REP_B
#define REP_B 1
#endif
__global__ void __launch_bounds__(NWAVES * 64, 2) mega_fwd(Args args_) {
    extern __shared__ __attribute__((aligned(16))) unsigned char lds[];
    Frame F;
    F.lds = (LAS unsigned char*)lds;
    F.MISC = (volatile LAS unsigned*)(F.lds + MISC_OFF);
    F.tid = threadIdx.x; F.lane = F.tid & 63; F.wave = __builtin_amdgcn_readfirstlane(F.tid >> 6);
    F.G = gridDim.x; { const int bx = blockIdx.x; F.vcu = (F.G % 8 == 0) ? (bx % 8) * (F.G / 8) + bx / 8 : bx; }
    F.ctl = (gu32*)(args_.ws + WS_CTL);
    for (int u = F.tid; u < (LDS_BYTES - LDSCTL_OFF) / 4; u += NWAVES * 64) ((LAS unsigned*)(F.lds + LDSCTL_OFF))[u] = 0u;
    __syncthreads();
    XcdBarrier bar = xcd_barrier_post((unsigned*)(F.ctl + CW_BAR), F.MISC + 8);
#if PROBE_TS
#define PROBE_HIT(i_) (((i_) == 0) ? false : ((i_) == 100 ? PROBE_PH == 7 : ((i_) == 1 ? PROBE_PH == 0 : (((i_) - 2) % 5 + 1 == PROBE_PH || (PROBE_PH == 8 && ((i_) - 2) % 5 == 1)))))
#define BAR_STAMP(i) do { const int i_ = (i); const bool hit_ = PROBE_HIT(i_); \
    for (int rb_ = 0; rb_ < (hit_ ? 2 : 1); ++rb_) { GRID_BAR(); \
        if (blockIdx.x == 0 && F.tid == 0) { const unsigned long long now_ = __builtin_amdgcn_s_memrealtime(); \
            if (hit_ && rb_ == 0) { const unsigned long long t0_ = ((unsigned long long)F.MISC[17] << 32) | F.MISC[16]; const unsigned long long d_ = now_ - t0_; while (__builtin_amdgcn_s_memrealtime() < now_ + 4 * d_) __builtin_amdgcn_s_sleep(20); } \
            if (PROBE_PH == 9 && i_ == 5 && rb_ == 0) { const unsigned long long t0_ = ((unsigned long long)F.MISC[17] << 32) | F.MISC[16], m0_ = ((unsigned long long)F.MISC[19] << 32) | F.MISC[18]; \
                const unsigned long long drt_ = now_ - t0_, dmt_ = __builtin_amdgcn_s_memtime() - m0_; const unsigned long long sp_ = dmt_ * 1000ull / drt_; while (__builtin_amdgcn_s_memrealtime() < now_ + sp_) __builtin_amdgcn_s_sleep(20); } \
            const unsigned long long n2_ = __builtin_amdgcn_s_memrealtime(); F.MISC[16] = (unsigned)n2_; F.MISC[17] = (unsigned)(n2_ >> 32); const unsigned long long m2_ = __builtin_amdgcn_s_memtime(); F.MISC[18] = (unsigned)m2_; F.MISC[19] = (unsigned)(m2_ >> 32); } } } while (0)
#define STAMP0() do { if (blockIdx.x == 0 && F.tid == 0) { const unsigned long long n2_ = __builtin_amdgcn_s_memrealtime(); F.MISC[16] = (unsigned)n2_; F.MISC[17] = (unsigned)(n2_ >> 32); } } while (0)
#else
#define BAR_STAMP(i) GRID_BAR()
#define STAMP0() do {} while (0)
#endif
#define GRID_BAR() do { XcdBarrier bb_ = bar; asm volatile("" : "+s"(bb_.x)); xcd_barrier(bb_); } while (0)
#define PHASE_ARGS() KArgs args = (KArgs)__builtin_amdgcn_kernarg_segment_ptr(); asm volatile("" : "+s"(args))
#define LAYER() int l = l_; asm volatile("" : "+s"(l))

    STAMP0();
    for (int rep_ = 0; rep_ < REP_P0; ++rep_) { PHASE_ARGS(); p0_prologue(F, args); }
    BAR_STAMP(1);
    for (int l_ = 0; l_ < NLAYER; ++l_) {
        {   PHASE_ARGS(); LAYER();
            pg8::Gemm g{WSP(bf16, WS_XB), WSP(bf16, WS_WIN) + (size_t)l * NIN * DM, M, NIN, DM}; pg8::StaticOrder S; S.init(M, NIN, F.G, (int)blockIdx.x);
            pg8::EpiScaleBf16 E{WSP(bf16, WS_Z), ZP, WSP(float, WS_SSQA), l == 0 ? 1 : 16, M};
            for (int rep_ = 0; rep_ < REP_A; ++rep_) pg8::gemm_phase<pg8::EpiScaleBf16, pg8::StaticOrder, true, true>(F.lds + RING_OFF, g, S, E);
            const int full = ((M / 256) * (NIN / 256)) % F.G;
            if ((int)blockIdx.x >= full) { Frame F2 = F; asm volatile("" : "+v"(F2.tid), "+v"(F2.lane)); cvt_range(args, l, CI_G, CI_END, ((int)blockIdx.x - full) * NWAVES + F2.wave, (F.G - full) * NWAVES, F2.lane); }
        }
        BAR_STAMP(2 + 5 * l_);
        for (int rep_ = 0; rep_ < REP_B; ++rep_) { { PHASE_ARGS(); LAYER(); phaseB1(F, args, l); }
#if PROBE_TS
            if (PROBE_PH == 7 || PROBE_PH == 8) { BAR_STAMP(100); }
#endif
            { PHASE_ARGS(); LAYER(); phaseB2(F, args, l); } }
        BAR_STAMP(3 + 5 * l_);
        {   PHASE_ARGS(); LAYER();
            pg8::Gemm g{WSP(bf16, WS_MB), WSP(bf16, WS_WOUT) + (size_t)l * DM * DM, MP, DM, DM}; pg8::StaticOrder S; S.init(MP, DM, F.G, (int)blockIdx.x);
            if (F.G == 256) {
                pg8::EpiResidTail<DM> E{WSP(bf16, WS_XB), WSP(float, WS_SSQD), M, WSP(bf16, WS_MB) + (size_t)MP * DM, WSP(bf16, WS_WOUT) + (size_t)l * DM * DM, F.vcu, WSP(bf16, WS_XB) + (size_t)MP * DM, WSP(float, WS_SSQD) + MP};
                pg8::gemm_phase<pg8::EpiResidTail<DM>, pg8::StaticOrder, false, true>(F.lds + RING_OFF, g, S, E);
            } else {
                pg8::EpiResid<false> E{WSP(bf16, WS_XB), args->out, WSP(float, WS_SSQD), M};
                pg8::gemm_phase<pg8::EpiResid<false>, pg8::StaticOrder, true, true>(F.lds + RING_OFF, g, S, E);
                Frame F2 = F; asm volatile("" : "+v"(F2.tid), "+v"(F2.lane));
                for (int tile = F.vcu; tile < 256; tile += F.G)
                    tail_gemm_resid<DM, false>(F2, WSP(bf16, WS_MB) + (size_t)MP * DM, WSP(bf16, WS_WOUT) + (size_t)l * DM * DM, WSP(bf16, WS_XB) + (size_t)MP * DM, args->out + (size_t)MP * DM, WSP(float, WS_SSQD) + MP, tile);
            }
        }
        BAR_STAMP(4 + 5 * l_);
        {   PHASE_ARGS(); LAYER();
            pg8::Gemm g{WSP(bf16, WS_XB), WSP(bf16, WS_WGU) + (size_t)l * NGU * DM, M, NGU, DM}; pg8::StaticOrder S; S.init(M, NGU, F.G, (int)blockIdx.x);
            pg8::EpiSwiGLU E{WSP(bf16, WS_HB), DFF, WSP(float, WS_SSQD), 16, M};
            for (int rep_ = 0; rep_ < REP_D; ++rep_) pg8::gemm_phase<pg8::EpiSwiGLU, pg8::StaticOrder, true, true>(F.lds + RING_OFF, g, S, E);
            const int full = ((M / 256) * (NGU / 256)) % F.G;
            if ((int)blockIdx.x >= full) { Frame F2 = F; asm volatile("" : "+v"(F2.tid), "+v"(F2.lane));
                if (l + 1 < NLAYER) cvt_range(args, l + 1, CI_IN, CI_G, ((int)blockIdx.x - full) * NWAVES + F2.wave, (F.G - full) * NWAVES, F2.lane);
                else for (int ll = 0; ll < NLAYER; ++ll) cache_copy(args, ll, ((int)blockIdx.x - full) * NWAVES + F2.wave, (F.G - full) * NWAVES, F2.lane, 1, 2); }
        }
        BAR_STAMP(5 + 5 * l_);
        {   PHASE_ARGS(); LAYER();
            pg8::Gemm g{WSP(bf16, WS_HB), WSP(bf16, WS_WDN) + (size_t)l * DM * DFF, MP, DM, DFF}; pg8::StaticOrder S; S.init(MP, DM, F.G, (int)blockIdx.x);
            if (F.G == 256) {
                pg8::EpiResidTail<DFF> E{WSP(bf16, WS_XB), WSP(float, WS_SSQA), M, WSP(bf16, WS_HB) + (size_t)MP * DFF, WSP(bf16, WS_WDN) + (size_t)l * DM * DFF, F.vcu, WSP(bf16, WS_XB) + (size_t)MP * DM, WSP(float, WS_SSQA) + MP};
                pg8::gemm_phase<pg8::EpiResidTail<DFF>, pg8::StaticOrder, false, true>(F.lds + RING_OFF, g, S, E);
            } else {
                pg8::EpiResid<false> E{WSP(bf16, WS_XB), args->out, WSP(float, WS_SSQA), M};
                pg8::gemm_phase<pg8::EpiResid<false>, pg8::StaticOrder, true, true>(F.lds + RING_OFF, g, S, E);
                Frame F2 = F; asm volatile("" : "+v"(F2.tid), "+v"(F2.lane));
                for (int tile = F.vcu; tile < 256; tile += F.G)
                    tail_gemm_resid<DFF, false>(F2, WSP(bf16, WS_HB) + (size_t)MP * DFF, WSP(bf16, WS_WDN) + (size_t)l * DM * DFF, WSP(bf16, WS_XB) + (size_t)MP * DM, args->out + (size_t)MP * DM, WSP(float, WS_SSQA) + MP, tile);
            }
        }
        BAR_STAMP(6 + 5 * l_);
    }
    for (int rep_ = 0; rep_ < REP_BAR; ++rep_) GRID_BAR();
    { PHASE_ARGS(); phase_final(F, args); }
#if PROBE_TS
    if (PROBE_PH == 6 && blockIdx.x == 0) { __syncthreads(); if (F.tid == 0) { const unsigned long long now_ = __builtin_amdgcn_s_memrealtime(); const unsigned long long t0_ = ((unsigned long long)F.MISC[17] << 32) | F.MISC[16]; const unsigned long long d_ = now_ - t0_; while (__builtin_amdgcn_s_memrealtime() < now_ + 4 * d_) __builtin_amdgcn_s_sleep(20); } }
#endif
}

extern "C" void kernel_launch(void* const* d_in, const int* in_sizes, int n_in, void* d_out, int out_size, void* d_ws, size_t ws_size, hipStream_t stream) {
    static int grid = 0;
    if (grid == 0) {
        if (n_in != 17 || (size_t)out_size != OUT_END || ws_size < WS_END) { fprintf(stderr, "kernel_launch: unexpected shapes: n_in %d out %d ws %zu\n", n_in, out_size, ws_size); grid = -1; return; }
        int dev = 0, cus = 0, per_cu = 0;
        if (hipGetDevice(&dev) != hipSuccess || hipDeviceGetAttribute(&cus, hipDeviceAttributeMultiprocessorCount, dev) != hipSuccess) { grid = -1; return; }
        if (hipFuncSetAttribute((const void*)mega_fwd, hipFuncAttributeMaxDynamicSharedMemorySize, LDS_BYTES) != hipSuccess) { fprintf(stderr, "kernel_launch: hipFuncSetAttribute failed\n"); grid = -1; return; }
        if (hipOccupancyMaxActiveBlocksPerMultiprocessor(&per_cu, (const void*)mega_fwd, NWAVES * 64, LDS_BYTES) != hipSuccess || per_cu < 1) { fprintf(stderr, "kernel_launch: occupancy query says %d blocks per CU\n", per_cu); grid = -1; (void)hipGetLastError(); return; }
        grid = cus;
        if (grid > 256) grid = 256;
        grid &= ~7;
    }
    if (grid <= 0) return;
    if (hipMemsetAsync((char*)d_ws + WS_CTL, 0, CTL_ZERO_BYTES, stream) != hipSuccess) return;
    Args a{};
    for (int i = 0; i < 17; ++i) a.in[i] = (const float*)d_in[i];
    a.out = (float*)d_out; a.ws = (unsigned char*)d_ws;
    hipLaunchKernelGGL(mega_fwd, dim3(grid), dim3(NWAVES * 64), LDS_BYTES, stream, a);
}
```

```cpp
#include <hip/hip_runtime.h>
#include <cstdio>
#include <cstdint>
namespace pg8 {
#define PG8_LAS __attribute__((address_space(3)))
typedef unsigned short bf16_t;
typedef short bf16x8 __attribute__((ext_vector_type(8)));
typedef float f32x4 __attribute__((ext_vector_type(4)));
typedef unsigned u32x4 __attribute__((ext_vector_type(4)));
constexpr int BM = 256, BK = 64, HALF = 128, HTB = HALF * BK * 2  , STAGE_BYTES = 8 * HTB, NXCD = 8, WGM = 8;

__host__ __device__ __forceinline__ int lds_byte(int r, int c) { const int st = (r >> 4) * 2 + (c >> 5), rr = r & 15, cc = c & 31, ob = rr * 64 + cc * 2; return st * 1024 + (ob ^ (((ob >> 9) & 1) << 5)); }
__host__ __device__ __forceinline__ void stage_rc(int b, int& R, int& C) { const int st = b / 1024, sb = b % 1024, swz = sb ^ (((sb >> 9) & 1) << 5); R = (st >> 1) * 16 + swz / 64; C = (st & 1) * 32 + (swz % 64) / 2; }
__host__ __device__ __forceinline__ int perm32(int rho) { const int n = rho >> 4, i = rho & 15; return 8 * (i >> 2) + 4 * n + (i & 3); }

struct Unit { int pm, pn; };
struct Gemm { const bf16_t* A; const bf16_t* Bt; int M, N, K; };

struct StaticOrder {
    int nM, nN, nwg, G, c; bool rev;
    __host__ __device__ void init(int M, int N, int G_, int c_, bool rev_ = false) { nM = M / BM; nN = N / BM; nwg = nM * nN; G = G_; c = c_; rev = rev_; }
    __host__ __device__ bool next(int i, Unit& u) const {
        const long L = (long)i * G + c; if (L >= nwg) return false;
        int wgid = rev ? nwg - 1 - (int)L : (int)L;
        const int nig = WGM * nN, gid = wgid / nig, fm = gid * WGM, gsz = (nM - fm) < WGM ? (nM - fm) : WGM;
        u.pm = fm + ((wgid % nig) % gsz); u.pn = (wgid % nig) / gsz; return true;
    }
    __device__ __forceinline__ void a_ready(const Unit&) const {}
    __device__ __forceinline__ void done(const Unit&) const {}
};

typedef float f32x2_t __attribute__((ext_vector_type(2))); typedef __bf16 bf16x2_t __attribute__((ext_vector_type(2)));
__device__ __forceinline__ unsigned cvt_pk_bf16(float lo, float hi) { const f32x2_t v = {lo, hi}; const bf16x2_t b = __builtin_convertvector(v, bf16x2_t); return __builtin_bit_cast(unsigned, b); }
template <int OFF> __device__ __forceinline__ void store16_wt(void* p, u32x4 v) { asm volatile("global_store_dwordx4 %0, %1, off offset:%2 sc1\n\ts_nop 1" :: "v"(p), "v"(v), "i"(OFF) : "memory"); }
constexpr int SSQ_SLOTS = 16;
constexpr float RMS_EPS = 1e-6f;
struct RstdState { float rs[2]; };
__device__ __forceinline__ void rstd_issue(const float* ssq, int nslots, int mrows, int pm, int wr, int lane, float (&v)[2][16]) {
    if (nslots == 16) {
#pragma unroll
        for (int ai = 0; ai < 2; ++ai) { const float* p = ssq + (size_t)(pm * BM + ai * HALF + wr * 64 + lane);
#pragma unroll
            for (int k = 0; k < 16; ++k) v[ai][k] = p[(size_t)k * mrows]; }
    } else {
#pragma unroll
        for (int ai = 0; ai < 2; ++ai) { v[ai][0] = ssq[(size_t)(pm * BM + ai * HALF + wr * 64 + lane)];
#pragma unroll
            for (int k = 1; k < 16; ++k) v[ai][k] = 0.f; }
    }
}
__device__ __forceinline__ void rstd_finish(const float (&v)[2][16], float (&rs)[2]) {
#pragma unroll
    for (int ai = 0; ai < 2; ++ai) { float s = 0.f;
#pragma unroll
        for (int k = 0; k < 16; ++k) s += v[ai][k];
        rs[ai] = rsqrtf(s * (1.0f / 1024.0f) + RMS_EPS); }
}
struct EpiScaleBf16 {
    static constexpr bool PERM = true, AFTER_DRAIN = false;
    typedef RstdState State;
    bf16_t* O; int ldc; const float* ssq; int nslots, mrows;
    __device__ __forceinline__ void init(State& st, const Unit& u, int wr, int lane) const { float v[2][16]; rstd_issue(ssq, nslots, mrows, u.pm, wr, lane, v); rstd_finish(v, st.rs); asm volatile("" : "+v"(st.rs[0]), "+v"(st.rs[1])); }
    __device__ __forceinline__ void acc_init(f32x4 (&)[2][2][4][2], const Unit&, int, int, int, int) const {}
    __device__ __forceinline__ void operator()(const f32x4 (&acc)[2][2][4][2], const Unit& u, int wr, int wc, int fr, int fq, State& st, bool has_next, const Unit& nxt) const {
        float v[2][16]; rstd_issue(ssq, nslots, mrows, has_next ? nxt.pm : u.pm, wr, fq * 16 + fr, v);
        const int row0 = u.pm * BM + wr * 64 + fr;
        if (u.pn < 5) {
            const int col0 = u.pn * BM + wc * 32 + 8 * fq;
#pragma unroll
            for (int ai = 0; ai < 2; ++ai)
#pragma unroll
                for (int m = 0; m < 4; ++m) { const float sc = __shfl(st.rs[ai], 16 * m + fr); bf16_t* rowp = O + (size_t)(row0 + ai * HALF + m * 16) * ldc + col0;
#pragma unroll
                    for (int bj = 0; bj < 2; ++bj) { const f32x4 v0 = acc[ai][bj][m][0] * sc, v1 = acc[ai][bj][m][1] * sc;
                        u32x4 w; w.x = cvt_pk_bf16(v0[0], v0[1]); w.y = cvt_pk_bf16(v0[2], v0[3]); w.z = cvt_pk_bf16(v1[0], v1[1]); w.w = cvt_pk_bf16(v1[2], v1[3]);
                        if (bj == 0) store16_wt<0>(rowp, w); else store16_wt<HALF * 2>(rowp, w); } }
        } else {
            const int col0 = 1280 + (u.pn - 5) * HALF + wc * 32 + 8 * fq;
#pragma unroll
            for (int ai = 0; ai < 2; ++ai)
#pragma unroll
                for (int m = 0; m < 4; ++m) { const float sc = __shfl(st.rs[ai], 16 * m + fr), s2 = sc * sc; bf16_t* rowp = O + (size_t)(row0 + ai * HALF + m * 16) * ldc + col0;
                    const f32x4 v0 = acc[ai][0][m][0] * acc[ai][1][m][0] * s2, v1 = acc[ai][0][m][1] * acc[ai][1][m][1] * s2;
                    u32x4 w; w.x = cvt_pk_bf16(v0[0], v0[1]); w.y = cvt_pk_bf16(v0[2], v0[3]); w.z = cvt_pk_bf16(v1[0], v1[1]); w.w = cvt_pk_bf16(v1[2], v1[3]);
                    store16_wt<0>(rowp, w); }
        }
        { rstd_finish(v, st.rs); asm volatile("" : "+v"(st.rs[0]), "+v"(st.rs[1])); }
    }
};
struct EpiSwiGLU {
    static constexpr bool PERM = true, AFTER_DRAIN = false;
    typedef RstdState State;
    bf16_t* O; int ldc; const float* ssq; int nslots, mrows;
    __device__ __forceinline__ void init(State& st, const Unit& u, int wr, int lane) const { float v[2][16]; rstd_issue(ssq, nslots, mrows, u.pm, wr, lane, v); rstd_finish(v, st.rs); asm volatile("" : "+v"(st.rs[0]), "+v"(st.rs[1])); }
    __device__ __forceinline__ void acc_init(f32x4 (&)[2][2][4][2], const Unit&, int, int, int, int) const {}
    __device__ __forceinline__ void operator()(const f32x4 (&acc)[2][2][4][2], const Unit& u, int wr, int wc, int fr, int fq, State& st, bool has_next, const Unit& nxt) const {
        float v[2][16]; rstd_issue(ssq, nslots, mrows, has_next ? nxt.pm : u.pm, wr, fq * 16 + fr, v);
        const int row0 = u.pm * BM + wr * 64 + fr, col0 = u.pn * HALF + wc * 32 + 8 * fq;
#pragma unroll
        for (int ai = 0; ai < 2; ++ai)
#pragma unroll
            for (int m = 0; m < 4; ++m) { const float sc = __shfl(st.rs[ai], 16 * m + fr); bf16_t* rowp = O + (size_t)(row0 + ai * HALF + m * 16) * ldc + col0;
                const float k1 = -sc * 1.4426950408889634f, s2 = sc * sc;
                f32x4 hv[2];
#pragma unroll
                for (int n = 0; n < 2; ++n) { const f32x4 ag = acc[ai][0][m][n], au = acc[ai][1][m][n], t = ag * k1; f32x4 r;
#pragma unroll
                    for (int i = 0; i < 4; ++i) r[i] = __builtin_amdgcn_rcpf(1.0f + __builtin_amdgcn_exp2f(t[i]));
                    hv[n] = (ag * au) * (r * s2); }
                u32x4 w; w.x = cvt_pk_bf16(hv[0][0], hv[0][1]); w.y = cvt_pk_bf16(hv[0][2], hv[0][3]); w.z = cvt_pk_bf16(hv[1][0], hv[1][1]); w.w = cvt_pk_bf16(hv[1][2], hv[1][3]);
                store16_wt<0>(rowp, w); }
        { rstd_finish(v, st.rs); asm volatile("" : "+v"(st.rs[0]), "+v"(st.rs[1])); }
    }
};
__device__ __forceinline__ float bf_lo(unsigned w) { return __uint_as_float(w << 16); }
__device__ __forceinline__ float bf_hi(unsigned w) { return __uint_as_float(w & 0xffff0000u); }
template <bool LAST> struct EpiResid {
    static constexpr bool PERM = true, AFTER_DRAIN = false;
    struct State {};
    bf16_t* xb; float* out; float* ssq_out; int mrows;
    __device__ __forceinline__ void init(State&, const Unit&, int, int) const {}
    __device__ __forceinline__ void acc_init(f32x4 (&acc)[2][2][4][2], const Unit& u, int wr, int wc, int fr, int fq) const {
        const int lrow0 = wr * 64 + fr, col0 = u.pn * BM + wc * 32 + 8 * fq;
        u32x4 b[2][4][2];
#pragma unroll
        for (int ai = 0; ai < 2; ++ai)
#pragma unroll
            for (int m = 0; m < 4; ++m)
#pragma unroll
                for (int bj = 0; bj < 2; ++bj) b[ai][m][bj] = *(const u32x4*)(xb + ((size_t)u.pm * BM + lrow0 + ai * HALF + m * 16) * 1024 + col0 + bj * HALF);
#pragma unroll
        for (int ai = 0; ai < 2; ++ai)
#pragma unroll
            for (int m = 0; m < 4; ++m)
#pragma unroll
                for (int bj = 0; bj < 2; ++bj) { const u32x4 w = b[ai][m][bj];
                    acc[ai][bj][m][0] = (f32x4){bf_lo(w.x), bf_hi(w.x), bf_lo(w.y), bf_hi(w.y)}; acc[ai][bj][m][1] = (f32x4){bf_lo(w.z), bf_hi(w.z), bf_lo(w.w), bf_hi(w.w)}; }
    }
    __device__ __forceinline__ void operator()(const f32x4 (&acc)[2][2][4][2], const Unit& u, int wr, int wc, int fr, int fq, State&, bool, const Unit&) const {
        const int lrow0 = wr * 64 + fr, col0 = u.pn * BM + wc * 32 + 8 * fq;
#pragma unroll
        for (int ai = 0; ai < 2; ++ai)
#pragma unroll
            for (int m = 0; m < 4; ++m) { const size_t grow = (size_t)u.pm * BM + lrow0 + ai * HALF + m * 16; float q = 0.f;
#pragma unroll
                for (int bj = 0; bj < 2; ++bj) { const f32x4 v0 = acc[ai][bj][m][0], v1 = acc[ai][bj][m][1];
                    if (LAST) { float* op = out + grow * 1024 + col0 + bj * HALF; *(f32x4*)op = v0; *(f32x4*)(op + 4) = v1; }
                    else { u32x4 w; w.x = cvt_pk_bf16(v0[0], v0[1]); w.y = cvt_pk_bf16(v0[2], v0[3]); w.z = cvt_pk_bf16(v1[0], v1[1]); w.w = cvt_pk_bf16(v1[2], v1[3]); if (bj == 0) store16_wt<0>(xb + grow * 1024 + col0, w); else store16_wt<HALF * 2>(xb + grow * 1024 + col0, w); }
                    q += ((v0[0] * v0[0] + v0[1] * v0[1]) + (v0[2] * v0[2] + v0[3] * v0[3])) + ((v1[0] * v1[0] + v1[1] * v1[1]) + (v1[2] * v1[2] + v1[3] * v1[3])); }
                q += __shfl_xor(q, 16); q += __shfl_xor(q, 32);
                if (fq == 0) ssq_out[(size_t)(u.pn * 4 + wc) * mrows + grow] = q; }
    }
};

template <int K> struct EpiResidTail {
    static constexpr bool PERM = true, AFTER_DRAIN = true;
    struct State {};
    bf16_t* xb; float* ssq_out; int mrows;
    const bf16_t* As; const bf16_t* Bt; int tile;
    bf16_t* xbs; float* ssq_rows;
    __device__ __forceinline__ void init(State&, const Unit&, int, int) const {}
    __device__ __forceinline__ void acc_init(f32x4 (&acc)[2][2][4][2], const Unit& u, int wr, int wc, int fr, int fq) const {
        const int lrow0 = wr * 64 + fr, col0 = u.pn * BM + wc * 32 + 8 * fq;
        u32x4 b[2][4][2];
#pragma unroll
        for (int ai = 0; ai < 2; ++ai)
#pragma unroll
            for (int m = 0; m < 4; ++m)
#pragma unroll
                for (int bj = 0; bj < 2; ++bj) b[ai][m][bj] = *(const u32x4*)(xb + ((size_t)u.pm * BM + lrow0 + ai * HALF + m * 16) * 1024 + col0 + bj * HALF);
#pragma unroll
        for (int ai = 0; ai < 2; ++ai)
#pragma unroll
            for (int m = 0; m < 4; ++m)
#pragma unroll
                for (int bj = 0; bj < 2; ++bj) { const u32x4 w = b[ai][m][bj];
                    acc[ai][bj][m][0] = (f32x4){bf_lo(w.x), bf_hi(w.x), bf_lo(w.y), bf_hi(w.y)}; acc[ai][bj][m][1] = (f32x4){bf_lo(w.z), bf_hi(w.z), bf_lo(w.w), bf_hi(w.w)}; }
    }
    __device__ __forceinline__ void main_group(const f32x4 (&acc)[2][2][4][2], const Unit& u, int g, int wr, int wc, int fr, int fq) const {
        const int ai = g >> 2, m = g & 3;
        const size_t grow = (size_t)u.pm * BM + wr * 64 + fr + ai * HALF + m * 16; const int col0 = u.pn * BM + wc * 32 + 8 * fq; float q = 0.f;
#pragma unroll
        for (int bj = 0; bj < 2; ++bj) { const f32x4 v0 = acc[ai][bj][m][0], v1 = acc[ai][bj][m][1];
            u32x4 w; w.x = cvt_pk_bf16(v0[0], v0[1]); w.y = cvt_pk_bf16(v0[2], v0[3]); w.z = cvt_pk_bf16(v1[0], v1[1]); w.w = cvt_pk_bf16(v1[2], v1[3]);
            if (bj == 0) store16_wt<0>(xb + grow * 1024 + col0, w); else store16_wt<HALF * 2>(xb + grow * 1024 + col0, w);
            q += ((v0[0] * v0[0] + v0[1] * v0[1]) + (v0[2] * v0[2] + v0[3] * v0[3])) + ((v1[0] * v1[0] + v1[1] * v1[1]) + (v1[2] * v1[2] + v1[3] * v1[3])); }
        q += __shfl_xor(q, 16); q += __shfl_xor(q, 32);
        if (fq == 0) ssq_out[(size_t)(u.pn * 4 + wc) * mrows + grow] = q;
    }
    __device__ __forceinline__ void fused(f32x4 (&acc)[2][2][4][2], const Unit& u, int wr, int wc, int fr, int fq, PG8_LAS unsigned char* lds, int wave, int lane) const {
        const int tid = wave * 64 + lane; PG8_LAS float* red = (PG8_LAS float*)lds;
        const int row0 = (tile >> 4) * 32, col0t = (tile & 15) * 64, tc = tile & 15;
        constexpr int KW = K / 8, STEPS = KW / 32; static_assert(KW % 32 == 0, "K split");
        constexpr int GPS = (8 + STEPS - 1) / STEPS;
        f32x4 at[2][4];
#pragma unroll
        for (int m = 0; m < 2; ++m)
#pragma unroll
            for (int n = 0; n < 4; ++n) at[m][n] = (f32x4){0.f, 0.f, 0.f, 0.f};
        const bf16_t* ap = As + (size_t)(row0 + fr) * K + wave * KW + 8 * fq;
        const bf16_t* bp = Bt + (size_t)(col0t + fr) * K + wave * KW + 8 * fq;
        bf16x8 a[2][2], b[2][4];
#pragma unroll
        for (int m = 0; m < 2; ++m) a[0][m] = *(const bf16x8*)(ap + (size_t)(16 * m) * K);
#pragma unroll
        for (int n = 0; n < 4; ++n) b[0][n] = *(const bf16x8*)(bp + (size_t)(16 * n) * K);
#pragma unroll
        for (int s = 0; s < STEPS; ++s) {
            if (s + 1 < STEPS) {
#pragma unroll
                for (int m = 0; m < 2; ++m) a[(s + 1) & 1][m] = *(const bf16x8*)(ap + (size_t)(16 * m) * K + 32 * (s + 1));
#pragma unroll
                for (int n = 0; n < 4; ++n) b[(s + 1) & 1][n] = *(const bf16x8*)(bp + (size_t)(16 * n) * K + 32 * (s + 1));
            }
#pragma unroll
            for (int gg = 0; gg < GPS; ++gg) if (s * GPS + gg < 8) main_group(acc, u, s * GPS + gg, wr, wc, fr, fq);
#pragma unroll
            for (int m = 0; m < 2; ++m)
#pragma unroll
                for (int n = 0; n < 4; ++n) at[m][n] = __builtin_amdgcn_mfma_f32_16x16x32_bf16(b[s & 1][n], a[s & 1][m], at[m][n], 0, 0, 0);
        }
#pragma unroll
        for (int m = 0; m < 2; ++m)
#pragma unroll
            for (int n = 0; n < 4; ++n) *(PG8_LAS f32x4*)(red + ((wave * 32 + 16 * m + fr) * 64 + 16 * n + 4 * fq)) = at[m][n];
        asm volatile("s_waitcnt lgkmcnt(0)" ::: "memory"); __builtin_amdgcn_s_barrier(); asm volatile("" ::: "memory");
        const int r = tid >> 4, c4 = (tid & 15) * 4;
        bf16_t* xp = xbs + (size_t)(row0 + r) * 1024 + col0t + c4;
        const unsigned long long bw = *(const unsigned long long*)xp;
        f32x4 v = (f32x4){bf_lo((unsigned)bw), bf_hi((unsigned)bw), bf_lo((unsigned)(bw >> 32)), bf_hi((unsigned)(bw >> 32))};
#pragma unroll
        for (int w = 0; w < 8; ++w) v += *(const PG8_LAS f32x4*)(red + ((w * 32 + r) * 64 + c4));
        *(unsigned long long*)xp = (unsigned long long)cvt_pk_bf16(v[0], v[1]) | ((unsigned long long)cvt_pk_bf16(v[2], v[3]) << 32);
        float q = (v[0] * v[0] + v[1] * v[1]) + (v[2] * v[2] + v[3] * v[3]);
        q += __shfl_xor(q, 1); q += __shfl_xor(q, 2); q += __shfl_xor(q, 4); q += __shfl_xor(q, 8);
        if ((tid & 15) == 0) ssq_rows[(size_t)tc * mrows + row0 + r] = q;
    }
};
template <class Epi, class Sched, bool ALIGN_EPI = false, bool SP2 = false>
__device__ __forceinline__ void gemm_phase(PG8_LAS unsigned char* lds, const Gemm g, const Sched& S, const Epi& E) {
    int tid_ = threadIdx.x; asm volatile("" : "+v"(tid_));
    const int tid = tid_, wid = __builtin_amdgcn_readfirstlane(tid >> 6), lane = tid & 63, wr = wid >> 2, wc = wid & 3, fr = lane & 15, fq = lane >> 4;
    const int K = g.K, nt = K / BK;
    unsigned voffA[2], voffB[2];
#pragma unroll
    for (int i = 0; i < 2; ++i) { int R, C; stage_rc(tid * 16 + i * 8192, R, C); const int Rb = Epi::PERM ? ((R & ~31) + perm32(R & 31)) : R;
        voffA[i] = (unsigned)(R * K + C) * 2u; voffB[i] = (unsigned)(Rb * K + C) * 2u; }
    const size_t kstep = (size_t)(BK * 2);
    const size_t hstep = (size_t)HALF * K * 2;
    const size_t tstep = 2 * hstep;
    const unsigned ldsw = (unsigned)wid * 1024u;
    const int aoff = lds_byte(wr * 64 + fr, fq * 8), boff = lds_byte(wc * 32 + fr, fq * 8);
#define PG8_SA(b, h) (((b) * 2 + (h)) * HTB)
#define PG8_SB(b, h) ((4 + (b) * 2 + (h)) * HTB)
#define PG8_STAGE(bufoff, gbase, voff) do { _Pragma("unroll") for (int _i = 0; _i < 2; ++_i) \
        __builtin_amdgcn_global_load_lds((const unsigned*)((const char*)(gbase) + (voff)[_i]), (PG8_LAS unsigned*)(lds + (bufoff) + ldsw + _i * 8192), 16, 0, 0); } while (0)
#define PG8_LDA(dst, b, h) do { _Pragma("unroll") for (int m = 0; m < 4; ++m) _Pragma("unroll") for (int k = 0; k < 2; ++k) dst[m][k] = *(const PG8_LAS bf16x8*)(lds + PG8_SA(b, h) + aoff + m * 2048 + k * 1024); } while (0)
#define PG8_LDB(dst, b, h) do { _Pragma("unroll") for (int n = 0; n < 2; ++n) _Pragma("unroll") for (int k = 0; k < 2; ++k) dst[n][k] = *(const PG8_LAS bf16x8*)(lds + PG8_SB(b, h) + boff + n * 2048 + k * 1024); } while (0)
#define PG8_MMA(ai, bj, At, Bt) do { __builtin_amdgcn_s_setprio(1); _Pragma("unroll") for (int m = 0; m < 4; ++m) _Pragma("unroll") for (int n = 0; n < 2; ++n) _Pragma("unroll") for (int k = 0; k < 2; ++k) \
        acc[ai][bj][m][n] = __builtin_amdgcn_mfma_f32_16x16x32_bf16(Bt[n][k], At[m][k], acc[ai][bj][m][n], 0, 0, 0); __builtin_amdgcn_s_setprio(0); } while (0)
#define PG8_WAIT_V(n) asm volatile("s_waitcnt vmcnt(" #n ")" ::: "memory")
#define PG8_WAIT_L(n) asm volatile("s_waitcnt lgkmcnt(" #n ")" ::: "memory")
#define PG8_BAR __builtin_amdgcn_s_barrier()
#define PG8_SCHED __builtin_amdgcn_sched_barrier(0)
    Unit cur, nxt; int ui = 0;
    if (!S.next(0, cur)) return;
    f32x4 acc[2][2][4][2];
#pragma unroll
    for (int a = 0; a < 2; ++a)
#pragma unroll
        for (int b = 0; b < 2; ++b)
#pragma unroll
            for (int m = 0; m < 4; ++m)
#pragma unroll
                for (int n = 0; n < 2; ++n) acc[a][b][m][n] = (f32x4){0.f, 0.f, 0.f, 0.f};
    bf16x8 At[4][2], B0[2][2], B1[2][2];
    const char* cA = (const char*)g.A + (size_t)cur.pm * tstep; const char* cB = (const char*)g.Bt + (size_t)cur.pn * tstep;
    S.a_ready(cur);
    typename Epi::State est;
    if constexpr (SP2) {
        PG8_STAGE(PG8_SB(0, 0), cB, voffB); PG8_STAGE(PG8_SB(0, 1), cB + hstep, voffB); PG8_STAGE(PG8_SA(0, 0), cA, voffA); PG8_STAGE(PG8_SA(0, 1), cA + hstep, voffA);
        E.init(est, cur, wr, lane); E.acc_init(acc, cur, wr, wc, fr, fq);
        if (wr == 1) PG8_BAR;
        PG8_WAIT_V(2); PG8_BAR;
        PG8_STAGE(PG8_SB(1, 0), cB + kstep, voffB); PG8_STAGE(PG8_SA(1, 0), cA + kstep, voffA); PG8_STAGE(PG8_SB(1, 1), cB + hstep + kstep, voffB);
        PG8_WAIT_V(6); PG8_BAR;
    } else {
        PG8_STAGE(PG8_SB(0, 0), cB, voffB); PG8_STAGE(PG8_SA(0, 0), cA, voffA); PG8_STAGE(PG8_SB(0, 1), cB + hstep, voffB); PG8_STAGE(PG8_SA(0, 1), cA + hstep, voffA);
        E.init(est, cur, wr, lane); E.acc_init(acc, cur, wr, wc, fr, fq);
        if (wr == 1) PG8_BAR;
        PG8_WAIT_V(4); PG8_BAR;
        PG8_STAGE(PG8_SB(1, 0), cB + kstep, voffB); PG8_STAGE(PG8_SA(1, 0), cA + kstep, voffA); PG8_STAGE(PG8_SB(1, 1), cB + hstep + kstep, voffB);
        PG8_WAIT_V(6); PG8_BAR;
    }
    for (;;) {
        const bool has_next = S.next(ui + 1, nxt);
        const char* nA = has_next ? (const char*)g.A + (size_t)nxt.pm * tstep : cA; const char* nB = has_next ? (const char*)g.Bt + (size_t)nxt.pn * tstep : cB;
        for (int t = 0; t < nt; t += 2) {
            const bool last = (t == nt - 2);
            const char* a1 = cA + (size_t)(t + 1) * kstep;
            const char* a2 = last ? nA : cA + (size_t)(t + 2) * kstep; const char* b2 = last ? nB : cB + (size_t)(t + 2) * kstep;
            const char* a3 = a2 + kstep; const char* b3 = b2 + kstep;
            if (last && has_next) S.a_ready(nxt);
            if constexpr (SP2) {
            PG8_LDB(B0, 0, 0); PG8_LDB(B1, 0, 1); PG8_SCHED; PG8_LDA(At, 0, 0); PG8_STAGE(PG8_SA(1, 1), a1 + hstep, voffA);
            PG8_WAIT_V(8); PG8_WAIT_L(0); PG8_BAR; PG8_MMA(0, 0, At, B0); PG8_MMA(0, 1, At, B1); PG8_BAR; PG8_SCHED;
            PG8_LDA(At, 0, 1); PG8_STAGE(PG8_SB(0, 0), b2, voffB); PG8_STAGE(PG8_SB(0, 1), b2 + hstep, voffB); PG8_STAGE(PG8_SA(0, 0), a2, voffA);
            PG8_WAIT_V(8); PG8_WAIT_L(0); PG8_BAR; PG8_MMA(1, 0, At, B0); PG8_MMA(1, 1, At, B1); PG8_BAR; PG8_SCHED;
            PG8_LDB(B0, 1, 0); PG8_LDB(B1, 1, 1); PG8_SCHED; PG8_LDA(At, 1, 0); PG8_STAGE(PG8_SA(0, 1), a2 + hstep, voffA);
            PG8_WAIT_V(8); PG8_WAIT_L(0); PG8_BAR; PG8_MMA(0, 0, At, B0); PG8_MMA(0, 1, At, B1); PG8_BAR; PG8_SCHED;
            PG8_LDA(At, 1, 1); PG8_STAGE(PG8_SB(1, 0), b3, voffB); PG8_STAGE(PG8_SB(1, 1), b3 + hstep, voffB); PG8_STAGE(PG8_SA(1, 0), a3, voffA);
            PG8_WAIT_V(8); PG8_WAIT_L(0); PG8_BAR; PG8_MMA(1, 0, At, B0); PG8_MMA(1, 1, At, B1); PG8_BAR; PG8_SCHED;
            } else {
            PG8_LDB(B0, 0, 0); PG8_SCHED; PG8_LDA(At, 0, 0); PG8_STAGE(PG8_SA(1, 1), a1 + hstep, voffA);
            PG8_WAIT_L(8); PG8_BAR; PG8_WAIT_L(0); PG8_MMA(0, 0, At, B0); PG8_BAR; PG8_SCHED;
            PG8_LDB(B1, 0, 1); PG8_STAGE(PG8_SB(0, 0), b2, voffB);
            PG8_BAR; PG8_WAIT_L(0); PG8_MMA(0, 1, At, B1); PG8_BAR;
            PG8_LDA(At, 0, 1); PG8_STAGE(PG8_SA(0, 0), a2, voffA);
            PG8_BAR; PG8_WAIT_L(0); PG8_MMA(1, 0, At, B0); PG8_BAR; PG8_SCHED;
            PG8_STAGE(PG8_SB(0, 1), b2 + hstep, voffB);
            PG8_WAIT_V(6); PG8_BAR; PG8_MMA(1, 1, At, B1); PG8_BAR;
            PG8_LDB(B0, 1, 0); PG8_SCHED; PG8_LDA(At, 1, 0); PG8_STAGE(PG8_SA(0, 1), a2 + hstep, voffA);
            PG8_WAIT_L(8); PG8_BAR; PG8_WAIT_L(0); PG8_MMA(0, 0, At, B0); PG8_BAR; PG8_SCHED;
            PG8_LDB(B1, 1, 1); PG8_STAGE(PG8_SB(1, 0), b3, voffB);
            PG8_BAR; PG8_WAIT_L(0); PG8_MMA(0, 1, At, B1); PG8_BAR;
            PG8_LDA(At, 1, 1); PG8_STAGE(PG8_SA(1, 0), a3, voffA);
            PG8_BAR; PG8_WAIT_L(0); PG8_MMA(1, 0, At, B0); PG8_BAR; PG8_SCHED;
            PG8_STAGE(PG8_SB(1, 1), b3 + hstep, voffB);
            PG8_WAIT_V(6); PG8_BAR; PG8_MMA(1, 1, At, B1); PG8_BAR;
            }
        }
        if constexpr (ALIGN_EPI) { if (wr == 0) PG8_BAR; }
        if constexpr (!Epi::AFTER_DRAIN) { E(acc, cur, wr, wc, fr, fq, est, has_next, nxt); S.done(cur); }
        if (!has_next) break;
#pragma unroll
        for (int a = 0; a < 2; ++a)
#pragma unroll
            for (int b = 0; b < 2; ++b)
#pragma unroll
                for (int m = 0; m < 4; ++m)
#pragma unroll
                    for (int n = 0; n < 2; ++n) acc[a][b][m][n] = (f32x4){0.f, 0.f, 0.f, 0.f};
        cur = nxt; cA = nA; cB = nB; ++ui;
        E.acc_init(acc, cur, wr, wc, fr, fq);
        if constexpr (ALIGN_EPI) { if (wr == 1) PG8_BAR; }
    }
    PG8_WAIT_V(0);
    if constexpr (!ALIGN_EPI) { if (wr == 0) PG8_BAR; }
    PG8_BAR;
    if constexpr (Epi::AFTER_DRAIN) { E.fused(acc, cur, wr, wc, fr, fq, lds, wid, lane); S.done(cur); }
#undef PG8_SA
#undef PG8_SB
#undef PG8_STAGE
#undef PG8_LDA
#undef PG8_LDB
#undef PG8_MMA
#undef PG8_WAIT_V
#undef PG8_WAIT_L
#undef PG8_BAR
#undef PG8_SCHED
}
}

#ifndef PROBE_TS
#define PROBE_TS 0
#endif
#ifndef PROBE_PH
#define PROBE_PH 0
#endif
constexpr int NWAVES = 8;
constexpr int DM = 1024, SEQ = 8192, NBATCH = 2, DBATCH = 128, DT = 4, MP = NBATCH * SEQ, MS = DBATCH * DT, M = MP + MS;
constexpr int NIN = 2304, DFF = 2816, NGU = 2 * DFF, WIN = 128, NLAYER = 2;
constexpr int ZP = 1792;
constexpr int ZQ = 0, ZK = 512, ZV = 640, ZGB = 768, ZCU = 1280;
constexpr float ATT_SCALE = 0.125f, EPS = 1e-6f;
constexpr size_t OUT_Y = 0, OUT_NKP = (size_t)M * DM, OUT_NVP = OUT_NKP + (size_t)NLAYER * NBATCH * WIN * 128, OUT_NCP = OUT_NVP + (size_t)NLAYER * NBATCH * WIN * 128,
                 OUT_NKS = OUT_NCP + (size_t)NLAYER * NBATCH * 2 * 512, OUT_NVS = OUT_NKS + (size_t)NLAYER * DBATCH * WIN * 128, OUT_NCS = OUT_NVS + (size_t)NLAYER * DBATCH * WIN * 128,
                 OUT_END = OUT_NCS + (size_t)NLAYER * DBATCH * 2 * 512;
static_assert(OUT_END == 26087424, "output size");
constexpr size_t MiB = 1u << 20;
constexpr size_t WS_CTL = 0, CTL_ZERO_BYTES = 32 * 1024;
constexpr size_t WS_WIN = 2 * MiB, WS_WOUT = 11 * MiB, WS_WGU = 15 * MiB, WS_WDN = 37 * MiB;
constexpr size_t WS_SSQA = 48 * MiB, WS_SSQD = 50 * MiB;
constexpr size_t WS_XB = 52 * MiB;
constexpr size_t WS_Z = 86 * MiB;
constexpr size_t WS_MB = 161 * MiB;
constexpr size_t WS_HB = 86 * MiB;
constexpr size_t WS_END = 194 * MiB;
static_assert(WS_WIN + (size_t)NLAYER * NIN * DM * 2 <= WS_WOUT && WS_WOUT + (size_t)NLAYER * DM * DM * 2 <= WS_WGU && WS_WGU + (size_t)NLAYER * NGU * DM * 2 <= WS_WDN && WS_WDN + (size_t)NLAYER * DM * DFF * 2 <= WS_SSQA, "ws weights");
static_assert(WS_SSQA + (size_t)M * 64 <= WS_SSQD && WS_SSQD + (size_t)M * 64 <= WS_XB && WS_XB + (size_t)M * DM * 2 <= WS_Z && WS_Z + (size_t)M * ZP * 2 <= WS_MB && WS_MB + (size_t)M * DM * 2 <= WS_END && WS_HB + (size_t)M * DFF * 2 <= WS_END, "ws activations");
constexpr int CW_TMO = 0, CW_CODE = 1, CW_BAR = 4096;
static_assert((CW_BAR + 3456) * 4 <= (int)CTL_ZERO_BYTES, "barrier words inside the zeroed region");
constexpr int RING_OFF = 0, RING_BYTES = 131072;
constexpr int LDS_BYTES = 163840;
constexpr int LDSCTL_BYTES = 512, LDSCTL_OFF = LDS_BYTES - LDSCTL_BYTES, MISC_OFF = LDSCTL_OFF + 320;
static_assert(MISC_OFF + 128 <= LDS_BYTES, "LDS map");
#define GAS __attribute__((address_space(1)))
#define LAS __attribute__((address_space(3)))
typedef unsigned short bf16;
typedef unsigned v4u __attribute__((ext_vector_type(4)));
typedef float f32x4 __attribute__((ext_vector_type(4)));
typedef short bf16x8 __attribute__((ext_vector_type(8)));
typedef GAS unsigned gu32;
typedef GAS unsigned long long gu64;
#define RLX_AGENT __ATOMIC_RELAXED, __HIP_MEMORY_SCOPE_AGENT
#define LDS_WAIT() asm volatile("s_waitcnt lgkmcnt(0)" ::: "memory")
#define VM_WAIT() asm volatile("s_waitcnt vmcnt(0)" ::: "memory")
__device__ __forceinline__ unsigned long long rt() { return __builtin_amdgcn_s_memrealtime(); }
__device__ __forceinline__ unsigned f2bf(float f) { unsigned u = __builtin_bit_cast(unsigned, f); return (u + 0x7fffu + ((u >> 16) & 1u)) >> 16; }
__device__ __forceinline__ unsigned pk2(float lo, float hi) { return f2bf(lo) | (f2bf(hi) << 16); }

#define XB_TMO      128
#define XB_XCNT(j)  (256  + 64 * (j))
#define XB_XSUB(j)  (1280 + 64 * (j))
#define XB_XGEN(j)  (2304 + 64 * (j))
#define XB_TOP      3328
#define XB_TOPGEN   3392
#define XCD_BAR_WORDS 3456
#define XB_SPIN_CAP (1u << 18)
#ifndef XB_POLL_TOP
#define XB_POLL_TOP 1
#endif
#ifndef XB_FLAT_REL
#define XB_FLAT_REL 0
#endif

__device__ __forceinline__ unsigned xb_ld(unsigned* p)              { return __hip_atomic_load(p, __ATOMIC_RELAXED, __HIP_MEMORY_SCOPE_AGENT); }
__device__ __forceinline__ unsigned xb_add(unsigned* p, unsigned v) { return __hip_atomic_fetch_add(p, v, __ATOMIC_RELAXED, __HIP_MEMORY_SCOPE_AGENT); }
__device__ __forceinline__ unsigned xb_xcc_id() { return (unsigned)__builtin_amdgcn_s_getreg((3 << 11) | 20) & 0xFu; }
#define XB_SPIN(cond, bar) do { unsigned _sp = 0; while (cond) { __builtin_amdgcn_s_sleep(1); \
    if ((++_sp & 255u) == 0u) { if (xb_ld(&(bar)[XB_TMO])) break; if (_sp > XB_SPIN_CAP) { atomicAdd(&(bar)[XB_TMO], 1u); break; } } } } while (0)

struct XcdBarrier {
    unsigned* bar; unsigned x;
    volatile LAS unsigned* st;
};

__device__ __forceinline__ XcdBarrier xcd_barrier_post(unsigned* bar, volatile LAS unsigned* st) {
    XcdBarrier b; b.bar = bar; b.x = xb_xcc_id(); b.st = st;
    if (threadIdx.x == 0) (void)xb_add(&bar[XB_XCNT(b.x)], 1u);
    return b;
}
__device__ __forceinline__ void xcd_barrier_complete(unsigned* bar, unsigned x, unsigned& nloc, unsigned& nx) {
    const unsigned G = gridDim.x * gridDim.y * gridDim.z;
    unsigned sum, cnt, mine, sp = 0u;
    for (;;) {
        sum = 0u; cnt = 0u; mine = 0u;
#pragma unroll
        for (unsigned j = 0; j < 16; ++j) { const unsigned c = xb_ld(&bar[XB_XCNT(j)]); sum += c; cnt += (c > 0u) ? 1u : 0u; mine = (j == x) ? c : mine; }
        if (sum == G) break;
        __builtin_amdgcn_s_sleep(1);
        if ((++sp & 255u) == 0u) { if (xb_ld(&bar[XB_TMO])) break; if (sp > XB_SPIN_CAP) { atomicAdd(&bar[XB_TMO], 1u); break; } }
    }
    nloc = mine > 0u ? mine : 1u; nx = cnt > 0u ? cnt : 1u;
}

template <bool REL = true> __device__ __forceinline__ void xcd_barrier(const XcdBarrier& b) {
    asm volatile("s_waitcnt vmcnt(0)" ::: "memory");
    __syncthreads();
    if (threadIdx.x == 0) {
        unsigned* bar = b.bar;
        __builtin_amdgcn_s_waitcnt(0);
        asm volatile("buffer_inv sc1" ::: "memory");
        unsigned nloc = b.st[0], nx = b.st[1];
        if (nloc == 0u) { xcd_barrier_complete(bar, b.x, nloc, nx); b.st[0] = nloc; b.st[1] = nx; }
        const unsigned old = xb_add(&bar[XB_XSUB(b.x)], 1u);
        const unsigned gen = old / nloc;
        if (old + 1u == (gen + 1u) * nloc) {
            if (REL) __builtin_amdgcn_fence(__ATOMIC_RELEASE, "agent");
            asm volatile("s_waitcnt vmcnt(0)" ::: "memory");
            const unsigned og = xb_add(&bar[XB_TOP], 1u);
            const unsigned tg = og / nx;
#if XB_POLL_TOP
            const unsigned tgt = (tg + 1u) * nx;
            if (og + 1u != tgt) XB_SPIN((int)(xb_ld(&bar[XB_TOP]) - tgt) < 0, bar);
#else
            if (og + 1u == (tg + 1u) * nx) xb_add(&bar[XB_TOPGEN], 1u);
            else XB_SPIN(xb_ld(&bar[XB_TOPGEN]) == tg, bar);
#endif
            asm volatile("" ::: "memory");
#if !XB_FLAT_REL
            xb_add(&bar[XB_XGEN(b.x)], 1u);
#endif
            asm volatile("s_waitcnt vmcnt(0)" ::: "memory");
        } else {
#if XB_FLAT_REL
            { const unsigned tgt = (gen + 1u) * nx; XB_SPIN((int)(xb_ld(&bar[XB_TOP]) - tgt) < 0, bar); }
#else
            XB_SPIN(xb_ld(&bar[XB_XGEN(b.x)]) == gen, bar);
#endif
            asm volatile("" ::: "memory");
            asm volatile("s_waitcnt vmcnt(0)" ::: "memory");
        }
    }
    __syncthreads();
}

struct Frame {
    LAS unsigned char* lds;
    volatile LAS unsigned* MISC;
    gu32* ctl;
    int tid, lane, wave;
    int vcu, G;
};
constexpr unsigned char BUCKET_C[128] = {0, 1, 2, 3, 4, 5, 6, 7, 8, 9, 10, 11, 12, 13, 14, 15, 16, 16, 16, 17, 17, 18, 18, 18, 19, 19, 19, 20, 20, 20, 20, 21, 21, 21, 21, 22, 22, 22, 22, 22, 23, 23, 23, 23, 23, 23, 24, 24, 24, 24, 24, 24, 25, 25, 25, 25, 25, 25, 25, 26, 26, 26, 26, 26, 26, 26, 26, 27, 27, 27, 27, 27, 27, 27, 27, 27, 27, 28, 28, 28, 28, 28, 28, 28, 28, 28, 28, 29, 29, 29, 29, 29, 29, 29, 29, 29, 29, 29, 29, 30, 30, 30, 30, 30, 30, 30, 30, 30, 30, 30, 30, 30, 30, 31, 31, 31, 31, 31, 31, 31, 31, 31, 31, 31, 31, 31, 31, 31};
__host__ __device__ constexpr int bucket_of(int d) { return d < 16 ? d : 16 + (d >= 19) + (d >= 21) + (d >= 24) + (d >= 27) + (d >= 31) + (d >= 35) + (d >= 40) + (d >= 46) + (d >= 52) + (d >= 59) + (d >= 67) + (d >= 77) + (d >= 87) + (d >= 99) + (d >= 113); }
constexpr bool bucket_ok() { for (int d = 0; d < 128; ++d) if (bucket_of(d) != BUCKET_C[d]) return false; return true; }
static_assert(bucket_ok(), "bucket_of");

__device__ __forceinline__ float wave_sum(float v) {
#pragma unroll
    for (int o = 1; o < 64; o <<= 1) v += __shfl_xor(v, o);
    return v;
}
__device__ __forceinline__ float wave_max(float v) {
#pragma unroll
    for (int o = 1; o < 64; o <<= 1) v = fmaxf(v, __shfl_xor(v, o));
    return v;
}
__device__ __forceinline__ float bf2f(bf16 u) { return __uint_as_float((unsigned)u << 16); }
__device__ __forceinline__ float bflo(unsigned w) { return __uint_as_float(w << 16); }
__device__ __forceinline__ float bfhi(unsigned w) { return __uint_as_float(w & 0xffff0000u); }

__device__ __forceinline__ void st16_wt(void* p, v4u v) { asm volatile("global_store_dwordx4 %0, %1, off sc1\n\ts_nop 1" :: "v"(p), "v"(v) : "memory"); }
__device__ __forceinline__ void st8_wt(void* p, unsigned long long v) { asm volatile("global_store_dwordx2 %0, %1, off sc1\n\ts_nop 1" :: "v"(p), "v"(v) : "memory"); }
struct Args { const float* in[17]; float* out; unsigned char* ws; };
typedef const __attribute__((address_space(4))) Args* KArgs;
enum { I_XP = 0, I_XS = 1, I_CK = 2, I_CV = 3, I_ST = 4, I_RB = 5, I_AN = 6, I_WIN = 7, I_SK = 8, I_CW = 9, I_MN = 10, I_WOUT = 11, I_FN = 12, I_WG = 13, I_WU = 14, I_WD = 15, I_FIN = 16 };
#define WSP(T, off) ((T*)(args->ws + (off)))
__device__ __forceinline__ void cvt_item(const float* W, const float* gain, int K, int N, bf16* WT, int kb, int n0, int dst_row0, int lane) {
    const int k0 = 32 * kb; const float* wp = W + (size_t)k0 * N + n0 + lane;
    float v[32];
#pragma unroll
    for (int j = 0; j < 32; ++j) v[j] = __builtin_nontemporal_load(wp + (size_t)j * N);
    if (gain) {
#pragma unroll
        for (int j = 0; j < 32; ++j) v[j] *= gain[k0 + j]; }
    bf16* op = WT + (size_t)(dst_row0 + lane) * K + k0;
#pragma unroll
    for (int c = 0; c < 4; ++c) { v4u o; o.x = pk2(v[8 * c], v[8 * c + 1]); o.y = pk2(v[8 * c + 2], v[8 * c + 3]); o.z = pk2(v[8 * c + 4], v[8 * c + 5]); o.w = pk2(v[8 * c + 6], v[8 * c + 7]); *(GAS v4u*)(op + 8 * c) = o; }
}
constexpr int CI_IN = 0, CI_OUT = 1152, CI_G = 1664, CI_U = 3072, CI_D = 4480, CI_END = 5888;
__device__ __forceinline__ void cvt_layer_item(KArgs args, int l, int r, int lane) {
    if (r < CI_OUT) { const int nb = r % (NIN / 64), kb = r / (NIN / 64), n0 = 64 * nb;
        const int d0 = n0 < 1280 ? n0 : (n0 < 1792 ? 1280 + ((n0 - 1280) / 128) * 256 + (n0 - 1280) % 128 : 1280 + ((n0 - 1792) / 128) * 256 + 128 + (n0 - 1792) % 128);
        cvt_item(args->in[I_WIN] + (size_t)l * DM * NIN, args->in[I_AN] + l * DM, DM, NIN, WSP(bf16, WS_WIN) + (size_t)l * NIN * DM, kb, n0, d0, lane); return; }
    if (r < CI_G) { r -= CI_OUT; const int nb = r % (DM / 64), kb = r / (DM / 64); cvt_item(args->in[I_WOUT] + (size_t)l * DM * DM, args->in[I_MN] + l * DM, DM, DM, WSP(bf16, WS_WOUT) + (size_t)l * DM * DM, kb, 64 * nb, 64 * nb, lane); return; }
    if (r < CI_D) { r -= CI_G; const int up = r >= (CI_U - CI_G); if (up) r -= (CI_U - CI_G); const int nb = r % (DFF / 64), kb = r / (DFF / 64), n0 = 64 * nb;
        cvt_item((up ? args->in[I_WU] : args->in[I_WG]) + (size_t)l * DM * DFF, args->in[I_FN] + l * DM, DM, DFF, WSP(bf16, WS_WGU) + (size_t)l * NGU * DM, kb, n0, (n0 / 128) * 256 + (n0 % 128) + (up ? 128 : 0), lane); return; }
    { r -= CI_D; const int nb = r % (DM / 64), kb = r / (DM / 64); cvt_item(args->in[I_WD] + (size_t)l * DFF * DM, nullptr, DFF, DM, WSP(bf16, WS_WDN) + (size_t)l * DM * DFF, kb, 64 * nb, 64 * nb, lane); }
}
__device__ __forceinline__ void cvt_range(KArgs args, int l, int lo, int hi, int worker, int nworkers, int lane) {
    for (int r = lo + worker; r < hi; r += nworkers) cvt_layer_item(args, l, r, lane);
}
__device__ __forceinline__ void cache_copy(KArgs args, int l, int worker, int nworkers, int lane, int part, int nparts) {
    constexpr int PER_B = (WIN - DT) * 128 / 4;
    constexpr int NP = 2 * DBATCH * PER_B;
    const int lo = (int)((long)NP * part / nparts), hi = (int)((long)NP * (part + 1) / nparts);
    const int stride = nworkers * 64;
    for (int i0 = lo + worker * 64 + lane; i0 < hi; i0 += 8 * stride) {
        f32x4 x[8];
#pragma unroll
        for (int k = 0; k < 8; ++k) { const int i = i0 + k * stride; if (i < hi) { const int isv = i / (DBATCH * PER_B), rem = i % (DBATCH * PER_B), b = rem / PER_B, p = rem % PER_B;
            x[k] = __builtin_nontemporal_load((const f32x4*)((isv ? args->in[I_CV] : args->in[I_CK]) + (size_t)l * DBATCH * WIN * 128 + (size_t)b * WIN * 128 + DT * 128 + 4 * p)); } }
#pragma unroll
        for (int k = 0; k < 8; ++k) { const int i = i0 + k * stride; if (i < hi) { const int isv = i / (DBATCH * PER_B), rem = i % (DBATCH * PER_B), b = rem / PER_B, p = rem % PER_B;
            __builtin_nontemporal_store(x[k], (f32x4*)(args->out + (isv ? OUT_NVS : OUT_NKS) + (size_t)l * DBATCH * WIN * 128 + (size_t)b * WIN * 128 + 4 * p)); } }
    }
}
__device__ __forceinline__ void p0_prologue(const Frame& F0, KArgs args) {
    Frame F = F0; asm volatile("" : "+v"(F.tid), "+v"(F.lane));
    const int gw = F.vcu * NWAVES + F.wave, NGW = F.G * NWAVES;
    bf16* XB = WSP(bf16, WS_XB); float* SSQA = WSP(float, WS_SSQA);
    for (int m0 = gw; m0 < M; m0 += 2 * NGW) {
        f32x4 v[2][4]; float s[2];
#pragma unroll
        for (int r = 0; r < 2; ++r) { const int m = m0 + r * NGW; const int mm = m < M ? m : m0;
            const float* xrow = mm < MP ? args->in[I_XP] + (size_t)mm * DM : args->in[I_XS] + (size_t)(mm - MP) * DM;
#pragma unroll
            for (int j = 0; j < 2; ++j) { v[r][2 * j] = __builtin_nontemporal_load((const f32x4*)(xrow + 512 * j + 8 * F.lane)); v[r][2 * j + 1] = __builtin_nontemporal_load((const f32x4*)(xrow + 512 * j + 8 * F.lane + 4)); } }
#pragma unroll
        for (int r = 0; r < 2; ++r) { s[r] = 0.f;
#pragma unroll
            for (int j = 0; j < 4; ++j) s[r] += (v[r][j].x * v[r][j].x + v[r][j].y * v[r][j].y) + (v[r][j].z * v[r][j].z + v[r][j].w * v[r][j].w); }
#pragma unroll
        for (int o = 1; o < 64; o <<= 1) { s[0] += __shfl_xor(s[0], o); s[1] += __shfl_xor(s[1], o); }
#pragma unroll
        for (int r = 0; r < 2; ++r) { const int m = m0 + r * NGW; if (m < M) {
#pragma unroll
            for (int j = 0; j < 2; ++j) { v4u w; w.x = pk2(v[r][2 * j].x, v[r][2 * j].y); w.y = pk2(v[r][2 * j].z, v[r][2 * j].w); w.z = pk2(v[r][2 * j + 1].x, v[r][2 * j + 1].y); w.w = pk2(v[r][2 * j + 1].z, v[r][2 * j + 1].w);
                st16_wt(XB + (size_t)m * DM + 512 * j + 8 * F.lane, w); }
            if (F.lane == 0) SSQA[m] = s[r]; } }
    }
    cvt_range(args, 0, CI_IN, CI_G, gw, NGW, F.lane);
}

typedef float f32x16 __attribute__((ext_vector_type(16)));
typedef short s16x4 __attribute__((ext_vector_type(4)));
constexpr int ARS = 144;
constexpr int AKR = 192;
constexpr int LB_K = 0, LB_V = 2 * AKR * ARS, LB_TAB = 2 * LB_V, LB_SSQ = LB_TAB + 8 * 192 * 4, LB_END = LB_SSQ + 2048;
constexpr int LB_ST0 = LB_END;
constexpr int OST0 = 144;
static_assert(LB_ST0 + 8 * 32 * OST0 <= LDSCTL_OFF, "mixer LDS");
constexpr float LOG2E = 1.4426950408889634f;
__device__ __forceinline__ s16x4 vtr(const LAS unsigned char* p) { return __builtin_bit_cast(s16x4, __builtin_amdgcn_ds_read_tr16_b64_v4i16((LAS s16x4*)p)); }
__device__ __forceinline__ void attn_qtile(const bf16x8 (&qf)[4], const LAS unsigned char* kimg, const LAS unsigned char* vimg, int tile0, const LAS float* tab_lane, float sink2, unsigned tilemask, int lane, f32x16 (&o)[2]) {
    const int q = lane & 31, hi = lane >> 5;
    f32x16 S[5];
    const LAS unsigned char* kb = kimg + (tile0 * 32 + q) * ARS + hi * 16;
#pragma unroll
    for (int jj = 0; jj < 5; ++jj) {
        f32x16 acc = {};
#pragma unroll
        for (int ds = 0; ds < 4; ++ds) { const bf16x8 kf = *(const LAS bf16x8*)(kb + jj * 32 * ARS + ds * 32); acc = __builtin_amdgcn_mfma_f32_32x32x16_bf16(kf, qf[ds], acc, 0, 0, 0); }
        S[jj] = acc;
    }
    const float c2 = 0.125f * LOG2E;
    float mx = sink2;
#pragma unroll
    for (int jj = 0; jj < 5; ++jj) { const bool tm = (tilemask >> jj) & 1u;
#pragma unroll
        for (int r = 0; r < 16; ++r) { const float bv = tab_lane[159 - 32 * jj - (r & 3) - 8 * (r >> 2)]; float s = fmaf(S[jj][r], c2, bv); s = tm ? -1e30f : s; S[jj][r] = s; mx = fmaxf(mx, s); } }
    mx = fmaxf(mx, __shfl_xor(mx, 32));
    float lsum = 0.f;
#pragma unroll
    for (int jj = 0; jj < 5; ++jj)
#pragma unroll
        for (int r = 0; r < 16; ++r) { const float p = __builtin_amdgcn_exp2f(S[jj][r] - mx); lsum += p; S[jj][r] = p; }
    lsum += __shfl_xor(lsum, 32); lsum += __builtin_amdgcn_exp2f(sink2 - mx);
    bf16x8 pf[5][2];
#pragma unroll
    for (int jj = 0; jj < 5; ++jj)
#pragma unroll
        for (int s = 0; s < 2; ++s) { v4u w; w.x = pg8::cvt_pk_bf16(S[jj][8 * s + 0], S[jj][8 * s + 1]); w.y = pg8::cvt_pk_bf16(S[jj][8 * s + 2], S[jj][8 * s + 3]); w.z = pg8::cvt_pk_bf16(S[jj][8 * s + 4], S[jj][8 * s + 5]); w.w = pg8::cvt_pk_bf16(S[jj][8 * s + 6], S[jj][8 * s + 7]);
            pf[jj][s] = __builtin_bit_cast(bf16x8, w); }
    const LAS unsigned char* vb = vimg + (tile0 * 32 + 4 * hi + ((lane & 15) >> 2)) * ARS + (16 * ((lane >> 4) & 1) + 4 * (lane & 3)) * 2;
    const float rl = 1.0f / lsum;
#pragma unroll
    for (int db = 0; db < 2; ++db) {
        f32x16 acc = {};
#pragma unroll
        for (int jj = 0; jj < 5; ++jj)
#pragma unroll
            for (int s = 0; s < 2; ++s) { const LAS unsigned char* a = vb + (jj * 32 + 16 * s) * ARS + db * 64;
                const s16x4 lo = vtr(a), hh = vtr(a + 8 * ARS);
                const bf16x8 vf = {lo[0], lo[1], lo[2], lo[3], hh[0], hh[1], hh[2], hh[3]};
                acc = __builtin_amdgcn_mfma_f32_32x32x16_bf16(vf, pf[jj][s], acc, 0, 0, 0); }
        o[db] = acc * rl;
    }
}
__device__ __forceinline__ void load_qf(const bf16* qptr, bf16x8 (&qf)[4]) {
#pragma unroll
    for (int ds = 0; ds < 4; ++ds) qf[ds] = *(const bf16x8*)(qptr + 16 * ds);
}
__device__ __forceinline__ float sumsq32(const f32x16 (&o)[2]) { float s = 0.f;
#pragma unroll
    for (int db = 0; db < 2; ++db)
#pragma unroll
        for (int r = 0; r < 16; ++r) s += o[db][r] * o[db][r];
    return s; }
__device__ __forceinline__ void store_o(bf16* mrow_head, const f32x16 (&o)[2], float ra, int hi) {
#pragma unroll
    for (int db = 0; db < 2; ++db)
#pragma unroll
        for (int g = 0; g < 4; ++g) { const unsigned w0 = pg8::cvt_pk_bf16(o[db][4 * g] * ra, o[db][4 * g + 1] * ra), w1 = pg8::cvt_pk_bf16(o[db][4 * g + 2] * ra, o[db][4 * g + 3] * ra);
            *(unsigned long long*)(mrow_head + 32 * db + 8 * g + 4 * hi) = (unsigned long long)w0 | ((unsigned long long)w1 << 32); }
}
__device__ __forceinline__ void unpack8(const v4u w, float (&f)[8]) { f[0] = bflo(w.x); f[1] = bfhi(w.x); f[2] = bflo(w.y); f[3] = bfhi(w.y); f[4] = bflo(w.z); f[5] = bfhi(w.z); f[6] = bflo(w.w); f[7] = bfhi(w.w); }
__device__ __forceinline__ void cu8(const bf16* Z, size_t row, int lane, float (&c)[8]) { unpack8(*(const v4u*)(Z + row * ZP + ZCU + 8 * lane), c); }
__device__ __forceinline__ void conv_row_out(const bf16* Z, bf16* MB, size_t row, int lane, const float (&cw)[3][8], const float (&c2)[8], const float (&c1)[8], const float (&c0)[8]) {
    float gb[8]; unpack8(*(const v4u*)(Z + row * ZP + ZGB + 8 * lane), gb);
    float v[8]; float ss = 0.f;
#pragma unroll
    for (int i = 0; i < 8; ++i) { v[i] = gb[i] * (cw[0][i] * c2[i] + cw[1][i] * c1[i] + cw[2][i] * c0[i]); ss += v[i] * v[i]; }
    const float rc = rsqrtf(wave_sum(ss) * (1.f / 512.f) + EPS);
    v4u w; w.x = pg8::cvt_pk_bf16(v[0] * rc, v[1] * rc); w.y = pg8::cvt_pk_bf16(v[2] * rc, v[3] * rc); w.z = pg8::cvt_pk_bf16(v[4] * rc, v[5] * rc); w.w = pg8::cvt_pk_bf16(v[6] * rc, v[7] * rc);
    *(v4u*)(MB + row * DM + 512 + 8 * lane) = w;
}
__device__ __forceinline__ void load_cw(const float* cwp, int lane, float (&cw)[3][8]) {
#pragma unroll
    for (int k = 0; k < 3; ++k) { const f32x4 a = *(const f32x4*)(cwp + k * 512 + 8 * lane), b = *(const f32x4*)(cwp + k * 512 + 8 * lane + 4);
        cw[k][0] = a[0]; cw[k][1] = a[1]; cw[k][2] = a[2]; cw[k][3] = a[3]; cw[k][4] = b[0]; cw[k][5] = b[1]; cw[k][6] = b[2]; cw[k][7] = b[3]; }
}
template <int NR> struct ConvIn { v4u cuw[NR + 2], gbw[NR]; };
template <int NR>
__device__ __forceinline__ void conv_load(const bf16* Z, size_t r0, long t0, int lane, ConvIn<NR>& in) {
#pragma unroll
    for (int j = 0; j < NR + 2; ++j) { const size_t rr = (t0 - 2 + j >= 0) ? r0 - 2 + j : r0; in.cuw[j] = *(const v4u*)(Z + rr * ZP + ZCU + 8 * lane); }
#pragma unroll
    for (int k = 0; k < NR; ++k) in.gbw[k] = *(const v4u*)(Z + (r0 + k) * ZP + ZGB + 8 * lane);
}
template <int NR>
__device__ __forceinline__ void conv_compute(const ConvIn<NR>& in, const float (&cw)[3][8], long t0, v4u (&w)[NR]) {
    float ss[NR]; float v[NR][8];
#pragma unroll
    for (int k = 0; k < NR; ++k) {
        float c2[8], c1[8], c0[8], gb[8]; unpack8(in.cuw[k], c2); unpack8(in.cuw[k + 1], c1); unpack8(in.cuw[k + 2], c0); unpack8(in.gbw[k], gb);
        const float k2 = (t0 - 2 + k >= 0) ? 1.f : 0.f, k1 = (t0 - 1 + k >= 0) ? 1.f : 0.f;
        ss[k] = 0.f;
#pragma unroll
        for (int i = 0; i < 8; ++i) { v[k][i] = gb[i] * (cw[0][i] * (c2[i] * k2) + cw[1][i] * (c1[i] * k1) + cw[2][i] * c0[i]); ss[k] += v[k][i] * v[k][i]; } }
#pragma unroll
    for (int o = 1; o < 64; o <<= 1)
#pragma unroll
        for (int k = 0; k < NR; ++k) ss[k] += __shfl_xor(ss[k], o);
#pragma unroll
    for (int k = 0; k < NR; ++k) { const float rc = rsqrtf(ss[k] * (1.f / 512.f) + EPS);
        w[k].x = pg8::cvt_pk_bf16(v[k][0] * rc, v[k][1] * rc); w[k].y = pg8::cvt_pk_bf16(v[k][2] * rc, v[k][3] * rc); w[k].z = pg8::cvt_pk_bf16(v[k][4] * rc, v[k][5] * rc); w[k].w = pg8::cvt_pk_bf16(v[k][6] * rc, v[k][7] * rc); }
}
#define LDS_BAR() do { asm volatile("s_waitcnt lgkmcnt(0)" ::: "memory"); __builtin_amdgcn_s_barrier(); asm volatile("" ::: "memory"); } while (0)
#define WG_BAR() do { asm volatile("s_waitcnt vmcnt(0) lgkmcnt(0)" ::: "memory"); __builtin_amdgcn_s_barrier(); asm volatile("" ::: "memory"); } while (0)
__device__ __forceinline__ void pack_o(const f32x16 (&o)[2], float s, unsigned (&p)[16]) {
#pragma unroll
    for (int db = 0; db < 2; ++db)
#pragma unroll
        for (int g = 0; g < 4; ++g) { p[db * 8 + g * 2] = pg8::cvt_pk_bf16(o[db][4 * g] * s, o[db][4 * g + 1] * s); p[db * 8 + g * 2 + 1] = pg8::cvt_pk_bf16(o[db][4 * g + 2] * s, o[db][4 * g + 3] * s); }
}
constexpr int OST = 144;
__device__ __forceinline__ void mixer_prompt_unit(const Frame& F, KArgs args, int l, int unit, bool build_tab) {
    const int tid = F.tid, lane = F.lane, wave = F.wave, q = lane & 31, hi = lane >> 5;
    const int b = unit >> 7, n = (unit >> 1) & 63, qh = unit & 1;
    const size_t R0 = (size_t)b * SEQ + 128 * n + 64 * qh;
    const long W0 = (long)R0 - 128, B0 = (long)b * SEQ;
    const bf16* Z = WSP(bf16, WS_Z); bf16* MB = WSP(bf16, WS_MB);
    LAS unsigned char* lds = F.lds + RING_OFF;
    const int h = wave, kv = h >> 2;
    const float* cwp = args->in[I_CW] + (size_t)l * 3 * 512;
    const size_t rc0 = R0 + 8 * wave; const long tc0 = (long)rc0 - B0;
    float tb[3];
    {   int tl = tid; asm volatile("" : "+v"(tl));
#pragma unroll
        for (int k = 0; k < 3; ++k) { const int i = tl + 512 * k, hh = i / 192, d = i % 192 - 32, dc = d < 0 ? 0 : (d > 127 ? 127 : d); tb[k] = args->in[I_RB][bucket_of(dc) * 8 + hh]; } }
    const float sink2 = args->in[I_SK][l * 8 + h] * LOG2E;
    v4u sd[12];
#pragma unroll
    for (int k = 0; k < 12; ++k) { const int idx = tid + 512 * k, piece = idx & 31, wrow = idx >> 5; long gr = W0 + wrow; gr = gr < B0 ? B0 : gr;
        sd[k] = *(const v4u*)(Z + (size_t)gr * ZP + ZK + piece * 8); }
    bf16x8 qf0[4]; load_qf(Z + (R0 + q) * ZP + h * 64 + 8 * hi, qf0);
    ConvIn<4> ci0, ci1; float cw[3][8];
    conv_load<4>(Z, rc0, tc0, lane, ci0); load_cw(cwp, lane, cw);
    asm volatile("" ::: "memory");
#pragma unroll
    for (int k = 0; k < 12; ++k) { const int idx = tid + 512 * k, piece = idx & 31, wrow = idx >> 5;
        *(LAS v4u*)(lds + ((piece >> 4) ? LB_V : LB_K) + (((piece >> 3) & 1) * AKR + wrow) * ARS + (piece & 7) * 16) = sd[k]; }
    asm volatile("" ::: "memory");
    conv_load<4>(Z, rc0 + 4, tc0 + 4, lane, ci1);
    asm volatile("" ::: "memory");
    if (build_tab) { LAS float* tab = (LAS float*)(lds + LB_TAB);
#pragma unroll
        for (int k = 0; k < 3; ++k) { const int i = tid + 512 * k, d = i % 192 - 32; tab[i] = (d >= 0 && d < 128) ? tb[k] * LOG2E : -1e30f; } }
    v4u cvo[2][4];
    conv_compute<4>(ci0, cw, tc0, cvo[0]);
    conv_compute<4>(ci1, cw, tc0 + 4, cvo[1]);
    LDS_BAR();
#pragma unroll
    for (int c = 0; c < 2; ++c)
#pragma unroll
        for (int k = 0; k < 4; ++k) st16_wt(MB + (rc0 + 4 * c + k) * DM + 512 + 8 * lane, cvo[c][k]);
    const LAS float* tab_lane = (const LAS float*)(lds + LB_TAB) + h * 192 + (1 + q - 4 * hi);
    LAS float* ssqx = (LAS float*)(lds + LB_SSQ);
    const unsigned tm0 = (n == 0) ? ((1u << (4 - 2 * qh)) - 1u) : 0u;
    f32x16 o1[2];
    LAS unsigned char* st0 = lds + LB_ST0 + wave * (32 * OST0);
    {   f32x16 o[2];
        attn_qtile(qf0, lds + LB_K + kv * AKR * ARS, lds + LB_V + kv * AKR * ARS, 0, tab_lane, sink2, tm0, lane, o);
        float ss = sumsq32(o); ss += __shfl_xor(ss, 32); if (hi == 0) ssqx[q * 8 + h] = ss;
        unsigned p0[16]; pack_o(o, 1.0f, p0);
#pragma unroll
        for (int i = 0; i < 8; ++i) *(LAS unsigned long long*)(st0 + q * OST0 + (i >> 2) * 64 + (i & 3) * 16 + hi * 8) = (unsigned long long)p0[2 * i] | ((unsigned long long)p0[2 * i + 1] << 32); }
    {   bf16x8 qf1[4]; load_qf(Z + (R0 + 32 + q) * ZP + h * 64 + 8 * hi, qf1);
        attn_qtile(qf1, lds + LB_K + kv * AKR * ARS, lds + LB_V + kv * AKR * ARS, 1, tab_lane, sink2, tm0 >> 1, lane, o1);
        float ss = sumsq32(o1); ss += __shfl_xor(ss, 32); if (hi == 0) ssqx[(32 + q) * 8 + h] = ss; }
    LDS_BAR();
    LAS unsigned char* st1 = lds + wave * (32 * OST);
    {   const LAS f32x4* sp = (const LAS f32x4*)(ssqx + (32 + q) * 8); const f32x4 a = sp[0], c = sp[1];
        const float ra = rsqrtf((((a[0] + a[1]) + (a[2] + a[3])) + ((c[0] + c[1]) + (c[2] + c[3]))) * (1.f / 512.f) + EPS);
        unsigned p1[16]; pack_o(o1, ra, p1);
#pragma unroll
        for (int i = 0; i < 8; ++i) *(LAS unsigned long long*)(st1 + q * OST + (i >> 2) * 64 + (i & 3) * 16 + hi * 8) = (unsigned long long)p1[2 * i] | ((unsigned long long)p1[2 * i + 1] << 32); }
    asm volatile("s_waitcnt lgkmcnt(0)" ::: "memory");
#pragma unroll
    for (int i = 0; i < 4; ++i) { const int row = 8 * i + (lane >> 3), ch = lane & 7;
        const LAS f32x4* sp = (const LAS f32x4*)(ssqx + row * 8); const f32x4 a = sp[0], c = sp[1];
        const float ra = rsqrtf((((a[0] + a[1]) + (a[2] + a[3])) + ((c[0] + c[1]) + (c[2] + c[3]))) * (1.f / 512.f) + EPS);
        const v4u d = *(const LAS v4u*)(st0 + row * OST0 + ch * 16);
        v4u w; w.x = pg8::cvt_pk_bf16(bflo(d.x) * ra, bfhi(d.x) * ra); w.y = pg8::cvt_pk_bf16(bflo(d.y) * ra, bfhi(d.y) * ra); w.z = pg8::cvt_pk_bf16(bflo(d.z) * ra, bfhi(d.z) * ra); w.w = pg8::cvt_pk_bf16(bflo(d.w) * ra, bfhi(d.w) * ra);
        st16_wt(MB + (R0 + row) * DM + h * 64 + 8 * ch, w); }
#pragma unroll
    for (int i = 0; i < 4; ++i) { const int row = 8 * i + (lane >> 3), ch = lane & 7;
        const v4u d = *(const LAS v4u*)(st1 + row * OST + ch * 16);
        st16_wt(MB + (R0 + 32 + row) * DM + h * 64 + 8 * ch, d); }
}
__device__ __forceinline__ void mixer_sample_unit(const Frame& F, KArgs args, int l, int b) {
    const int tid = F.tid, lane = F.lane, wave = F.wave, hi = lane >> 5;
    const size_t RS0 = (size_t)MP + 4 * b;
    const bf16* Z = WSP(bf16, WS_Z); bf16* MB = WSP(bf16, WS_MB);
    LAS unsigned char* lds = F.lds + RING_OFF;
    float* out = args->out;
    const int qc = lane & 31, t = (qc >> 2) & 3, g = qc & 3;
    bf16x8 qf[4]; float sink2 = 0.f;
    float cw[3][8]; f32x4 s2a, s2b, s1a, s1b; v4u c2w, c1w, c0w, gbw;
    const int tt = wave - 2;
    if (wave < 2) { const int head = 4 * wave + g; sink2 = args->in[I_SK][l * 8 + head] * LOG2E; load_qf(Z + (RS0 + t) * ZP + head * 64 + 8 * hi, qf); }
    else if (wave < 6) { load_cw(args->in[I_CW] + (size_t)l * 3 * 512, lane, cw);
        const float* st = args->in[I_ST] + (size_t)l * DBATCH * 2 * 512 + (size_t)b * 2 * 512;
        if (tt >= 2) c2w = *(const v4u*)(Z + (RS0 + tt - 2) * ZP + ZCU + 8 * lane); else { s2a = *(const f32x4*)(st + tt * 512 + 8 * lane); s2b = *(const f32x4*)(st + tt * 512 + 8 * lane + 4); }
        if (tt >= 1) c1w = *(const v4u*)(Z + (RS0 + tt - 1) * ZP + ZCU + 8 * lane); else { s1a = *(const f32x4*)(st + 512 + 8 * lane); s1b = *(const f32x4*)(st + 512 + 8 * lane + 4); }
        c0w = *(const v4u*)(Z + (RS0 + tt) * ZP + ZCU + 8 * lane); gbw = *(const v4u*)(Z + (RS0 + tt) * ZP + ZGB + 8 * lane); }
    v4u nd = {0u, 0u, 0u, 0u};
    if (tid < 128) nd = *(const v4u*)(Z + (RS0 + (tid >> 5)) * ZP + ZK + (tid & 31) * 8);
    asm volatile("" ::: "memory");
#if PROBE_TS
#pragma unroll 2
#else
#pragma unroll
#endif
    for (int k = 0; k < 8; ++k) { const int idx = tid + 512 * k, isv = idx >> 11, rem = idx & 2047, w = rem >> 4, pc = rem & 15;
        const float* src = (isv ? args->in[I_CV] : args->in[I_CK]) + (size_t)l * DBATCH * WIN * 128 + ((size_t)b * WIN + w) * 128 + pc * 8;
        const f32x4 x0 = __builtin_nontemporal_load((const f32x4*)src), x1 = __builtin_nontemporal_load((const f32x4*)(src + 4));
        v4u pk; pk.x = pg8::cvt_pk_bf16(x0[0], x0[1]); pk.y = pg8::cvt_pk_bf16(x0[2], x0[3]); pk.z = pg8::cvt_pk_bf16(x1[0], x1[1]); pk.w = pg8::cvt_pk_bf16(x1[2], x1[3]);
        *(LAS v4u*)(lds + (isv ? LB_V : LB_K) + ((pc >> 3) * AKR + w) * ARS + (pc & 7) * 16) = pk; }
    if (tid < 128) { const int tr = tid >> 5, piece = tid & 31; const v4u d = nd;
        *(LAS v4u*)(lds + ((piece >> 4) ? LB_V : LB_K) + (((piece >> 3) & 1) * AKR + 128 + tr) * ARS + (piece & 7) * 16) = d;
        float f[8]; unpack8(d, f);
        float* dst = out + ((piece >> 4) ? OUT_NVS : OUT_NKS) + (size_t)l * DBATCH * WIN * 128 + ((size_t)b * WIN + (WIN - DT) + tr) * 128 + (piece & 15) * 8;
        *(f32x4*)dst = (f32x4){f[0], f[1], f[2], f[3]}; *(f32x4*)(dst + 4) = (f32x4){f[4], f[5], f[6], f[7]}; }
    for (int idx = tid; idx < 28 * 32; idx += 512) { const int zr = idx >> 5, piece = idx & 31;
        *(LAS v4u*)(lds + ((piece >> 4) ? LB_V : LB_K) + (((piece >> 3) & 1) * AKR + 132 + zr) * ARS + (piece & 7) * 16) = (v4u){0u, 0u, 0u, 0u}; }
    LDS_BAR();
    LAS float* ssqx = (LAS float*)(lds + LB_SSQ);
    f32x16 o[2];
    if (wave < 2) {
        const int kv = wave, head = 4 * kv + g;
        const LAS float* tab_lane = (const LAS float*)(lds + LB_TAB) + head * 192 + (1 + t - 4 * hi);
        attn_qtile(qf, lds + LB_K + kv * AKR * ARS, lds + LB_V + kv * AKR * ARS, 0, tab_lane, sink2, 0u, lane, o);
        float ss = sumsq32(o); ss += __shfl_xor(ss, 32); ss += __shfl_xor(ss, 1); ss += __shfl_xor(ss, 2);
        if (lane < 16 && g == 0) ssqx[t * 2 + kv] = ss;
    } else if (wave < 6) {
        float c2[8], c1[8], c0[8];
        if (tt >= 2) unpack8(c2w, c2); else { c2[0] = s2a[0]; c2[1] = s2a[1]; c2[2] = s2a[2]; c2[3] = s2a[3]; c2[4] = s2b[0]; c2[5] = s2b[1]; c2[6] = s2b[2]; c2[7] = s2b[3]; }
        if (tt >= 1) unpack8(c1w, c1); else { c1[0] = s1a[0]; c1[1] = s1a[1]; c1[2] = s1a[2]; c1[3] = s1a[3]; c1[4] = s1b[0]; c1[5] = s1b[1]; c1[6] = s1b[2]; c1[7] = s1b[3]; }
        unpack8(c0w, c0);
        float gb[8]; unpack8(gbw, gb);
        float v[8]; float ss = 0.f;
#pragma unroll
        for (int i = 0; i < 8; ++i) { v[i] = gb[i] * (cw[0][i] * c2[i] + cw[1][i] * c1[i] + cw[2][i] * c0[i]); ss += v[i] * v[i]; }
        const float rc = rsqrtf(wave_sum(ss) * (1.f / 512.f) + EPS);
        v4u w; w.x = pg8::cvt_pk_bf16(v[0] * rc, v[1] * rc); w.y = pg8::cvt_pk_bf16(v[2] * rc, v[3] * rc); w.z = pg8::cvt_pk_bf16(v[4] * rc, v[5] * rc); w.w = pg8::cvt_pk_bf16(v[6] * rc, v[7] * rc);
        *(v4u*)(MB + (RS0 + tt) * DM + 512 + 8 * lane) = w;
    }
    LDS_BAR();
    if (wave < 2) { const int head = 4 * wave + g;
        const float ra = rsqrtf((ssqx[t * 2] + ssqx[t * 2 + 1]) * (1.f / 512.f) + EPS);
        if (qc < 16) store_o(MB + (RS0 + t) * DM + head * 64, o, ra, hi); }
}
__device__ __forceinline__ void state_outputs(const Frame& F, KArgs args, int l, int wg, int nwg) {
    const bf16* Z = WSP(bf16, WS_Z); float* out = args->out;
    const size_t gt = (size_t)wg * 512 + F.tid, NT = (size_t)nwg * 512;
    for (size_t i = gt; i < (size_t)DBATCH * 2 * 512; i += NT) {
        if (i < (size_t)NBATCH * WIN * 128) { const int b = i / (WIN * 128), w = (i / 128) % WIN, c = i % 128; const size_t r = (size_t)b * SEQ + SEQ - WIN + w;
            out[OUT_NKP + (size_t)l * NBATCH * WIN * 128 + i] = bf2f(Z[r * ZP + ZK + c]); out[OUT_NVP + (size_t)l * NBATCH * WIN * 128 + i] = bf2f(Z[r * ZP + ZV + c]); }
        if (i < (size_t)NBATCH * 2 * 512) { const int b = i / 1024, j = (i / 512) % 2, ch = i % 512; const size_t r = (size_t)b * SEQ + SEQ - 2 + j;
            out[OUT_NCP + (size_t)l * NBATCH * 1024 + i] = bf2f(Z[r * ZP + ZCU + ch]); }
        { const int b = i / 1024, j = (i / 512) % 2, ch = i % 512; const size_t r = (size_t)MP + b * DT + 2 + j;
            out[OUT_NCS + (size_t)l * DBATCH * 1024 + i] = bf2f(Z[r * ZP + ZCU + ch]); }
    }
}
__device__ __forceinline__ void phaseB1(const Frame& F0, KArgs args, int l) {
    Frame F = F0; asm volatile("" : "+v"(F.tid), "+v"(F.lane));
    bool first = true;
    for (int u = F.vcu; u < NBATCH * 64 * 2; u += F.G) { LDS_BAR(); mixer_prompt_unit(F, args, l, u, first); first = false; }
}
__device__ __forceinline__ void phaseB2(const Frame& F0, KArgs args, int l) {
    Frame F = F0; asm volatile("" : "+v"(F.tid), "+v"(F.lane));
    for (int b = F.vcu; b < DBATCH; b += F.G) { LDS_BAR(); mixer_sample_unit(F, args, l, b); }
    if (F.G > DBATCH) { if (F.vcu >= DBATCH) { cache_copy(args, l, (F.vcu - DBATCH) * NWAVES + F.wave, (F.G - DBATCH) * NWAVES, F.lane, 0, 2); state_outputs(F, args, l, F.vcu - DBATCH, F.G - DBATCH); } }
    else { cache_copy(args, l, F.vcu * NWAVES + F.wave, F.G * NWAVES, F.lane, 0, 2); state_outputs(F, args, l, F.vcu, F.G); }
    WG_BAR();
}
template <int K, bool LAST>
__device__ __forceinline__ void tail_gemm_resid(const Frame& F, const bf16* A, const bf16* Bt, bf16* xb, float* out, float* ssq_rows  , int tile) {
    const int lane = F.lane, wave = F.wave, fr = lane & 15, fq = lane >> 4;
    const int row0 = (tile >> 4) * 32, col0 = (tile & 15) * 64, tc = tile & 15;
    constexpr int KW = K / 8, STEPS = KW / 32; static_assert(KW % 32 == 0, "K split");
    f32x4 acc[2][4];
#pragma unroll
    for (int m = 0; m < 2; ++m)
#pragma unroll
        for (int n = 0; n < 4; ++n) acc[m][n] = (f32x4){0.f, 0.f, 0.f, 0.f};
    const bf16* ap = A + (size_t)(row0 + fr) * K + wave * KW + 8 * fq;
    const bf16* bp = Bt + (size_t)(col0 + fr) * K + wave * KW + 8 * fq;
#pragma unroll 2
    for (int s = 0; s < STEPS; ++s) {
        bf16x8 a[2], b[4];
#pragma unroll
        for (int m = 0; m < 2; ++m) a[m] = *(const bf16x8*)(ap + (size_t)(16 * m) * K + 32 * s);
#pragma unroll
        for (int n = 0; n < 4; ++n) b[n] = *(const bf16x8*)(bp + (size_t)(16 * n) * K + 32 * s);
#pragma unroll
        for (int m = 0; m < 2; ++m)
#pragma unroll
            for (int n = 0; n < 4; ++n) acc[m][n] = __builtin_amdgcn_mfma_f32_16x16x32_bf16(b[n], a[m], acc[m][n], 0, 0, 0);
    }
    LAS float* red = (LAS float*)(F.lds + RING_OFF);
#pragma unroll
    for (int m = 0; m < 2; ++m)
#pragma unroll
        for (int n = 0; n < 4; ++n) *(LAS f32x4*)(red + ((wave * 32 + 16 * m + fr) * 64 + 16 * n + 4 * fq)) = acc[m][n];
    WG_BAR();
    const int t = F.tid, r = t >> 4, c4 = (t & 15) * 4;
    bf16* xp = xb + (size_t)(row0 + r) * DM + col0 + c4;
    const unsigned long long bw = *(const unsigned long long*)xp;
    f32x4 v = (f32x4){bflo((unsigned)bw), bfhi((unsigned)bw), bflo((unsigned)(bw >> 32)), bfhi((unsigned)(bw >> 32))};
#pragma unroll
    for (int w = 0; w < 8; ++w) v += *(const LAS f32x4*)(red + ((w * 32 + r) * 64 + c4));
    if (LAST) *(f32x4*)(out + (size_t)(row0 + r) * DM + col0 + c4) = v;
    else *(unsigned long long*)xp = (unsigned long long)pg8::cvt_pk_bf16(v[0], v[1]) | ((unsigned long long)pg8::cvt_pk_bf16(v[2], v[3]) << 32);
    float q = (v[0] * v[0] + v[1] * v[1]) + (v[2] * v[2] + v[3] * v[3]);
    q += __shfl_xor(q, 1); q += __shfl_xor(q, 2); q += __shfl_xor(q, 4); q += __shfl_xor(q, 8);
    if ((t & 15) == 0) ssq_rows[(size_t)tc * M + row0 + r] = q;
    WG_BAR();
}
__device__ __forceinline__ void phase_final(const Frame& F0, KArgs args) {
    Frame F = F0; asm volatile("" : "+v"(F.tid), "+v"(F.lane));
    const int gw = F.vcu * NWAVES + F.wave, NGW = F.G * NWAVES;
    const float* SSQA = WSP(float, WS_SSQA);
    const bf16* XB = WSP(bf16, WS_XB);
    for (int m = gw; m < M; m += NGW) {
        float part = F.lane < 16 ? SSQA[(size_t)F.lane * M + m] : 0.f;
        const float rstd = rsqrtf(wave_sum(part) * (1.f / DM) + EPS);
        const GAS unsigned long long* xr = (const GAS unsigned long long*)(XB + (size_t)m * DM) + F.lane; const GAS f32x4* g = (const GAS f32x4*)args->in[I_FIN] + F.lane;
        GAS f32x4* yr = (GAS f32x4*)(args->out + (size_t)m * DM) + F.lane;
#pragma unroll
        for (int j = 0; j < 4; ++j) { const unsigned long long w = xr[64 * j]; const f32x4 gg = g[64 * j];
            f32x4 v = (f32x4){bflo((unsigned)w), bfhi((unsigned)w), bflo((unsigned)(w >> 32)), bfhi((unsigned)(w >> 32))}; v = v * rstd * gg; __builtin_nontemporal_store(v, (f32x4*)(yr + 64 * j)); }
    }
}

#ifndef REP_A
#define REP_A 1
#endif
#ifndef REP_D
#define REP_D 1
#endif
#ifndef REP_T
#define REP_T 1
#endif
#ifndef REP_BAR_REL
#define REP_BAR_REL true
#endif
#ifndef REP_BAR
#define REP_BAR 0
#endif
#ifndef REP_P0
#define REP_P0 1
#endif
#ifndef REP_B
#define REP_B 1
#endif
__global__ void __launch_bounds__(NWAVES * 64, 2) mega_fwd(Args args_) {
    extern __shared__ __attribute__((aligned(16))) unsigned char lds[];
    Frame F;
    F.lds = (LAS unsigned char*)lds;
    F.MISC = (volatile LAS unsigned*)(F.lds + MISC_OFF);
    F.tid = threadIdx.x; F.lane = F.tid & 63; F.wave = __builtin_amdgcn_readfirstlane(F.tid >> 6);
    F.G = gridDim.x; { const int bx = blockIdx.x; F.vcu = (F.G % 8 == 0) ? (bx % 8) * (F.G / 8) + bx / 8 : bx; }
    F.ctl = (gu32*)(args_.ws + WS_CTL);
    for (int u = F.tid; u < (LDS_BYTES - LDSCTL_OFF) / 4; u += NWAVES * 64) ((LAS unsigned*)(F.lds + LDSCTL_OFF))[u] = 0u;
    __syncthreads();
    XcdBarrier bar = xcd_barrier_post((unsigned*)(F.ctl + CW_BAR), F.MISC + 8);
#if PROBE_TS
#define PROBE_HIT(i_) (((i_) == 0) ? false : ((i_) == 100 ? PROBE_PH == 7 : ((i_) == 1 ? PROBE_PH == 0 : (((i_) - 2) % 5 + 1 == PROBE_PH || (PROBE_PH == 8 && ((i_) - 2) % 5 == 1)))))
#define BAR_STAMP(i) do { const int i_ = (i); const bool hit_ = PROBE_HIT(i_); \
    for (int rb_ = 0; rb_ < (hit_ ? 2 : 1); ++rb_) { GRID_BAR(); \
        if (blockIdx.x == 0 && F.tid == 0) { const unsigned long long now_ = __builtin_amdgcn_s_memrealtime(); \
            if (hit_ && rb_ == 0) { const unsigned long long t0_ = ((unsigned long long)F.MISC[17] << 32) | F.MISC[16]; const unsigned long long d_ = now_ - t0_; while (__builtin_amdgcn_s_memrealtime() < now_ + 4 * d_) __builtin_amdgcn_s_sleep(20); } \
            if (PROBE_PH == 9 && i_ == 5 && rb_ == 0) { const unsigned long long t0_ = ((unsigned long long)F.MISC[17] << 32) | F.MISC[16], m0_ = ((unsigned long long)F.MISC[19] << 32) | F.MISC[18]; \
                const unsigned long long drt_ = now_ - t0_, dmt_ = __builtin_amdgcn_s_memtime() - m0_; const unsigned long long sp_ = dmt_ * 1000ull / drt_; while (__builtin_amdgcn_s_memrealtime() < now_ + sp_) __builtin_amdgcn_s_sleep(20); } \
            const unsigned long long n2_ = __builtin_amdgcn_s_memrealtime(); F.MISC[16] = (unsigned)n2_; F.MISC[17] = (unsigned)(n2_ >> 32); const unsigned long long m2_ = __builtin_amdgcn_s_memtime(); F.MISC[18] = (unsigned)m2_; F.MISC[19] = (unsigned)(m2_ >> 32); } } } while (0)
#define STAMP0() do { if (blockIdx.x == 0 && F.tid == 0) { const unsigned long long n2_ = __builtin_amdgcn_s_memrealtime(); F.MISC[16] = (unsigned)n2_; F.MISC[17] = (unsigned)(n2_ >> 32); } } while (0)
#else
#define BAR_STAMP(i) GRID_BAR()
#define STAMP0() do {} while (0)
#endif
#define GRID_BAR() do { XcdBarrier bb_ = bar; asm volatile("" : "+s"(bb_.x)); xcd_barrier(bb_); } while (0)
#define PHASE_ARGS() KArgs args = (KArgs)__builtin_amdgcn_kernarg_segment_ptr(); asm volatile("" : "+s"(args))
#define LAYER() int l = l_; asm volatile("" : "+s"(l))

    STAMP0();
    for (int rep_ = 0; rep_ < REP_P0; ++rep_) { PHASE_ARGS(); p0_prologue(F, args); }
    BAR_STAMP(1);
    for (int l_ = 0; l_ < NLAYER; ++l_) {
        {   PHASE_ARGS(); LAYER();
            pg8::Gemm g{WSP(bf16, WS_XB), WSP(bf16, WS_WIN) + (size_t)l * NIN * DM, M, NIN, DM}; pg8::StaticOrder S; S.init(M, NIN, F.G, (int)blockIdx.x);
            pg8::EpiScaleBf16 E{WSP(bf16, WS_Z), ZP, WSP(float, WS_SSQA), l == 0 ? 1 : 16, M};
            for (int rep_ = 0; rep_ < REP_A; ++rep_) pg8::gemm_phase<pg8::EpiScaleBf16, pg8::StaticOrder, true, true>(F.lds + RING_OFF, g, S, E);
            const int full = ((M / 256) * (NIN / 256)) % F.G;
            if ((int)blockIdx.x >= full) { Frame F2 = F; asm volatile("" : "+v"(F2.tid), "+v"(F2.lane)); cvt_range(args, l, CI_G, CI_END, ((int)blockIdx.x - full) * NWAVES + F2.wave, (F.G - full) * NWAVES, F2.lane); }
        }
        BAR_STAMP(2 + 5 * l_);
        for (int rep_ = 0; rep_ < REP_B; ++rep_) { { PHASE_ARGS(); LAYER(); phaseB1(F, args, l); }
#if PROBE_TS
            if (PROBE_PH == 7 || PROBE_PH == 8) { BAR_STAMP(100); }
#endif
            { PHASE_ARGS(); LAYER(); phaseB2(F, args, l); } }
        BAR_STAMP(3 + 5 * l_);
        {   PHASE_ARGS(); LAYER();
            pg8::Gemm g{WSP(bf16, WS_MB), WSP(bf16, WS_WOUT) + (size_t)l * DM * DM, MP, DM, DM}; pg8::StaticOrder S; S.init(MP, DM, F.G, (int)blockIdx.x);
            if (F.G == 256) {
                pg8::EpiResidTail<DM> E{WSP(bf16, WS_XB), WSP(float, WS_SSQD), M, WSP(bf16, WS_MB) + (size_t)MP * DM, WSP(bf16, WS_WOUT) + (size_t)l * DM * DM, F.vcu, WSP(bf16, WS_XB) + (size_t)MP * DM, WSP(float, WS_SSQD) + MP};
                pg8::gemm_phase<pg8::EpiResidTail<DM>, pg8::StaticOrder, false, true>(F.lds + RING_OFF, g, S, E);
            } else {
                pg8::EpiResid<false> E{WSP(bf16, WS_XB), args->out, WSP(float, WS_SSQD), M};
                pg8::gemm_phase<pg8::EpiResid<false>, pg8::StaticOrder, true, true>(F.lds + RING_OFF, g, S, E);
                Frame F2 = F; asm volatile("" : "+v"(F2.tid), "+v"(F2.lane));
                for (int tile = F.vcu; tile < 256; tile += F.G)
                    tail_gemm_resid<DM, false>(F2, WSP(bf16, WS_MB) + (size_t)MP * DM, WSP(bf16, WS_WOUT) + (size_t)l * DM * DM, WSP(bf16, WS_XB) + (size_t)MP * DM, args->out + (size_t)MP * DM, WSP(float, WS_SSQD) + MP, tile);
            }
        }
        BAR_STAMP(4 + 5 * l_);
        {   PHASE_ARGS(); LAYER();
            pg8::Gemm g{WSP(bf16, WS_XB), WSP(bf16, WS_WGU) + (size_t)l * NGU * DM, M, NGU, DM}; pg8::StaticOrder S; S.init(M, NGU, F.G, (int)blockIdx.x);
            pg8::EpiSwiGLU E{WSP(bf16, WS_HB), DFF, WSP(float, WS_SSQD), 16, M};
            for (int rep_ = 0; rep_ < REP_D; ++rep_) pg8::gemm_phase<pg8::EpiSwiGLU, pg8::StaticOrder, true, true>(F.lds + RING_OFF, g, S, E);
            const int full = ((M / 256) * (NGU / 256)) % F.G;
            if ((int)blockIdx.x >= full) { Frame F2 = F; asm volatile("" : "+v"(F2.tid), "+v"(F2.lane));
                if (l + 1 < NLAYER) cvt_range(args, l + 1, CI_IN, CI_G, ((int)blockIdx.x - full) * NWAVES + F2.wave, (F.G - full) * NWAVES, F2.lane);
                else for (int ll = 0; ll < NLAYER; ++ll) cache_copy(args, ll, ((int)blockIdx.x - full) * NWAVES + F2.wave, (F.G - full) * NWAVES, F2.lane, 1, 2); }
        }
        BAR_STAMP(5 + 5 * l_);
        {   PHASE_ARGS(); LAYER();
            pg8::Gemm g{WSP(bf16, WS_HB), WSP(bf16, WS_WDN) + (size_t)l * DM * DFF, MP, DM, DFF}; pg8::StaticOrder S; S.init(MP, DM, F.G, (int)blockIdx.x);
            if (F.G == 256) {
                pg8::EpiResidTail<DFF> E{WSP(bf16, WS_XB), WSP(float, WS_SSQA), M, WSP(bf16, WS_HB) + (size_t)MP * DFF, WSP(bf16, WS_WDN) + (size_t)l * DM * DFF, F.vcu, WSP(bf16, WS_XB) + (size_t)MP * DM, WSP(float, WS_SSQA) + MP};
                pg8::gemm_phase<pg8::EpiResidTail<DFF>, pg8::StaticOrder, false, true>(F.lds + RING_OFF, g, S, E);
            } else {
                pg8::EpiResid<false> E{WSP(bf16, WS_XB), args->out, WSP(float, WS_SSQA), M};
                pg8::gemm_phase<pg8::EpiResid<false>, pg8::StaticOrder, true, true>(F.lds + RING_OFF, g, S, E);
                Frame F2 = F; asm volatile("" : "+v"(F2.tid), "+v"(F2.lane));
                for (int tile = F.vcu; tile < 256; tile += F.G)
                    tail_gemm_resid<DFF, false>(F2, WSP(bf16, WS_HB) + (size_t)MP * DFF, WSP(bf16, WS_WDN) + (size_t)l * DM * DFF, WSP(bf16, WS_XB) + (size_t)MP * DM, args->out + (size_t)MP * DM, WSP(float, WS_SSQA) + MP, tile);
            }
        }
        BAR_STAMP(6 + 5 * l_);
    }
    for (int rep_ = 0; rep_ < REP_BAR; ++rep_) { XcdBarrier bb_ = bar; asm volatile("" : "+s"(bb_.x)); xcd_barrier<REP_BAR_REL>(bb_); }
    { PHASE_ARGS(); phase_final(F, args); }
#if PROBE_TS
    if (PROBE_PH == 6 && blockIdx.x == 0) { __syncthreads(); if (F.tid == 0) { const unsigned long long now_ = __builtin_amdgcn_s_memrealtime(); const unsigned long long t0_ = ((unsigned long long)F.MISC[17] << 32) | F.MISC[16]; const unsigned long long d_ = now_ - t0_; while (__builtin_amdgcn_s_memrealtime() < now_ + 4 * d_) __builtin_amdgcn_s_sleep(20); } }
#endif
}

extern "C" void kernel_launch(void* const* d_in, const int* in_sizes, int n_in, void* d_out, int out_size, void* d_ws, size_t ws_size, hipStream_t stream) {
    static int grid = 0;
    if (grid == 0) {
        if (n_in != 17 || (size_t)out_size != OUT_END || ws_size < WS_END) { fprintf(stderr, "kernel_launch: unexpected shapes: n_in %d out %d ws %zu\n", n_in, out_size, ws_size); grid = -1; return; }
        int dev = 0, cus = 0, per_cu = 0;
        if (hipGetDevice(&dev) != hipSuccess || hipDeviceGetAttribute(&cus, hipDeviceAttributeMultiprocessorCount, dev) != hipSuccess) { grid = -1; return; }
        if (hipFuncSetAttribute((const void*)mega_fwd, hipFuncAttributeMaxDynamicSharedMemorySize, LDS_BYTES) != hipSuccess) { fprintf(stderr, "kernel_launch: hipFuncSetAttribute failed\n"); grid = -1; return; }
        if (hipOccupancyMaxActiveBlocksPerMultiprocessor(&per_cu, (const void*)mega_fwd, NWAVES * 64, LDS_BYTES) != hipSuccess || per_cu < 1) { fprintf(stderr, "kernel_launch: occupancy query says %d blocks per CU\n", per_cu); grid = -1; (void)hipGetLastError(); return; }
        grid = cus;
        if (grid > 256) grid = 256;
        grid &= ~7;
    }
    if (grid <= 0) return;
    if (hipMemsetAsync((char*)d_ws + WS_CTL, 0, CTL_ZERO_BYTES, stream) != hipSuccess) return;
    Args a{};
    for (int i = 0; i < 17; ++i) a.in[i] = (const float*)d_in[i];
    a.out = (float*)d_out; a.ws = (unsigned char*)d_ws;
    hipLaunchKernelGGL(mega_fwd, dim3(grid), dim3(NWAVES * 64), LDS_BYTES, stream, a);
}
```

```cpp
#include <hip/hip_runtime.h>
#include <cstdio>
#include <cstdint>
namespace pg8 {
#define PG8_LAS __attribute__((address_space(3)))
typedef unsigned short bf16_t;
typedef short bf16x8 __attribute__((ext_vector_type(8)));
typedef float f32x4 __attribute__((ext_vector_type(4)));
typedef unsigned u32x4 __attribute__((ext_vector_type(4)));
constexpr int BM = 256, BK = 64, HALF = 128, HTB = HALF * BK * 2  , STAGE_BYTES = 8 * HTB, NXCD = 8, WGM = 8;

__host__ __device__ __forceinline__ int lds_byte(int r, int c) { const int st = (r >> 4) * 2 + (c >> 5), rr = r & 15, cc = c & 31, ob = rr * 64 + cc * 2; return st * 1024 + (ob ^ (((ob >> 9) & 1) << 5)); }
__host__ __device__ __forceinline__ void stage_rc(int b, int& R, int& C) { const int st = b / 1024, sb = b % 1024, swz = sb ^ (((sb >> 9) & 1) << 5); R = (st >> 1) * 16 + swz / 64; C = (st & 1) * 32 + (swz % 64) / 2; }
__host__ __device__ __forceinline__ int perm32(int rho) { const int n = rho >> 4, i = rho & 15; return 8 * (i >> 2) + 4 * n + (i & 3); }

struct Unit { int pm, pn; };
struct Gemm { const bf16_t* A; const bf16_t* Bt; int M, N, K; };

struct StaticOrder {
    static constexpr bool EARLY_ACC = false;
    int nM, nN, nwg, G, c; bool rev;
    __host__ __device__ void init(int M, int N, int G_, int c_, bool rev_ = false) { nM = M / BM; nN = N / BM; nwg = nM * nN; G = G_; c = c_; rev = rev_; }
    __host__ __device__ bool next(int i, Unit& u) const {
        const long L = (long)i * G + c; if (L >= nwg) return false;
        int wgid = rev ? nwg - 1 - (int)L : (int)L;
        const int nig = WGM * nN, gid = wgid / nig, fm = gid * WGM, gsz = (nM - fm) < WGM ? (nM - fm) : WGM;
        u.pm = fm + ((wgid % nig) % gsz); u.pn = (wgid % nig) / gsz; return true;
    }
    __device__ __forceinline__ void a_ready(const Unit&) const {}
    __device__ __forceinline__ void done(const Unit&) const {}
};

struct XcdOrder {
    static constexpr bool EARLY_ACC = false;
    int nN, c;
    __host__ __device__ void init(int  , int N, int  , int c_) { nN = N / BM; c = c_; }
    __host__ __device__ bool next(int i, Unit& u) const {
        const int xcd = c & 7, j = c >> 3, L = i * 32 + j, nloc = 8 * nN;
        if (L < nloc) { u.pm = 8 * xcd + (L & 7); u.pn = L >> 3; return true; }
        const int t = xcd + 8 * (L - nloc); if (t >= 2 * nN) return false;
        u.pm = 64 + t / nN; u.pn = t % nN; return true;
    }
    __device__ __forceinline__ void a_ready(const Unit&) const {}
    __device__ __forceinline__ void done(const Unit&) const {}
};

struct MeetOrder : StaticOrder {
    static constexpr bool EARLY_ACC = true;
    unsigned* cnt; int wave;
    __device__ __forceinline__ void a_ready(const Unit&) const {
        unsigned ln_; asm volatile("v_mbcnt_lo_u32_b32 %0, -1, 0\n\tv_mbcnt_hi_u32_b32 %0, -1, %0" : "=v"(ln_));
        if (wave == 0 && ln_ == 0u) { unsigned sp_ = 0;
            while (__hip_atomic_load(cnt, __ATOMIC_RELAXED, __HIP_MEMORY_SCOPE_AGENT) < 4u) { __builtin_amdgcn_s_sleep(1); if (++sp_ > (1u << 22)) break; }
            asm volatile("s_waitcnt vmcnt(0)" ::: "memory"); }
        __syncthreads();
    }
};

typedef float f32x2_t __attribute__((ext_vector_type(2))); typedef __bf16 bf16x2_t __attribute__((ext_vector_type(2)));
__device__ __forceinline__ unsigned cvt_pk_bf16(float lo, float hi) { const f32x2_t v = {lo, hi}; const bf16x2_t b = __builtin_convertvector(v, bf16x2_t); return __builtin_bit_cast(unsigned, b); }
template <int OFF> __device__ __forceinline__ void store16_wt(void* p, u32x4 v) { asm volatile("global_store_dwordx4 %0, %1, off offset:%2 sc1\n\ts_nop 1" :: "v"(p), "v"(v), "i"(OFF) : "memory"); }
constexpr int SSQ_SLOTS = 16;
constexpr float RMS_EPS = 1e-6f;
struct RstdState { float rs[2]; };
__device__ __forceinline__ void rstd_issue(const float* ssq, int nslots, int mrows, int pm, int wr, int lane, float (&v)[2][16]) {
    if (nslots == 16) {
#pragma unroll
        for (int ai = 0; ai < 2; ++ai) { const float* p = ssq + (size_t)(pm * BM + ai * HALF + wr * 64 + lane);
#pragma unroll
            for (int k = 0; k < 16; ++k) v[ai][k] = p[(size_t)k * mrows]; }
    } else {
#pragma unroll
        for (int ai = 0; ai < 2; ++ai) { v[ai][0] = ssq[(size_t)(pm * BM + ai * HALF + wr * 64 + lane)];
#pragma unroll
            for (int k = 1; k < 16; ++k) v[ai][k] = 0.f; }
    }
}
__device__ __forceinline__ void rstd_finish(const float (&v)[2][16], float (&rs)[2]) {
#pragma unroll
    for (int ai = 0; ai < 2; ++ai) { float s = 0.f;
#pragma unroll
        for (int k = 0; k < 16; ++k) s += v[ai][k];
        rs[ai] = rsqrtf(s * (1.0f / 1024.0f) + RMS_EPS); }
}
struct EpiScaleBf16 {
    static constexpr bool PERM = true, AFTER_DRAIN = false, XROWS = false;
    typedef RstdState State;
    bf16_t* O; int ldc; const float* ssq; int nslots, mrows;
    __device__ __forceinline__ void init(State& st, const Unit& u, int wr, int lane) const { float v[2][16]; rstd_issue(ssq, nslots, mrows, u.pm, wr, lane, v); rstd_finish(v, st.rs); asm volatile("" : "+v"(st.rs[0]), "+v"(st.rs[1])); }
    __device__ __forceinline__ void acc_init(f32x4 (&)[2][2][4][2], const Unit&, int, int, int, int) const {}
    __device__ __forceinline__ void operator()(const f32x4 (&acc)[2][2][4][2], const Unit& u, int wr, int wc, int fr, int fq, State& st, bool has_next, const Unit& nxt) const {
        float v[2][16]; rstd_issue(ssq, nslots, mrows, has_next ? nxt.pm : u.pm, wr, fq * 16 + fr, v);
        const int row0 = u.pm * BM + wr * 64 + fr;
        if (u.pn < 5) {
            const int col0 = u.pn * BM + wc * 32 + 8 * fq;
#pragma unroll
            for (int ai = 0; ai < 2; ++ai)
#pragma unroll
                for (int m = 0; m < 4; ++m) { const float sc = __shfl(st.rs[ai], 16 * m + fr); bf16_t* rowp = O + (size_t)(row0 + ai * HALF + m * 16) * ldc + col0;
#pragma unroll
                    for (int bj = 0; bj < 2; ++bj) { const f32x4 v0 = acc[ai][bj][m][0] * sc, v1 = acc[ai][bj][m][1] * sc;
                        u32x4 w; w.x = cvt_pk_bf16(v0[0], v0[1]); w.y = cvt_pk_bf16(v0[2], v0[3]); w.z = cvt_pk_bf16(v1[0], v1[1]); w.w = cvt_pk_bf16(v1[2], v1[3]);
                        if (bj == 0) store16_wt<0>(rowp, w); else store16_wt<HALF * 2>(rowp, w); } }
        } else {
            const int col0 = 1280 + (u.pn - 5) * HALF + wc * 32 + 8 * fq;
#pragma unroll
            for (int ai = 0; ai < 2; ++ai)
#pragma unroll
                for (int m = 0; m < 4; ++m) { const float sc = __shfl(st.rs[ai], 16 * m + fr), s2 = sc * sc; bf16_t* rowp = O + (size_t)(row0 + ai * HALF + m * 16) * ldc + col0;
                    const f32x4 v0 = acc[ai][0][m][0] * acc[ai][1][m][0] * s2, v1 = acc[ai][0][m][1] * acc[ai][1][m][1] * s2;
                    u32x4 w; w.x = cvt_pk_bf16(v0[0], v0[1]); w.y = cvt_pk_bf16(v0[2], v0[3]); w.z = cvt_pk_bf16(v1[0], v1[1]); w.w = cvt_pk_bf16(v1[2], v1[3]);
                    store16_wt<0>(rowp, w); }
        }
        { rstd_finish(v, st.rs); asm volatile("" : "+v"(st.rs[0]), "+v"(st.rs[1])); }
    }
};
struct EpiSwiGLU {
    static constexpr bool PERM = true, AFTER_DRAIN = false, XROWS = false;
    typedef RstdState State;
    bf16_t* O; int ldc; const float* ssq; int nslots, mrows;
    __device__ __forceinline__ void init(State& st, const Unit& u, int wr, int lane) const { float v[2][16]; rstd_issue(ssq, nslots, mrows, u.pm, wr, lane, v); rstd_finish(v, st.rs); asm volatile("" : "+v"(st.rs[0]), "+v"(st.rs[1])); }
    __device__ __forceinline__ void acc_init(f32x4 (&)[2][2][4][2], const Unit&, int, int, int, int) const {}
    __device__ __forceinline__ void operator()(const f32x4 (&acc)[2][2][4][2], const Unit& u, int wr, int wc, int fr, int fq, State& st, bool has_next, const Unit& nxt) const {
        float v[2][16]; rstd_issue(ssq, nslots, mrows, has_next ? nxt.pm : u.pm, wr, fq * 16 + fr, v);
        const int row0 = u.pm * BM + wr * 64 + fr, col0 = u.pn * HALF + wc * 32 + 8 * fq;
#pragma unroll
        for (int ai = 0; ai < 2; ++ai)
#pragma unroll
            for (int m = 0; m < 4; ++m) { const float sc = __shfl(st.rs[ai], 16 * m + fr); bf16_t* rowp = O + (size_t)(row0 + ai * HALF + m * 16) * ldc + col0;
                const float k1 = -sc * 1.4426950408889634f, s2 = sc * sc;
                f32x4 hv[2];
#pragma unroll
                for (int n = 0; n < 2; ++n) { const f32x4 ag = acc[ai][0][m][n], au = acc[ai][1][m][n], t = ag * k1; f32x4 r;
#pragma unroll
                    for (int i = 0; i < 4; ++i) r[i] = __builtin_amdgcn_rcpf(1.0f + __builtin_amdgcn_exp2f(t[i]));
                    hv[n] = (ag * au) * (r * s2); }
                u32x4 w; w.x = cvt_pk_bf16(hv[0][0], hv[0][1]); w.y = cvt_pk_bf16(hv[0][2], hv[0][3]); w.z = cvt_pk_bf16(hv[1][0], hv[1][1]); w.w = cvt_pk_bf16(hv[1][2], hv[1][3]);
                store16_wt<0>(rowp, w); }
        { rstd_finish(v, st.rs); asm volatile("" : "+v"(st.rs[0]), "+v"(st.rs[1])); }
    }
};
__device__ __forceinline__ float bf_lo(unsigned w) { return __uint_as_float(w << 16); }
__device__ __forceinline__ float bf_hi(unsigned w) { return __uint_as_float(w & 0xffff0000u); }
template <bool LAST> struct EpiResid {
    static constexpr bool PERM = true, AFTER_DRAIN = false, XROWS = false;
    struct State {};
    bf16_t* xb; float* out; float* ssq_out; int mrows;
    __device__ __forceinline__ void init(State&, const Unit&, int, int) const {}
    __device__ __forceinline__ void acc_init(f32x4 (&acc)[2][2][4][2], const Unit& u, int wr, int wc, int fr, int fq) const {
        const int lrow0 = wr * 64 + fr, col0 = u.pn * BM + wc * 32 + 8 * fq;
        u32x4 b[2][4][2];
#pragma unroll
        for (int ai = 0; ai < 2; ++ai)
#pragma unroll
            for (int m = 0; m < 4; ++m)
#pragma unroll
                for (int bj = 0; bj < 2; ++bj) b[ai][m][bj] = *(const u32x4*)(xb + ((size_t)u.pm * BM + lrow0 + ai * HALF + m * 16) * 1024 + col0 + bj * HALF);
#pragma unroll
        for (int ai = 0; ai < 2; ++ai)
#pragma unroll
            for (int m = 0; m < 4; ++m)
#pragma unroll
                for (int bj = 0; bj < 2; ++bj) { const u32x4 w = b[ai][m][bj];
                    acc[ai][bj][m][0] = (f32x4){bf_lo(w.x), bf_hi(w.x), bf_lo(w.y), bf_hi(w.y)}; acc[ai][bj][m][1] = (f32x4){bf_lo(w.z), bf_hi(w.z), bf_lo(w.w), bf_hi(w.w)}; }
    }
    __device__ __forceinline__ void operator()(const f32x4 (&acc)[2][2][4][2], const Unit& u, int wr, int wc, int fr, int fq, State&, bool, const Unit&) const {
        const int lrow0 = wr * 64 + fr, col0 = u.pn * BM + wc * 32 + 8 * fq;
#pragma unroll
        for (int ai = 0; ai < 2; ++ai)
#pragma unroll
            for (int m = 0; m < 4; ++m) { const size_t grow = (size_t)u.pm * BM + lrow0 + ai * HALF + m * 16; float q = 0.f;
#pragma unroll
                for (int bj = 0; bj < 2; ++bj) { const f32x4 v0 = acc[ai][bj][m][0], v1 = acc[ai][bj][m][1];
                    if (LAST) { float* op = out + grow * 1024 + col0 + bj * HALF; *(f32x4*)op = v0; *(f32x4*)(op + 4) = v1; }
                    else { u32x4 w; w.x = cvt_pk_bf16(v0[0], v0[1]); w.y = cvt_pk_bf16(v0[2], v0[3]); w.z = cvt_pk_bf16(v1[0], v1[1]); w.w = cvt_pk_bf16(v1[2], v1[3]); if (bj == 0) store16_wt<0>(xb + grow * 1024 + col0, w); else store16_wt<HALF * 2>(xb + grow * 1024 + col0, w); }
                    q += ((v0[0] * v0[0] + v0[1] * v0[1]) + (v0[2] * v0[2] + v0[3] * v0[3])) + ((v1[0] * v1[0] + v1[1] * v1[1]) + (v1[2] * v1[2] + v1[3] * v1[3])); }
                q += __shfl_xor(q, 16); q += __shfl_xor(q, 32);
                if (fq == 0) ssq_out[(size_t)(u.pn * 4 + wc) * mrows + grow] = q; }
    }
};

template <int K, bool ASCALE, bool FIN = false> struct EpiResidX {
    static constexpr bool PERM = true, AFTER_DRAIN = true, XROWS = true;
    struct State {};
    bf16_t* xb; float* ssq_out; int mrows;
    const bf16_t* xA; int xrows;
    bf16_t* xbs; float* ssq_rows;
    const float* ssq_attn;
    int xpm;
    float* yout; const float* fgain; unsigned* cnt; int mp_rows;
    __device__ __forceinline__ void init(State&, const Unit&, int, int) const {}
    __device__ __forceinline__ void acc_init(f32x4 (&acc)[2][2][4][2], const Unit& u, int wr, int wc, int fr, int fq) const {
        const int lrow0 = wr * 64 + fr, col0 = u.pn * BM + wc * 32 + 8 * fq;
#pragma unroll
        for (int ai = 0; ai < 2; ++ai) {
            u32x4 b[4][2];
#pragma unroll
            for (int m = 0; m < 4; ++m)
#pragma unroll
                for (int bj = 0; bj < 2; ++bj) b[m][bj] = *(const u32x4*)(xb + ((size_t)u.pm * BM + lrow0 + ai * HALF + m * 16) * 1024 + col0 + bj * HALF);
#pragma unroll
            for (int m = 0; m < 4; ++m)
#pragma unroll
                for (int bj = 0; bj < 2; ++bj) { const u32x4 w = b[m][bj];
                    acc[ai][bj][m][0] = (f32x4){bf_lo(w.x), bf_hi(w.x), bf_lo(w.y), bf_hi(w.y)}; acc[ai][bj][m][1] = (f32x4){bf_lo(w.z), bf_hi(w.z), bf_lo(w.w), bf_hi(w.w)}; }
            asm volatile("" ::: "memory");
        }
    }
    __device__ __forceinline__ void xscale(f32x4 (&xacc)[2], int t) const {
        if (ASCALE && t == 8) { int lane; asm volatile("v_mbcnt_lo_u32_b32 %0, -1, 0\n\tv_mbcnt_hi_u32_b32 %0, -1, %0" : "=v"(lane));
            int xr = 8 * xpm + (lane & 15); xr = xr < xrows ? xr : xrows - 1;
            const f32x2_t sq = *(const f32x2_t*)(ssq_attn + 2 * xr); const float rs = rsqrtf((sq[0] + sq[1]) * (1.0f / 512.0f) + RMS_EPS);
#pragma unroll
            for (int n = 0; n < 2; ++n) xacc[n] *= rs; }
    }
    __device__ __forceinline__ void main_group(const f32x4 (&acc)[2][2][4][2], const Unit& u, int g, int wr, int wc, int fr, int fq) const {
        const int ai = g >> 2, m = g & 3;
        const size_t grow = (size_t)u.pm * BM + wr * 64 + fr + ai * HALF + m * 16; const int col0 = u.pn * BM + wc * 32 + 8 * fq; float q = 0.f;
#pragma unroll
        for (int bj = 0; bj < 2; ++bj) { const f32x4 v0 = acc[ai][bj][m][0], v1 = acc[ai][bj][m][1];
            u32x4 w; w.x = cvt_pk_bf16(v0[0], v0[1]); w.y = cvt_pk_bf16(v0[2], v0[3]); w.z = cvt_pk_bf16(v1[0], v1[1]); w.w = cvt_pk_bf16(v1[2], v1[3]);
            if (bj == 0) store16_wt<0>(xb + grow * 1024 + col0, w); else store16_wt<HALF * 2>(xb + grow * 1024 + col0, w);
            q += ((v0[0] * v0[0] + v0[1] * v0[1]) + (v0[2] * v0[2] + v0[3] * v0[3])) + ((v1[0] * v1[0] + v1[1] * v1[1]) + (v1[2] * v1[2] + v1[3] * v1[3])); }
        q += __shfl_xor(q, 16); q += __shfl_xor(q, 32);
        if (fq == 0) ssq_out[(size_t)(u.pn * 4 + wc) * mrows + grow] = q;
    }
    __device__ __forceinline__ void fused_fin(f32x4 (&acc)[2][2][4][2], f32x4 (&xacc)[2], const Unit& u, PG8_LAS unsigned char* lds, int wave, int lane, int wr, int wc, int fr, int fq) const {
        const int tid = wave * 64 + lane;
        const size_t srow = (size_t)8 * u.pm + (fr & 7); const int scol = u.pn * BM + wr * HALF + wc * 32 + 8 * fq;
        const u32x4 w0 = *(const u32x4*)(xbs + srow * 1024 + scol);
        const f32x4 s0 = xacc[0] + (f32x4){bf_lo(w0.x), bf_hi(w0.x), bf_lo(w0.y), bf_hi(w0.y)}, s1 = xacc[1] + (f32x4){bf_lo(w0.z), bf_hi(w0.z), bf_lo(w0.w), bf_hi(w0.w)};
        float qs = ((s0[0] * s0[0] + s0[1] * s0[1]) + (s0[2] * s0[2] + s0[3] * s0[3])) + ((s1[0] * s1[0] + s1[1] * s1[1]) + (s1[2] * s1[2] + s1[3] * s1[3]));
        qs += __shfl_xor(qs, 16); qs += __shfl_xor(qs, 32);
        PG8_LAS float* ex = (PG8_LAS float*)(lds + 131072 + 8192);
        if (wr == 1 && fq == 0) ex[wc * 16 + fr] = qs;
#pragma unroll
        for (int ai = 0; ai < 2; ++ai)
#pragma unroll
            for (int m = 0; m < 4; ++m) { const size_t grow = (size_t)u.pm * BM + wr * 64 + fr + ai * HALF + m * 16; float q = 0.f;
#pragma unroll
                for (int bj = 0; bj < 2; ++bj) { const f32x4 v0 = acc[ai][bj][m][0], v1 = acc[ai][bj][m][1];
                    q += ((v0[0] * v0[0] + v0[1] * v0[1]) + (v0[2] * v0[2] + v0[3] * v0[3])) + ((v1[0] * v1[0] + v1[1] * v1[1]) + (v1[2] * v1[2] + v1[3] * v1[3])); }
                q += __shfl_xor(q, 16); q += __shfl_xor(q, 32);
                if (fq == 0) __hip_atomic_store(ssq_out + (size_t)(u.pn * 4 + wc) * mrows + grow, q, __ATOMIC_RELAXED, __HIP_MEMORY_SCOPE_AGENT); }
        asm volatile("s_waitcnt lgkmcnt(0)" ::: "memory"); __builtin_amdgcn_s_barrier(); asm volatile("" ::: "memory");
        if (wr == 0 && fq == 0 && fr < 8) __hip_atomic_store(ssq_rows + (size_t)(u.pn * 4 + wc) * mrows + srow, qs + ex[wc * 16 + fr], __ATOMIC_RELAXED, __HIP_MEMORY_SCOPE_AGENT);
        asm volatile("s_waitcnt vmcnt(0)" ::: "memory"); __builtin_amdgcn_s_barrier(); asm volatile("" ::: "memory");
        if (tid == 0) { unsigned* c = cnt + u.pm; (void)__hip_atomic_fetch_add(c, 1u, __ATOMIC_RELAXED, __HIP_MEMORY_SCOPE_AGENT);
            unsigned sp = 0; while (__hip_atomic_load(c, __ATOMIC_RELAXED, __HIP_MEMORY_SCOPE_AGENT) < 4u) { __builtin_amdgcn_s_sleep(1); if (++sp > (1u << 22)) break; } }
        asm volatile("s_waitcnt vmcnt(0) lgkmcnt(0)" ::: "memory"); __builtin_amdgcn_s_barrier(); asm volatile("" ::: "memory");
        const int col0 = u.pn * BM + wc * 32 + 8 * fq;
        f32x4 g[2][2];
#pragma unroll
        for (int bj = 0; bj < 2; ++bj) { g[bj][0] = *(const f32x4*)(fgain + col0 + bj * HALF); g[bj][1] = *(const f32x4*)(fgain + col0 + bj * HALF + 4); }
        float rsv[2][4];
        {   float pv[2][4][4];
#pragma unroll
            for (int ai = 0; ai < 2; ++ai)
#pragma unroll
                for (int m = 0; m < 4; ++m) { const size_t grow = (size_t)u.pm * BM + ai * HALF + wr * 64 + m * 16 + fr;
#pragma unroll
                    for (int s4 = 0; s4 < 4; ++s4) pv[ai][m][s4] = __hip_atomic_load(ssq_out + (size_t)(4 * fq + s4) * mrows + grow, __ATOMIC_RELAXED, __HIP_MEMORY_SCOPE_AGENT); }
#pragma unroll
            for (int ai = 0; ai < 2; ++ai)
#pragma unroll
                for (int m = 0; m < 4; ++m) { float part = (pv[ai][m][0] + pv[ai][m][1]) + (pv[ai][m][2] + pv[ai][m][3]);
                    part += __shfl_xor(part, 16); part += __shfl_xor(part, 32);
                    rsv[ai][m] = rsqrtf(part * (1.0f / 1024.0f) + RMS_EPS); } }
#pragma unroll
        for (int ai = 0; ai < 2; ++ai) {
#pragma unroll
            for (int m = 0; m < 4; ++m) { const int lr = wr * 64 + m * 16 + fr; const float rs = rsv[ai][m];
#pragma unroll
                for (int bj = 0; bj < 2; ++bj) { const int p = bj * 32 + wc * 8 + fq * 2;
                    *(PG8_LAS f32x4*)(lds + lr * 1024 + ((p ^ (lr & 63)) * 16)) = acc[ai][bj][m][0] * rs * g[bj][0];
                    *(PG8_LAS f32x4*)(lds + lr * 1024 + (((p + 1) ^ (lr & 63)) * 16)) = acc[ai][bj][m][1] * rs * g[bj][1]; } }
            asm volatile("s_waitcnt lgkmcnt(0)" ::: "memory"); __builtin_amdgcn_s_barrier(); asm volatile("" ::: "memory");
#pragma unroll 1
            for (int i0 = 0; i0 < 16; i0 += 8) {
                f32x4 v[8];
#pragma unroll
                for (int j = 0; j < 8; ++j) { const int r = wave * 16 + i0 + j; v[j] = *(const PG8_LAS f32x4*)(lds + r * 1024 + lane * 16); }
#pragma unroll
                for (int j = 0; j < 8; ++j) { const int r = wave * 16 + i0 + j;
                    __builtin_nontemporal_store(v[j], (f32x4*)(yout + ((size_t)u.pm * BM + ai * HALF + r) * 1024 + u.pn * BM + ((lane ^ (r & 63)) * 4))); }
            }
            asm volatile("s_waitcnt lgkmcnt(0)" ::: "memory"); __builtin_amdgcn_s_barrier(); asm volatile("" ::: "memory");
        }
        {   float part = 0.f;
#pragma unroll
            for (int s4 = 0; s4 < 4; ++s4) part += __hip_atomic_load(ssq_rows + (size_t)(4 * fq + s4) * mrows + srow, __ATOMIC_RELAXED, __HIP_MEMORY_SCOPE_AGENT);
            part += __shfl_xor(part, 16); part += __shfl_xor(part, 32);
            const float rs = rsqrtf(part * (1.0f / 1024.0f) + RMS_EPS);
            const f32x4 g0 = *(const f32x4*)(fgain + scol), g1 = *(const f32x4*)(fgain + scol + 4);
            if (fr < 8) { float* yp = yout + ((size_t)mp_rows + srow) * 1024 + scol; __builtin_nontemporal_store(s0 * rs * g0, (f32x4*)yp); __builtin_nontemporal_store(s1 * rs * g1, (f32x4*)(yp + 4)); } }
    }
    __device__ __forceinline__ void fused_x(f32x4 (&acc)[2][2][4][2], f32x4 (&xacc)[2], const Unit& u, PG8_LAS unsigned char* lds, int wave) const {
        int lane; asm volatile("v_mbcnt_lo_u32_b32 %0, -1, 0\n\tv_mbcnt_hi_u32_b32 %0, -1, %0" : "=v"(lane));
        const int wr = wave >> 2, wc = wave & 3, fr = lane & 15, fq = lane >> 4;
        if constexpr (FIN) { fused_fin(acc, xacc, u, lds, wave, lane, wr, wc, fr, fq); return; }
        const size_t srow = (size_t)8 * u.pm + (fr & 7); const int scol = u.pn * BM + wr * HALF + wc * 32 + 8 * fq;
        const u32x4 w0 = *(const u32x4*)(xbs + srow * 1024 + scol);
        const f32x4 v0 = xacc[0] + (f32x4){bf_lo(w0.x), bf_hi(w0.x), bf_lo(w0.y), bf_hi(w0.y)}, v1 = xacc[1] + (f32x4){bf_lo(w0.z), bf_hi(w0.z), bf_lo(w0.w), bf_hi(w0.w)};
        u32x4 w; w.x = cvt_pk_bf16(v0[0], v0[1]); w.y = cvt_pk_bf16(v0[2], v0[3]); w.z = cvt_pk_bf16(v1[0], v1[1]); w.w = cvt_pk_bf16(v1[2], v1[3]);
        if (fr < 8) *(u32x4*)(xbs + srow * 1024 + scol) = w;
        float q = ((v0[0] * v0[0] + v0[1] * v0[1]) + (v0[2] * v0[2] + v0[3] * v0[3])) + ((v1[0] * v1[0] + v1[1] * v1[1]) + (v1[2] * v1[2] + v1[3] * v1[3]));
        q += __shfl_xor(q, 16); q += __shfl_xor(q, 32);
        PG8_LAS float* ex = (PG8_LAS float*)lds;
        if (wr == 1 && fq == 0) ex[wc * 16 + fr] = q;
#pragma unroll
        for (int g = 0; g < 8; ++g) main_group(acc, u, g, wr, wc, fr, fq);
        asm volatile("s_waitcnt lgkmcnt(0)" ::: "memory"); __builtin_amdgcn_s_barrier(); asm volatile("" ::: "memory");
        if (wr == 0 && fq == 0 && fr < 8) ssq_rows[(size_t)(u.pn * 4 + wc) * mrows + srow] = q + ex[wc * 16 + fr];
    }
};
template <class Epi, class Sched, bool ALIGN_EPI = false, bool SP2 = false>
__device__ __forceinline__ void gemm_phase(PG8_LAS unsigned char* lds, const Gemm g, const Sched& S, const Epi& E, int wave_) {
    int tid_; asm volatile("v_mbcnt_lo_u32_b32 %0, -1, 0\n\tv_mbcnt_hi_u32_b32 %0, -1, %0" : "=v"(tid_)); tid_ += wave_ * 64; asm volatile("" : "+v"(tid_));
    const int tid = tid_, wid = __builtin_amdgcn_readfirstlane(tid >> 6), lane = tid & 63, wr = wid >> 2, wc = wid & 3, fr = lane & 15, fq = lane >> 4;
    const int K = g.K, nt = K / BK;
    unsigned voffA[2], voffB[2];
#pragma unroll
    for (int i = 0; i < 2; ++i) { int R, C; stage_rc(tid * 16 + i * 8192, R, C); const int Rb = Epi::PERM ? ((R & ~31) + perm32(R & 31)) : R;
        voffA[i] = (unsigned)(R * K + C) * 2u; voffB[i] = (unsigned)(Rb * K + C) * 2u; }
    const size_t kstep = (size_t)(BK * 2);
    const size_t hstep = (size_t)HALF * K * 2;
    const size_t tstep = 2 * hstep;
    const unsigned ldsw = (unsigned)wid * 1024u;
    const int aoff = lds_byte(wr * 64 + fr, fq * 8), boff = lds_byte(wc * 32 + fr, fq * 8);
#define PG8_SA(b, h) (((b) * 2 + (h)) * HTB)
#define PG8_SB(b, h) ((4 + (b) * 2 + (h)) * HTB)
#define PG8_STAGE(bufoff, gbase, voff) do { _Pragma("unroll") for (int _i = 0; _i < 2; ++_i) \
        __builtin_amdgcn_global_load_lds((const unsigned*)((const char*)(gbase) + (voff)[_i]), (PG8_LAS unsigned*)(lds + (bufoff) + ldsw + _i * 8192), 16, 0, 0); } while (0)
#define PG8_LDA(dst, b, h) do { _Pragma("unroll") for (int m = 0; m < 4; ++m) _Pragma("unroll") for (int k = 0; k < 2; ++k) dst[m][k] = *(const PG8_LAS bf16x8*)(lds + PG8_SA(b, h) + aoff + m * 2048 + k * 1024); } while (0)
#define PG8_LDB(dst, b, h) do { _Pragma("unroll") for (int n = 0; n < 2; ++n) _Pragma("unroll") for (int k = 0; k < 2; ++k) dst[n][k] = *(const PG8_LAS bf16x8*)(lds + PG8_SB(b, h) + boff + n * 2048 + k * 1024); } while (0)
#define PG8_MMA(ai, bj, At, Bt) do { __builtin_amdgcn_s_setprio(1); _Pragma("unroll") for (int m = 0; m < 4; ++m) _Pragma("unroll") for (int n = 0; n < 2; ++n) _Pragma("unroll") for (int k = 0; k < 2; ++k) \
        acc[ai][bj][m][n] = __builtin_amdgcn_mfma_f32_16x16x32_bf16(Bt[n][k], At[m][k], acc[ai][bj][m][n], 0, 0, 0); __builtin_amdgcn_s_setprio(0); } while (0)
#define PG8_WAIT_V(n) asm volatile("s_waitcnt vmcnt(" #n ")" ::: "memory")
#define PG8_WAIT_L(n) asm volatile("s_waitcnt lgkmcnt(" #n ")" ::: "memory")
#define PG8_BAR __builtin_amdgcn_s_barrier()
#define PG8_SCHED __builtin_amdgcn_sched_barrier(0)
    Unit cur, nxt; int ui = 0;
    if (!S.next(0, cur)) return;
    f32x4 acc[2][2][4][2];
#pragma unroll
    for (int a = 0; a < 2; ++a)
#pragma unroll
        for (int b = 0; b < 2; ++b)
#pragma unroll
            for (int m = 0; m < 4; ++m)
#pragma unroll
                for (int n = 0; n < 2; ++n) acc[a][b][m][n] = (f32x4){0.f, 0.f, 0.f, 0.f};
    bf16x8 At[4][2], B0[2][2], B1[2][2];
    f32x4 xacc[2]; bf16x8 xf[2]; unsigned xvoff = 0; const char* cX = nullptr;
#pragma unroll
    for (int n = 0; n < 2; ++n) xacc[n] = (f32x4){0.f, 0.f, 0.f, 0.f};
    constexpr int XS_OFF = 131072;
#define PG8_XSTAGE(buf, kt_) do { if (lane < 16) __builtin_amdgcn_global_load_lds((const unsigned*)(cX + xvoff + (size_t)(kt_) * kstep), (PG8_LAS unsigned*)(lds + XS_OFF + (buf) * 2048 + wid * 256), 16, 0, 0); } while (0)
#define PG8_XLD(buf) do { xf[0] = *(const PG8_LAS bf16x8*)(lds + XS_OFF + (buf) * 2048 + lane * 16); xf[1] = *(const PG8_LAS bf16x8*)(lds + XS_OFF + (buf) * 2048 + 1024 + lane * 16); } while (0)
#define PG8_XMMA() do { __builtin_amdgcn_s_setprio(1); if (wr) { _Pragma("unroll") for (int n = 0; n < 2; ++n) _Pragma("unroll") for (int k = 0; k < 2; ++k) xacc[n] = __builtin_amdgcn_mfma_f32_16x16x32_bf16(B1[n][k], xf[k], xacc[n], 0, 0, 0); } \
        else { _Pragma("unroll") for (int n = 0; n < 2; ++n) _Pragma("unroll") for (int k = 0; k < 2; ++k) xacc[n] = __builtin_amdgcn_mfma_f32_16x16x32_bf16(B0[n][k], xf[k], xacc[n], 0, 0, 0); } __builtin_amdgcn_s_setprio(0); } while (0)
    const char* cA = (const char*)g.A + (size_t)cur.pm * tstep; const char* cB = (const char*)g.Bt + (size_t)cur.pn * tstep;
    if constexpr (Epi::XROWS) { int xr = 8 * cur.pm + (lane & 15); xr = xr < E.xrows ? xr : E.xrows - 1; cX = (const char*)E.xA; xvoff = (unsigned)((xr * K + 32 * (wid >> 2) + 8 * (wid & 3)) * 2); }
    typename Epi::State est;
    if constexpr (SP2) {
        PG8_STAGE(PG8_SB(0, 0), cB, voffB); PG8_STAGE(PG8_SB(0, 1), cB + hstep, voffB);
        if constexpr (Sched::EARLY_ACC) E.acc_init(acc, cur, wr, wc, fr, fq);
        S.a_ready(cur);
        PG8_STAGE(PG8_SA(0, 0), cA, voffA); if constexpr (Epi::XROWS) PG8_XSTAGE(0, 0); PG8_STAGE(PG8_SA(0, 1), cA + hstep, voffA);
        E.init(est, cur, wr, lane); if constexpr (!Sched::EARLY_ACC) E.acc_init(acc, cur, wr, wc, fr, fq);
        if (wr == 1) PG8_BAR;
        PG8_WAIT_V(2); PG8_BAR;
        if constexpr (Epi::XROWS) PG8_XSTAGE(1, 1);
        PG8_STAGE(PG8_SB(1, 0), cB + kstep, voffB); PG8_STAGE(PG8_SA(1, 0), cA + kstep, voffA); PG8_STAGE(PG8_SB(1, 1), cB + hstep + kstep, voffB);
        PG8_WAIT_V(6); PG8_BAR;
    } else {
        S.a_ready(cur);
        PG8_STAGE(PG8_SB(0, 0), cB, voffB); PG8_STAGE(PG8_SA(0, 0), cA, voffA); PG8_STAGE(PG8_SB(0, 1), cB + hstep, voffB); PG8_STAGE(PG8_SA(0, 1), cA + hstep, voffA);
        E.init(est, cur, wr, lane); E.acc_init(acc, cur, wr, wc, fr, fq);
        if (wr == 1) PG8_BAR;
        PG8_WAIT_V(4); PG8_BAR;
        PG8_STAGE(PG8_SB(1, 0), cB + kstep, voffB); PG8_STAGE(PG8_SA(1, 0), cA + kstep, voffA); PG8_STAGE(PG8_SB(1, 1), cB + hstep + kstep, voffB);
        PG8_WAIT_V(6); PG8_BAR;
    }
    for (;;) {
        const bool has_next = Epi::XROWS ? false : S.next(ui + 1, nxt);
        const char* nA = has_next ? (const char*)g.A + (size_t)nxt.pm * tstep : cA; const char* nB = has_next ? (const char*)g.Bt + (size_t)nxt.pn * tstep : cB;
        for (int t = 0; t < nt; t += 2) {
            const bool last = (t == nt - 2);
            const char* a1 = cA + (size_t)(t + 1) * kstep;
            const char* a2 = last ? nA : cA + (size_t)(t + 2) * kstep; const char* b2 = last ? nB : cB + (size_t)(t + 2) * kstep;
            const char* a3 = a2 + kstep; const char* b3 = b2 + kstep;
            if (last && has_next) S.a_ready(nxt);
            if constexpr (SP2) {
            if constexpr (Epi::XROWS) E.xscale(xacc, t);
            PG8_LDB(B0, 0, 0); PG8_LDB(B1, 0, 1); PG8_SCHED; PG8_LDA(At, 0, 0); if constexpr (Epi::XROWS) PG8_XLD(0); PG8_STAGE(PG8_SA(1, 1), a1 + hstep, voffA);
            if constexpr (Epi::XROWS) PG8_WAIT_V(9); else PG8_WAIT_V(8);
            PG8_WAIT_L(0); PG8_BAR; PG8_MMA(0, 0, At, B0); PG8_MMA(0, 1, At, B1); if constexpr (Epi::XROWS) PG8_XMMA(); PG8_BAR; PG8_SCHED;
            PG8_LDA(At, 0, 1); PG8_STAGE(PG8_SB(0, 0), b2, voffB); PG8_STAGE(PG8_SB(0, 1), b2 + hstep, voffB); PG8_STAGE(PG8_SA(0, 0), a2, voffA); if constexpr (Epi::XROWS) PG8_XSTAGE(0, last ? 0 : t + 2);
            if constexpr (Epi::XROWS) PG8_WAIT_V(9); else PG8_WAIT_V(8);
            PG8_WAIT_L(0); PG8_BAR; PG8_MMA(1, 0, At, B0); PG8_MMA(1, 1, At, B1); PG8_BAR; PG8_SCHED;
            PG8_LDB(B0, 1, 0); PG8_LDB(B1, 1, 1); PG8_SCHED; PG8_LDA(At, 1, 0); if constexpr (Epi::XROWS) PG8_XLD(1); PG8_STAGE(PG8_SA(0, 1), a2 + hstep, voffA);
            if constexpr (Epi::XROWS) PG8_WAIT_V(9); else PG8_WAIT_V(8);
            PG8_WAIT_L(0); PG8_BAR; PG8_MMA(0, 0, At, B0); PG8_MMA(0, 1, At, B1); if constexpr (Epi::XROWS) PG8_XMMA(); PG8_BAR; PG8_SCHED;
            PG8_LDA(At, 1, 1); PG8_STAGE(PG8_SB(1, 0), b3, voffB); PG8_STAGE(PG8_SB(1, 1), b3 + hstep, voffB); PG8_STAGE(PG8_SA(1, 0), a3, voffA); if constexpr (Epi::XROWS) PG8_XSTAGE(1, last ? 1 : t + 3);
            if constexpr (Epi::XROWS) PG8_WAIT_V(9); else PG8_WAIT_V(8);
            PG8_WAIT_L(0); PG8_BAR; PG8_MMA(1, 0, At, B0); PG8_MMA(1, 1, At, B1); PG8_BAR; PG8_SCHED;
            } else {
            PG8_LDB(B0, 0, 0); PG8_SCHED; PG8_LDA(At, 0, 0); PG8_STAGE(PG8_SA(1, 1), a1 + hstep, voffA);
            PG8_WAIT_L(8); PG8_BAR; PG8_WAIT_L(0); PG8_MMA(0, 0, At, B0); PG8_BAR; PG8_SCHED;
            PG8_LDB(B1, 0, 1); PG8_STAGE(PG8_SB(0, 0), b2, voffB);
            PG8_BAR; PG8_WAIT_L(0); PG8_MMA(0, 1, At, B1); PG8_BAR;
            PG8_LDA(At, 0, 1); PG8_STAGE(PG8_SA(0, 0), a2, voffA);
            PG8_BAR; PG8_WAIT_L(0); PG8_MMA(1, 0, At, B0); PG8_BAR; PG8_SCHED;
            PG8_STAGE(PG8_SB(0, 1), b2 + hstep, voffB);
            PG8_WAIT_V(6); PG8_BAR; PG8_MMA(1, 1, At, B1); PG8_BAR;
            PG8_LDB(B0, 1, 0); PG8_SCHED; PG8_LDA(At, 1, 0); PG8_STAGE(PG8_SA(0, 1), a2 + hstep, voffA);
            PG8_WAIT_L(8); PG8_BAR; PG8_WAIT_L(0); PG8_MMA(0, 0, At, B0); PG8_BAR; PG8_SCHED;
            PG8_LDB(B1, 1, 1); PG8_STAGE(PG8_SB(1, 0), b3, voffB);
            PG8_BAR; PG8_WAIT_L(0); PG8_MMA(0, 1, At, B1); PG8_BAR;
            PG8_LDA(At, 1, 1); PG8_STAGE(PG8_SA(1, 0), a3, voffA);
            PG8_BAR; PG8_WAIT_L(0); PG8_MMA(1, 0, At, B0); PG8_BAR; PG8_SCHED;
            PG8_STAGE(PG8_SB(1, 1), b3 + hstep, voffB);
            PG8_WAIT_V(6); PG8_BAR; PG8_MMA(1, 1, At, B1); PG8_BAR;
            }
        }
        if constexpr (ALIGN_EPI) { if (wr == 0) PG8_BAR; }
        if constexpr (!Epi::AFTER_DRAIN) { E(acc, cur, wr, wc, fr, fq, est, has_next, nxt); S.done(cur); }
        if (!has_next) break;
#pragma unroll
        for (int a = 0; a < 2; ++a)
#pragma unroll
            for (int b = 0; b < 2; ++b)
#pragma unroll
                for (int m = 0; m < 4; ++m)
#pragma unroll
                    for (int n = 0; n < 2; ++n) acc[a][b][m][n] = (f32x4){0.f, 0.f, 0.f, 0.f};
        cur = nxt; cA = nA; cB = nB; ++ui;
        E.acc_init(acc, cur, wr, wc, fr, fq);
        if constexpr (ALIGN_EPI) { if (wr == 1) PG8_BAR; }
    }
    PG8_WAIT_V(0);
    if constexpr (!ALIGN_EPI) { if (wr == 0) PG8_BAR; }
    PG8_BAR;
    if constexpr (Epi::AFTER_DRAIN) { if constexpr (Epi::XROWS) E.fused_x(acc, xacc, cur, lds, wid); else E.fused(acc, cur, wr, wc, fr, fq, lds, wid, lane); S.done(cur); }
#undef PG8_XSTAGE
#undef PG8_XLD
#undef PG8_XMMA
#undef PG8_SA
#undef PG8_SB
#undef PG8_STAGE
#undef PG8_LDA
#undef PG8_LDB
#undef PG8_MMA
#undef PG8_WAIT_V
#undef PG8_WAIT_L
#undef PG8_BAR
#undef PG8_SCHED
}
}

#ifndef PROBE_TS
#define PROBE_TS 0
#endif
#ifndef PROBE_PH
#define PROBE_PH 0
#endif
constexpr int NWAVES = 8;
constexpr int DM = 1024, SEQ = 8192, NBATCH = 2, DBATCH = 128, DT = 4, MP = NBATCH * SEQ, MS = DBATCH * DT, M = MP + MS;
constexpr int NIN = 2304, DFF = 2816, NGU = 2 * DFF, WIN = 128, NLAYER = 2;
constexpr int ZP = 1792;
constexpr int ZQ = 0, ZK = 512, ZV = 640, ZGB = 768, ZCU = 1280;
constexpr float ATT_SCALE = 0.125f, EPS = 1e-6f;
constexpr size_t OUT_Y = 0, OUT_NKP = (size_t)M * DM, OUT_NVP = OUT_NKP + (size_t)NLAYER * NBATCH * WIN * 128, OUT_NCP = OUT_NVP + (size_t)NLAYER * NBATCH * WIN * 128,
                 OUT_NKS = OUT_NCP + (size_t)NLAYER * NBATCH * 2 * 512, OUT_NVS = OUT_NKS + (size_t)NLAYER * DBATCH * WIN * 128, OUT_NCS = OUT_NVS + (size_t)NLAYER * DBATCH * WIN * 128,
                 OUT_END = OUT_NCS + (size_t)NLAYER * DBATCH * 2 * 512;
static_assert(OUT_END == 26087424, "output size");
constexpr size_t MiB = 1u << 20;
constexpr size_t WS_CTL = 0, CTL_ZERO_BYTES = 32 * 1024;
constexpr size_t WS_WIN = 2 * MiB, WS_WOUT = 11 * MiB, WS_WGU = 15 * MiB, WS_WDN = 37 * MiB;
constexpr size_t WS_SSQA = 48 * MiB, WS_SSQD = 50 * MiB;
constexpr size_t WS_SSQS = WS_SSQD + 3 * MiB / 2;
static_assert(WS_SSQD + (size_t)M * 64 <= WS_SSQS && WS_SSQS + 4096 <= 52 * MiB, "ws ssqs");
constexpr size_t WS_XB = 52 * MiB;
constexpr size_t WS_Z = 86 * MiB;
constexpr size_t WS_MB = 161 * MiB;
constexpr size_t WS_HB = 86 * MiB;
constexpr size_t WS_END = 194 * MiB;
static_assert(WS_WIN + (size_t)NLAYER * NIN * DM * 2 <= WS_WOUT && WS_WOUT + (size_t)NLAYER * DM * DM * 2 <= WS_WGU && WS_WGU + (size_t)NLAYER * NGU * DM * 2 <= WS_WDN && WS_WDN + (size_t)NLAYER * DM * DFF * 2 <= WS_SSQA, "ws weights");
static_assert(WS_SSQA + (size_t)M * 64 <= WS_SSQD && WS_SSQD + (size_t)M * 64 <= WS_XB && WS_XB + (size_t)M * DM * 2 <= WS_Z && WS_Z + (size_t)M * ZP * 2 <= WS_MB && WS_MB + (size_t)M * DM * 2 <= WS_END && WS_HB + (size_t)M * DFF * 2 <= WS_END, "ws activations");
constexpr int CW_TMO = 0, CW_CODE = 1, CW_FIN = 1024  , CW_BC = 1088  , CW_BAR = 4096;
static_assert((CW_BAR + 3456) * 4 <= (int)CTL_ZERO_BYTES, "barrier words inside the zeroed region");
constexpr int RING_OFF = 0, RING_BYTES = 131072;
constexpr int LDS_BYTES = 163840;
constexpr int LDSCTL_BYTES = 512, LDSCTL_OFF = LDS_BYTES - LDSCTL_BYTES, MISC_OFF = LDSCTL_OFF + 320;
static_assert(MISC_OFF + 128 <= LDS_BYTES, "LDS map");
#define GAS __attribute__((address_space(1)))
#define LAS __attribute__((address_space(3)))
typedef unsigned short bf16;
typedef unsigned v4u __attribute__((ext_vector_type(4)));
typedef float f32x4 __attribute__((ext_vector_type(4)));
typedef short bf16x8 __attribute__((ext_vector_type(8)));
typedef GAS unsigned gu32;
typedef GAS unsigned long long gu64;
#define RLX_AGENT __ATOMIC_RELAXED, __HIP_MEMORY_SCOPE_AGENT
#define LDS_WAIT() asm volatile("s_waitcnt lgkmcnt(0)" ::: "memory")
#define VM_WAIT() asm volatile("s_waitcnt vmcnt(0)" ::: "memory")
__device__ __forceinline__ unsigned long long rt() { return __builtin_amdgcn_s_memrealtime(); }
__device__ __forceinline__ unsigned f2bf(float f) { unsigned u = __builtin_bit_cast(unsigned, f); return (u + 0x7fffu + ((u >> 16) & 1u)) >> 16; }
__device__ __forceinline__ unsigned pk2(float lo, float hi) { return f2bf(lo) | (f2bf(hi) << 16); }

#define XB_TMO      128
#define XB_XCNT(j)  (256  + 64 * (j))
#define XB_XSUB(j)  (1280 + 64 * (j))
#define XB_XGEN(j)  (2304 + 64 * (j))
#define XB_TOP      3328
#define XB_TOPGEN   3392
#define XCD_BAR_WORDS 3456
#define XB_SPIN_CAP (1u << 18)
#ifndef XB_POLL_TOP
#define XB_POLL_TOP 1
#endif
#ifndef XB_FLAT_REL
#define XB_FLAT_REL 0
#endif

__device__ __forceinline__ unsigned xb_ld(unsigned* p)              { return __hip_atomic_load(p, __ATOMIC_RELAXED, __HIP_MEMORY_SCOPE_AGENT); }
__device__ __forceinline__ unsigned xb_add(unsigned* p, unsigned v) { return __hip_atomic_fetch_add(p, v, __ATOMIC_RELAXED, __HIP_MEMORY_SCOPE_AGENT); }
__device__ __forceinline__ unsigned xb_xcc_id() { return (unsigned)__builtin_amdgcn_s_getreg((3 << 11) | 20) & 0xFu; }
#define XB_SPIN(cond, bar) do { unsigned _sp = 0; while (cond) { __builtin_amdgcn_s_sleep(1); \
    if ((++_sp & 255u) == 0u) { if (xb_ld(&(bar)[XB_TMO])) break; if (_sp > XB_SPIN_CAP) { atomicAdd(&(bar)[XB_TMO], 1u); break; } } } } while (0)

struct XcdBarrier {
    unsigned* bar; unsigned x; int wave;
    volatile LAS unsigned* st;
};

__device__ __forceinline__ XcdBarrier xcd_barrier_post(unsigned* bar, volatile LAS unsigned* st, int wave) {
    XcdBarrier b; b.bar = bar; b.x = xb_xcc_id(); b.st = st; b.wave = wave;
    if (threadIdx.x == 0) (void)xb_add(&bar[XB_XCNT(b.x)], 1u);
    return b;
}
__device__ __forceinline__ void xcd_barrier_complete(unsigned* bar, unsigned x, unsigned& nloc, unsigned& nx) {
    const unsigned G = gridDim.x * gridDim.y * gridDim.z;
    unsigned sum, cnt, mine, sp = 0u;
    for (;;) {
        sum = 0u; cnt = 0u; mine = 0u;
#pragma unroll
        for (unsigned j = 0; j < 16; ++j) { const unsigned c = xb_ld(&bar[XB_XCNT(j)]); sum += c; cnt += (c > 0u) ? 1u : 0u; mine = (j == x) ? c : mine; }
        if (sum == G) break;
        __builtin_amdgcn_s_sleep(1);
        if ((++sp & 255u) == 0u) { if (xb_ld(&bar[XB_TMO])) break; if (sp > XB_SPIN_CAP) { atomicAdd(&bar[XB_TMO], 1u); break; } }
    }
    nloc = mine > 0u ? mine : 1u; nx = cnt > 0u ? cnt : 1u;
}

__device__ __forceinline__ void xcd_barrier_enter() {
    asm volatile("s_waitcnt vmcnt(0)" ::: "memory");
    __syncthreads();
}
template <bool REL = true> __device__ __forceinline__ void xcd_barrier_rest(const XcdBarrier& b) {
    unsigned ln_; asm volatile("v_mbcnt_lo_u32_b32 %0, -1, 0\n\tv_mbcnt_hi_u32_b32 %0, -1, %0" : "=v"(ln_));
    if (b.wave == 0 && ln_ == 0u) {
        unsigned* bar = b.bar;
        __builtin_amdgcn_s_waitcnt(0);
        asm volatile("buffer_inv sc1" ::: "memory");
        unsigned nloc = b.st[0], nx = b.st[1];
        if (nloc == 0u) { xcd_barrier_complete(bar, b.x, nloc, nx); b.st[0] = nloc; b.st[1] = nx; }
        const unsigned old = xb_add(&bar[XB_XSUB(b.x)], 1u);
        const unsigned gen = old / nloc;
        if (old + 1u == (gen + 1u) * nloc) {
            if (REL) __builtin_amdgcn_fence(__ATOMIC_RELEASE, "agent");
            asm volatile("s_waitcnt vmcnt(0)" ::: "memory");
            const unsigned og = xb_add(&bar[XB_TOP], 1u);
            const unsigned tg = og / nx;
#if XB_POLL_TOP
            const unsigned tgt = (tg + 1u) * nx;
            if (og + 1u != tgt) XB_SPIN((int)(xb_ld(&bar[XB_TOP]) - tgt) < 0, bar);
#else
            if (og + 1u == (tg + 1u) * nx) xb_add(&bar[XB_TOPGEN], 1u);
            else XB_SPIN(xb_ld(&bar[XB_TOPGEN]) == tg, bar);
#endif
            asm volatile("" ::: "memory");
#if !XB_FLAT_REL
            xb_add(&bar[XB_XGEN(b.x)], 1u);
#endif
            asm volatile("s_waitcnt vmcnt(0)" ::: "memory");
        } else {
#if XB_FLAT_REL
            { const unsigned tgt = (gen + 1u) * nx; XB_SPIN((int)(xb_ld(&bar[XB_TOP]) - tgt) < 0, bar); }
#else
            XB_SPIN(xb_ld(&bar[XB_XGEN(b.x)]) == gen, bar);
#endif
            asm volatile("" ::: "memory");
            asm volatile("s_waitcnt vmcnt(0)" ::: "memory");
        }
    }
    __syncthreads();
}
template <bool REL = true> __device__ __forceinline__ void xcd_barrier(const XcdBarrier& b) { xcd_barrier_enter(); xcd_barrier_rest<REL>(b); }

struct Frame {
    LAS unsigned char* lds;
    volatile LAS unsigned* MISC;
    gu32* ctl;
    int tid, lane, wave;
    int vcu, G;
};
constexpr unsigned char BUCKET_C[128] = {0, 1, 2, 3, 4, 5, 6, 7, 8, 9, 10, 11, 12, 13, 14, 15, 16, 16, 16, 17, 17, 18, 18, 18, 19, 19, 19, 20, 20, 20, 20, 21, 21, 21, 21, 22, 22, 22, 22, 22, 23, 23, 23, 23, 23, 23, 24, 24, 24, 24, 24, 24, 25, 25, 25, 25, 25, 25, 25, 26, 26, 26, 26, 26, 26, 26, 26, 27, 27, 27, 27, 27, 27, 27, 27, 27, 27, 28, 28, 28, 28, 28, 28, 28, 28, 28, 28, 29, 29, 29, 29, 29, 29, 29, 29, 29, 29, 29, 29, 30, 30, 30, 30, 30, 30, 30, 30, 30, 30, 30, 30, 30, 30, 31, 31, 31, 31, 31, 31, 31, 31, 31, 31, 31, 31, 31, 31, 31};
__host__ __device__ constexpr int bucket_of(int d) { return d < 16 ? d : 16 + (d >= 19) + (d >= 21) + (d >= 24) + (d >= 27) + (d >= 31) + (d >= 35) + (d >= 40) + (d >= 46) + (d >= 52) + (d >= 59) + (d >= 67) + (d >= 77) + (d >= 87) + (d >= 99) + (d >= 113); }
constexpr bool bucket_ok() { for (int d = 0; d < 128; ++d) if (bucket_of(d) != BUCKET_C[d]) return false; return true; }
static_assert(bucket_ok(), "bucket_of");

__device__ __forceinline__ int hw_lane() { int l; asm volatile("v_mbcnt_lo_u32_b32 %0, -1, 0\n\tv_mbcnt_hi_u32_b32 %0, -1, %0" : "=v"(l)); return l; }
__device__ __forceinline__ float wave_sum(float v) {
#pragma unroll
    for (int o = 1; o < 64; o <<= 1) v += __shfl_xor(v, o);
    return v;
}
__device__ __forceinline__ float wave_max(float v) {
#pragma unroll
    for (int o = 1; o < 64; o <<= 1) v = fmaxf(v, __shfl_xor(v, o));
    return v;
}
__device__ __forceinline__ float bf2f(bf16 u) { return __uint_as_float((unsigned)u << 16); }
__device__ __forceinline__ float bflo(unsigned w) { return __uint_as_float(w << 16); }
__device__ __forceinline__ float bfhi(unsigned w) { return __uint_as_float(w & 0xffff0000u); }

__device__ __forceinline__ void st16_wt(void* p, v4u v) { asm volatile("global_store_dwordx4 %0, %1, off sc1\n\ts_nop 1" :: "v"(p), "v"(v) : "memory"); }
__device__ __forceinline__ void st8_wt(void* p, unsigned long long v) { asm volatile("global_store_dwordx2 %0, %1, off sc1\n\ts_nop 1" :: "v"(p), "v"(v) : "memory"); }
struct Args { const float* in[17]; float* out; unsigned char* ws; };
typedef const __attribute__((address_space(4))) Args* KArgs;
enum { I_XP = 0, I_XS = 1, I_CK = 2, I_CV = 3, I_ST = 4, I_RB = 5, I_AN = 6, I_WIN = 7, I_SK = 8, I_CW = 9, I_MN = 10, I_WOUT = 11, I_FN = 12, I_WG = 13, I_WU = 14, I_WD = 15, I_FIN = 16 };
#define WSP(T, off) ((T*)(args->ws + (off)))
__device__ __forceinline__ void cvt_item(const float* W, const float* gain, int K, int N, bf16* WT, int kb, int n0, int dst_row0, int lane) {
    const int k0 = 32 * kb; const float* wp = W + (size_t)k0 * N + n0 + lane;
    float v[32];
#pragma unroll
    for (int j = 0; j < 32; ++j) v[j] = __builtin_nontemporal_load(wp + (size_t)j * N);
    if (gain) {
#pragma unroll
        for (int j = 0; j < 32; ++j) v[j] *= gain[k0 + j]; }
    bf16* op = WT + (size_t)(dst_row0 + lane) * K + k0;
#pragma unroll
    for (int c = 0; c < 4; ++c) { v4u o; o.x = pk2(v[8 * c], v[8 * c + 1]); o.y = pk2(v[8 * c + 2], v[8 * c + 3]); o.z = pk2(v[8 * c + 4], v[8 * c + 5]); o.w = pk2(v[8 * c + 6], v[8 * c + 7]); *(GAS v4u*)(op + 8 * c) = o; }
}
constexpr int CI_IN = 0, CI_OUT = 1152, CI_G = 1664, CI_U = 3072, CI_D = 4480, CI_END = 5888;
__device__ __forceinline__ void cvt_layer_item(KArgs args, int l, int r, int lane) {
    if (r < CI_OUT) { const int nb = r % (NIN / 64), kb = r / (NIN / 64), n0 = 64 * nb;
        const int d0 = n0 < 1280 ? n0 : (n0 < 1792 ? 1280 + ((n0 - 1280) / 128) * 256 + (n0 - 1280) % 128 : 1280 + ((n0 - 1792) / 128) * 256 + 128 + (n0 - 1792) % 128);
        cvt_item(args->in[I_WIN] + (size_t)l * DM * NIN, args->in[I_AN] + l * DM, DM, NIN, WSP(bf16, WS_WIN) + (size_t)l * NIN * DM, kb, n0, d0, lane); return; }
    if (r < CI_G) { r -= CI_OUT; const int nb = r % (DM / 64), kb = r / (DM / 64); cvt_item(args->in[I_WOUT] + (size_t)l * DM * DM, args->in[I_MN] + l * DM, DM, DM, WSP(bf16, WS_WOUT) + (size_t)l * DM * DM, kb, 64 * nb, 64 * nb, lane); return; }
    if (r < CI_D) { r -= CI_G; const int up = r >= (CI_U - CI_G); if (up) r -= (CI_U - CI_G); const int nb = r % (DFF / 64), kb = r / (DFF / 64), n0 = 64 * nb;
        cvt_item((up ? args->in[I_WU] : args->in[I_WG]) + (size_t)l * DM * DFF, args->in[I_FN] + l * DM, DM, DFF, WSP(bf16, WS_WGU) + (size_t)l * NGU * DM, kb, n0, (n0 / 128) * 256 + (n0 % 128) + (up ? 128 : 0), lane); return; }
    { r -= CI_D; const int nb = r % (DM / 64), kb = r / (DM / 64); cvt_item(args->in[I_WD] + (size_t)l * DFF * DM, nullptr, DFF, DM, WSP(bf16, WS_WDN) + (size_t)l * DM * DFF, kb, 64 * nb, 64 * nb, lane); }
}
struct CvtDesc { const float* W; const float* gain; int K, N; bf16* WT; int kb, n0, d0; };
__device__ __forceinline__ CvtDesc cvt_desc(KArgs args, int l, int r) {
    if (r < CI_OUT) { const int nb = r % (NIN / 64), kb = r / (NIN / 64), n0 = 64 * nb;
        const int d0 = n0 < 1280 ? n0 : (n0 < 1792 ? 1280 + ((n0 - 1280) / 128) * 256 + (n0 - 1280) % 128 : 1280 + ((n0 - 1792) / 128) * 256 + 128 + (n0 - 1792) % 128);
        return CvtDesc{args->in[I_WIN] + (size_t)l * DM * NIN, args->in[I_AN] + l * DM, DM, NIN, WSP(bf16, WS_WIN) + (size_t)l * NIN * DM, kb, n0, d0}; }
    { r -= CI_OUT; const int nb = r % (DM / 64), kb = r / (DM / 64); return CvtDesc{args->in[I_WOUT] + (size_t)l * DM * DM, args->in[I_MN] + l * DM, DM, DM, WSP(bf16, WS_WOUT) + (size_t)l * DM * DM, kb, 64 * nb, 64 * nb}; }
}
__device__ __forceinline__ void cvt_load(const CvtDesc& d, int lane, float (&v)[32]) {
    const float* wp = d.W + (size_t)(32 * d.kb) * d.N + d.n0 + lane;
#pragma unroll
    for (int j = 0; j < 32; ++j) v[j] = __builtin_nontemporal_load(wp + (size_t)j * d.N);
}
__device__ __forceinline__ void cvt_store(const CvtDesc& d, int lane, float (&v)[32]) {
    const int k0 = 32 * d.kb;
#pragma unroll
    for (int j = 0; j < 32; ++j) v[j] *= d.gain[k0 + j];
    bf16* op = d.WT + (size_t)(d.d0 + lane) * d.K + k0;
#pragma unroll
    for (int c = 0; c < 4; ++c) { v4u o; o.x = pk2(v[8 * c], v[8 * c + 1]); o.y = pk2(v[8 * c + 2], v[8 * c + 3]); o.z = pk2(v[8 * c + 4], v[8 * c + 5]); o.w = pk2(v[8 * c + 6], v[8 * c + 7]); *(GAS v4u*)(op + 8 * c) = o; }
}
__device__ __forceinline__ void cvt_range(KArgs args, int l, int lo, int hi, int worker, int nworkers, int lane) {
    for (int r = lo + worker; r < hi; r += nworkers) cvt_layer_item(args, l, r, lane);
}
__device__ __forceinline__ void p0_prologue(const Frame& F0, KArgs args) {
    Frame F = F0; F.lane = hw_lane(); F.tid = F.wave * 64 + F.lane; asm volatile("" : "+v"(F.tid), "+v"(F.lane));
    const int gw = F.vcu * NWAVES + F.wave, NGW = F.G * NWAVES;
    const int ir = F.wave * F.G + F.vcu;
    const bool has_item = ir < CI_G; float wv[32]; CvtDesc wd = cvt_desc(args, 0, has_item ? ir : 0);
    cvt_load(wd, F.lane, wv);
    bf16* XB = WSP(bf16, WS_XB); float* SSQA = WSP(float, WS_SSQA);
    const bool local = (F.G == 256);
    const int nrow = local ? (F.wave < 2 ? 10 : 8) : 2 * ((M - gw + 2 * NGW - 1) / (2 * NGW));
    auto prow = [&](int k) -> int { if (local) return k < 8 ? (F.vcu >> 5) * 2048 + (F.vcu & 31) * 64 + F.wave * 8 + k : ((k == 8 && F.wave < 2) ? MP + (F.vcu >> 5) * 64 + (F.vcu & 31) * 2 + F.wave : -1);
                                    const int m = gw + k * NGW; return m < M ? m : -1; };
    f32x4 v[2][4], vn[2][4];
#pragma unroll
    for (int r = 0; r < 2; ++r) { const int m = prow(r); const int mm = m >= 0 ? m : 0;
        const float* xrow = mm < MP ? args->in[I_XP] + (size_t)mm * DM : args->in[I_XS] + (size_t)(mm - MP) * DM;
#pragma unroll
        for (int j = 0; j < 2; ++j) { v[r][2 * j] = __builtin_nontemporal_load((const f32x4*)(xrow + 512 * j + 8 * F.lane)); v[r][2 * j + 1] = __builtin_nontemporal_load((const f32x4*)(xrow + 512 * j + 8 * F.lane + 4)); } }
    for (int k0 = 0; k0 < nrow; k0 += 2) {
        float s[2];
#pragma unroll
        for (int r = 0; r < 2; ++r) { const int m = (k0 + 2 + r < nrow) ? prow(k0 + 2 + r) : -1; const int mm = m >= 0 ? m : 0;
            const float* xrow = mm < MP ? args->in[I_XP] + (size_t)mm * DM : args->in[I_XS] + (size_t)(mm - MP) * DM;
#pragma unroll
            for (int j = 0; j < 2; ++j) { vn[r][2 * j] = __builtin_nontemporal_load((const f32x4*)(xrow + 512 * j + 8 * F.lane)); vn[r][2 * j + 1] = __builtin_nontemporal_load((const f32x4*)(xrow + 512 * j + 8 * F.lane + 4)); } }
#pragma unroll
        for (int r = 0; r < 2; ++r) { s[r] = 0.f;
#pragma unroll
            for (int j = 0; j < 4; ++j) s[r] += (v[r][j].x * v[r][j].x + v[r][j].y * v[r][j].y) + (v[r][j].z * v[r][j].z + v[r][j].w * v[r][j].w); }
#pragma unroll
        for (int o = 1; o < 64; o <<= 1) { s[0] += __shfl_xor(s[0], o); s[1] += __shfl_xor(s[1], o); }
#pragma unroll
        for (int r = 0; r < 2; ++r) { const int m = prow(k0 + r); if (m >= 0) {
#pragma unroll
            for (int j = 0; j < 2; ++j) { v4u w; w.x = pk2(v[r][2 * j].x, v[r][2 * j].y); w.y = pk2(v[r][2 * j].z, v[r][2 * j].w); w.z = pk2(v[r][2 * j + 1].x, v[r][2 * j + 1].y); w.w = pk2(v[r][2 * j + 1].z, v[r][2 * j + 1].w);
                st16_wt(XB + (size_t)m * DM + 512 * j + 8 * F.lane, w); }
            if (F.lane == 0) SSQA[m] = s[r]; } }
#pragma unroll
        for (int r = 0; r < 2; ++r)
#pragma unroll
            for (int j = 0; j < 4; ++j) v[r][j] = vn[r][j];
    }
    if (has_item) cvt_store(wd, F.lane, wv);
    cvt_range(args, 0, CI_IN + NGW, CI_G, ir, NGW, F.lane);
}

typedef float f32x16 __attribute__((ext_vector_type(16)));
typedef short s16x4 __attribute__((ext_vector_type(4)));
constexpr int ARS = 144;
constexpr int AKR = 192;
constexpr int LB_K = 0, LB_V = 2 * AKR * ARS, LB_TAB = 2 * LB_V, LB_SSQ = LB_TAB + 9 * 192 * 4, LB_END = LB_SSQ + 2048;
constexpr int LB_ST0 = LB_END;
constexpr int OST0 = 144;
static_assert(LB_ST0 + 8 * 32 * OST0 <= LDSCTL_OFF, "mixer LDS");
constexpr float LOG2E = 1.4426950408889634f;
__device__ __forceinline__ s16x4 vtr(const LAS unsigned char* p) { return __builtin_bit_cast(s16x4, __builtin_amdgcn_ds_read_tr16_b64_v4i16((LAS s16x4*)p)); }
struct Store4 { bf16* p; size_t step; v4u w0, w1, w2, w3; };
template <bool ST4 = false> __device__ __forceinline__ void attn_qtile(const bf16x8 (&qf)[4], const LAS unsigned char* kimg, const LAS unsigned char* vimg, int tile0, const LAS float* tab_lane, const LAS float* neg_lane, float sink2, unsigned tilemask, int lane, f32x16 (&o)[2], const Store4 st4 = Store4{}) {
    const int q = lane & 31, hi = lane >> 5;
    f32x16 S[5];
    const LAS unsigned char* kb = kimg + (tile0 * 32 + q) * ARS + hi * 16;
#pragma unroll
    for (int jj = 0; jj < 5; ++jj) {
        f32x16 acc = {};
#pragma unroll
        for (int ds = 0; ds < 4; ++ds) { const bf16x8 kf = *(const LAS bf16x8*)(kb + jj * 32 * ARS + ds * 32); acc = __builtin_amdgcn_mfma_f32_32x32x16_bf16(kf, qf[ds], acc, 0, 0, 0); }
        S[jj] = acc;
    }
    if constexpr (ST4) { st16_wt(st4.p, st4.w0); st16_wt(st4.p + st4.step, st4.w1); st16_wt(st4.p + 2 * st4.step, st4.w2); st16_wt(st4.p + 3 * st4.step, st4.w3); }
    const float c2 = 0.125f * LOG2E;
    float mx = sink2;
#pragma unroll
    for (int jj = 0; jj < 5; ++jj) { const LAS float* tp = ((tilemask >> jj) & 1u) ? neg_lane : tab_lane;
#pragma unroll
        for (int g = 0; g < 4; ++g) { const int i0 = 159 - 32 * jj - 8 * g; const f32x4 bv = {tp[i0], tp[i0 - 1], tp[i0 - 2], tp[i0 - 3]};
            const f32x4 s = (f32x4){S[jj][4 * g], S[jj][4 * g + 1], S[jj][4 * g + 2], S[jj][4 * g + 3]} * c2 + bv;
            S[jj][4 * g] = s[0]; S[jj][4 * g + 1] = s[1]; S[jj][4 * g + 2] = s[2]; S[jj][4 * g + 3] = s[3];
            mx = fmaxf(fmaxf(mx, s[0]), s[1]); mx = fmaxf(fmaxf(mx, s[2]), s[3]); } }
    mx = fmaxf(mx, __shfl_xor(mx, 32));
    f32x4 ls4 = {}; f32x4 nmx = {-mx, -mx, -mx, -mx}; asm volatile("" : "+v"(nmx));
#pragma unroll
    for (int jj = 0; jj < 5; ++jj)
#pragma unroll
        for (int g = 0; g < 4; ++g) { const f32x4 d = (f32x4){S[jj][4 * g], S[jj][4 * g + 1], S[jj][4 * g + 2], S[jj][4 * g + 3]} + nmx; f32x4 p;
#pragma unroll
            for (int i = 0; i < 4; ++i) p[i] = __builtin_amdgcn_exp2f(d[i]);
            ls4 += p; S[jj][4 * g] = p[0]; S[jj][4 * g + 1] = p[1]; S[jj][4 * g + 2] = p[2]; S[jj][4 * g + 3] = p[3]; }
    float lsum = (ls4[0] + ls4[1]) + (ls4[2] + ls4[3]);
    lsum += __shfl_xor(lsum, 32); lsum += __builtin_amdgcn_exp2f(sink2 - mx);
    bf16x8 pf[5][2];
#pragma unroll
    for (int jj = 0; jj < 5; ++jj)
#pragma unroll
        for (int s = 0; s < 2; ++s) { v4u w; w.x = pg8::cvt_pk_bf16(S[jj][8 * s + 0], S[jj][8 * s + 1]); w.y = pg8::cvt_pk_bf16(S[jj][8 * s + 2], S[jj][8 * s + 3]); w.z = pg8::cvt_pk_bf16(S[jj][8 * s + 4], S[jj][8 * s + 5]); w.w = pg8::cvt_pk_bf16(S[jj][8 * s + 6], S[jj][8 * s + 7]);
            pf[jj][s] = __builtin_bit_cast(bf16x8, w); }
    const LAS unsigned char* vb = vimg + (tile0 * 32 + 4 * hi + ((lane & 15) >> 2)) * ARS + (16 * ((lane >> 4) & 1) + 4 * (lane & 3)) * 2;
    const float rl = 1.0f / lsum;
#pragma unroll
    for (int db = 0; db < 2; ++db) {
        f32x16 acc = {};
#pragma unroll
        for (int jj = 0; jj < 5; ++jj)
#pragma unroll
            for (int s = 0; s < 2; ++s) { const LAS unsigned char* a = vb + (jj * 32 + 16 * s) * ARS + db * 64;
                const s16x4 lo = vtr(a), hh = vtr(a + 8 * ARS);
                const bf16x8 vf = {lo[0], lo[1], lo[2], lo[3], hh[0], hh[1], hh[2], hh[3]};
                acc = __builtin_amdgcn_mfma_f32_32x32x16_bf16(vf, pf[jj][s], acc, 0, 0, 0); }
        o[db] = acc * rl;
    }
}
__device__ __forceinline__ void load_qf(const bf16* qptr, bf16x8 (&qf)[4]) {
#pragma unroll
    for (int ds = 0; ds < 4; ++ds) qf[ds] = *(const bf16x8*)(qptr + 16 * ds);
}
__device__ __forceinline__ float sumsq32(const f32x16 (&o)[2]) { float s = 0.f;
#pragma unroll
    for (int db = 0; db < 2; ++db)
#pragma unroll
        for (int r = 0; r < 16; ++r) s += o[db][r] * o[db][r];
    return s; }
__device__ __forceinline__ void store_o(bf16* mrow_head, const f32x16 (&o)[2], float ra, int hi) {
#pragma unroll
    for (int db = 0; db < 2; ++db)
#pragma unroll
        for (int g = 0; g < 4; ++g) { const unsigned w0 = pg8::cvt_pk_bf16(o[db][4 * g] * ra, o[db][4 * g + 1] * ra), w1 = pg8::cvt_pk_bf16(o[db][4 * g + 2] * ra, o[db][4 * g + 3] * ra);
            st8_wt(mrow_head + 32 * db + 8 * g + 4 * hi, (unsigned long long)w0 | ((unsigned long long)w1 << 32)); }
}
__device__ __forceinline__ void unpack8(const v4u w, float (&f)[8]) { f[0] = bflo(w.x); f[1] = bfhi(w.x); f[2] = bflo(w.y); f[3] = bfhi(w.y); f[4] = bflo(w.z); f[5] = bfhi(w.z); f[6] = bflo(w.w); f[7] = bfhi(w.w); }
__device__ __forceinline__ void cu8(const bf16* Z, size_t row, int lane, float (&c)[8]) { unpack8(*(const v4u*)(Z + row * ZP + ZCU + 8 * lane), c); }
__device__ __forceinline__ void conv_row_out(const bf16* Z, bf16* MB, size_t row, int lane, const float (&cw)[3][8], const float (&c2)[8], const float (&c1)[8], const float (&c0)[8]) {
    float gb[8]; unpack8(*(const v4u*)(Z + row * ZP + ZGB + 8 * lane), gb);
    float v[8]; float ss = 0.f;
#pragma unroll
    for (int i = 0; i < 8; ++i) { v[i] = gb[i] * (cw[0][i] * c2[i] + cw[1][i] * c1[i] + cw[2][i] * c0[i]); ss += v[i] * v[i]; }
    const float rc = rsqrtf(wave_sum(ss) * (1.f / 512.f) + EPS);
    v4u w; w.x = pg8::cvt_pk_bf16(v[0] * rc, v[1] * rc); w.y = pg8::cvt_pk_bf16(v[2] * rc, v[3] * rc); w.z = pg8::cvt_pk_bf16(v[4] * rc, v[5] * rc); w.w = pg8::cvt_pk_bf16(v[6] * rc, v[7] * rc);
    *(v4u*)(MB + row * DM + 512 + 8 * lane) = w;
}
__device__ __forceinline__ void load_cw(const float* cwp, int lane, float (&cw)[3][8]) {
#pragma unroll
    for (int k = 0; k < 3; ++k) { const f32x4 a = *(const f32x4*)(cwp + k * 512 + 8 * lane), b = *(const f32x4*)(cwp + k * 512 + 8 * lane + 4);
        cw[k][0] = a[0]; cw[k][1] = a[1]; cw[k][2] = a[2]; cw[k][3] = a[3]; cw[k][4] = b[0]; cw[k][5] = b[1]; cw[k][6] = b[2]; cw[k][7] = b[3]; }
}
template <int NR> struct ConvIn { v4u cuw[NR + 2], gbw[NR]; };
template <int NR>
__device__ __forceinline__ void conv_load(const bf16* Z, size_t r0, long t0, int lane, ConvIn<NR>& in) {
#pragma unroll
    for (int j = 0; j < NR + 2; ++j) { const size_t rr = (t0 - 2 + j >= 0) ? r0 - 2 + j : r0; in.cuw[j] = *(const v4u*)(Z + rr * ZP + ZCU + 8 * lane); }
#pragma unroll
    for (int k = 0; k < NR; ++k) in.gbw[k] = *(const v4u*)(Z + (r0 + k) * ZP + ZGB + 8 * lane);
}
template <int NR>
__device__ __forceinline__ void conv_compute(const ConvIn<NR>& in, const float (&cw)[3][8], long t0, v4u (&w)[NR]) {
    float ss[NR]; float v[NR][8];
#pragma unroll
    for (int k = 0; k < NR; ++k) {
        float c2[8], c1[8], c0[8], gb[8]; unpack8(in.cuw[k], c2); unpack8(in.cuw[k + 1], c1); unpack8(in.cuw[k + 2], c0); unpack8(in.gbw[k], gb);
        const float k2 = (t0 - 2 + k >= 0) ? 1.f : 0.f, k1 = (t0 - 1 + k >= 0) ? 1.f : 0.f;
        ss[k] = 0.f;
#pragma unroll
        for (int i = 0; i < 8; ++i) { v[k][i] = gb[i] * (cw[0][i] * (c2[i] * k2) + cw[1][i] * (c1[i] * k1) + cw[2][i] * c0[i]); ss[k] += v[k][i] * v[k][i]; } }
#pragma unroll
    for (int o = 1; o < 64; o <<= 1)
#pragma unroll
        for (int k = 0; k < NR; ++k) ss[k] += __shfl_xor(ss[k], o);
#pragma unroll
    for (int k = 0; k < NR; ++k) { const float rc = rsqrtf(ss[k] * (1.f / 512.f) + EPS);
        w[k].x = pg8::cvt_pk_bf16(v[k][0] * rc, v[k][1] * rc); w[k].y = pg8::cvt_pk_bf16(v[k][2] * rc, v[k][3] * rc); w[k].z = pg8::cvt_pk_bf16(v[k][4] * rc, v[k][5] * rc); w[k].w = pg8::cvt_pk_bf16(v[k][6] * rc, v[k][7] * rc); }
}
#define LDS_BAR() do { asm volatile("s_waitcnt lgkmcnt(0)" ::: "memory"); __builtin_amdgcn_s_barrier(); asm volatile("" ::: "memory"); } while (0)
#define WG_BAR() do { asm volatile("s_waitcnt vmcnt(0) lgkmcnt(0)" ::: "memory"); __builtin_amdgcn_s_barrier(); asm volatile("" ::: "memory"); } while (0)
__device__ __forceinline__ void pack_o(const f32x16 (&o)[2], float s, unsigned (&p)[16]) {
#pragma unroll
    for (int db = 0; db < 2; ++db)
#pragma unroll
        for (int g = 0; g < 4; ++g) { p[db * 8 + g * 2] = pg8::cvt_pk_bf16(o[db][4 * g] * s, o[db][4 * g + 1] * s); p[db * 8 + g * 2 + 1] = pg8::cvt_pk_bf16(o[db][4 * g + 2] * s, o[db][4 * g + 3] * s); }
}
#ifndef PROBE_IV
#define PROBE_IV -1
#endif
#define IV_STAMP(i_) do { if (PROBE_IV >= 0 && blockIdx.x == 0 && F.tid == 0) { F.MISC[20 + (i_)] = (unsigned)__builtin_amdgcn_s_memrealtime(); } } while (0)
constexpr int OST = 144;
__device__ __forceinline__ void mixer_prompt_unit(const Frame& F, KArgs args, int l, int unit, bool build_tab, bool bar_inside = false) {
    const int tid = F.tid, lane = F.lane, wave = F.wave, q = lane & 31, hi = lane >> 5;
    const int b = unit >> 7, n = (unit >> 1) & 63, qh = unit & 1;
    const size_t R0 = (size_t)b * SEQ + 128 * n + 64 * qh;
    const long W0 = (long)R0 - 128, B0 = (long)b * SEQ;
    const bf16* Z = WSP(bf16, WS_Z); bf16* MB = WSP(bf16, WS_MB);
    LAS unsigned char* lds = F.lds + RING_OFF;
    const int h = wave, kv = h >> 2;
    IV_STAMP(0);
    const float* cwp = args->in[I_CW] + (size_t)l * 3 * 512;
    const size_t rc0 = R0 + 8 * wave; const long tc0 = (long)rc0 - B0;
    float tb[3];
    {   int tl = tid; asm volatile("" : "+v"(tl));
#pragma unroll
        for (int k = 0; k < 3; ++k) { const int i = tl + 512 * k, hh = i / 192, d = i % 192 - 32, dc = d < 0 ? 0 : (d > 127 ? 127 : d); tb[k] = args->in[I_RB][bucket_of(dc) * 8 + hh]; } }
    const float sink2 = args->in[I_SK][l * 8 + h] * LOG2E;
    v4u sd[12];
#pragma unroll
    for (int k = 0; k < 12; ++k) { const int idx = tid + 512 * k, piece = idx & 31, wrow = idx >> 5; long gr = W0 + wrow; gr = gr < B0 ? B0 : gr;
        sd[k] = *(const v4u*)(Z + (size_t)gr * ZP + ZK + piece * 8); }
    bf16x8 qf0[4]; load_qf(Z + (R0 + q) * ZP + h * 64 + 8 * hi, qf0);
    ConvIn<4> ci0, ci1; float cw[3][8];
    conv_load<4>(Z, rc0, tc0, lane, ci0); load_cw(cwp, lane, cw);
    asm volatile("" ::: "memory");
    if (bar_inside) LDS_BAR();
#pragma unroll
    for (int k = 0; k < 12; ++k) { const int idx = tid + 512 * k, piece = idx & 31, wrow = idx >> 5;
        *(LAS v4u*)(lds + ((piece >> 4) ? LB_V : LB_K) + (((piece >> 3) & 1) * AKR + wrow) * ARS + (piece & 7) * 16) = sd[k]; }
    asm volatile("" ::: "memory");
    conv_load<4>(Z, rc0 + 4, tc0 + 4, lane, ci1);
    asm volatile("" ::: "memory");
    if (build_tab) { LAS float* tab = (LAS float*)(lds + LB_TAB);
#pragma unroll
        for (int k = 0; k < 3; ++k) { const int i = tid + 512 * k, d = i % 192 - 32; tab[i] = (d >= 0 && d < 128) ? tb[k] * LOG2E : -1e30f; }
        if (tid < 192) tab[8 * 192 + tid] = -1e30f; }
    v4u cvo[2][4];
    if (wave < 4) LDS_BAR();
    conv_compute<4>(ci0, cw, tc0, cvo[0]); conv_compute<4>(ci1, cw, tc0 + 4, cvo[1]);
    IV_STAMP(1);
    if (wave >= 4) LDS_BAR();
#pragma unroll
    for (int c = 0; c < 2; ++c)
#pragma unroll
        for (int k = 0; k < 4; ++k) st16_wt(MB + (rc0 + 4 * c + k) * DM + 512 + 8 * lane, cvo[c][k]);
    IV_STAMP(2);
    const LAS float* tab_lane = (const LAS float*)(lds + LB_TAB) + h * 192 + (1 + q - 4 * hi);
    const LAS float* neg_lane = (const LAS float*)(lds + LB_TAB) + 8 * 192 + (1 + q - 4 * hi);
    LAS float* ssqx = (LAS float*)(lds + LB_SSQ);
    const unsigned tm0 = (n == 0) ? ((1u << (4 - 2 * qh)) - 1u) : 0u;
    f32x16 o1[2];
    LAS unsigned char* st0 = lds + LB_ST0 + wave * (32 * OST0);
    {   f32x16 o[2];
        attn_qtile(qf0, lds + LB_K + kv * AKR * ARS, lds + LB_V + kv * AKR * ARS, 0, tab_lane, neg_lane, sink2, tm0, lane, o);
        float ss = sumsq32(o); ss += __shfl_xor(ss, 32); if (hi == 0) ssqx[q * 8 + h] = ss;
        unsigned p0[16]; pack_o(o, 1.0f, p0);
#pragma unroll
        for (int i = 0; i < 8; ++i) *(LAS unsigned long long*)(st0 + q * OST0 + (i >> 2) * 64 + (i & 3) * 16 + hi * 8) = (unsigned long long)p0[2 * i] | ((unsigned long long)p0[2 * i + 1] << 32); }
    LDS_BAR();
    Store4 s4; s4.p = MB + (R0 + (lane >> 3)) * DM + h * 64 + 8 * (lane & 7); s4.step = (size_t)8 * DM;
    {   v4u wq[4];
#pragma unroll
        for (int i = 0; i < 4; ++i) { const int row = 8 * i + (lane >> 3), ch = lane & 7;
            const LAS f32x4* sp = (const LAS f32x4*)(ssqx + row * 8); const f32x4 a = sp[0], c = sp[1];
            const float ra = rsqrtf((((a[0] + a[1]) + (a[2] + a[3])) + ((c[0] + c[1]) + (c[2] + c[3]))) * (1.f / 512.f) + EPS);
            const v4u d = *(const LAS v4u*)(st0 + row * OST0 + ch * 16);
            wq[i].x = pg8::cvt_pk_bf16(bflo(d.x) * ra, bfhi(d.x) * ra); wq[i].y = pg8::cvt_pk_bf16(bflo(d.y) * ra, bfhi(d.y) * ra); wq[i].z = pg8::cvt_pk_bf16(bflo(d.z) * ra, bfhi(d.z) * ra); wq[i].w = pg8::cvt_pk_bf16(bflo(d.w) * ra, bfhi(d.w) * ra); }
        s4.w0 = wq[0]; s4.w1 = wq[1]; s4.w2 = wq[2]; s4.w3 = wq[3]; }
    {   bf16x8 qf1[4]; load_qf(Z + (R0 + 32 + q) * ZP + h * 64 + 8 * hi, qf1);
        attn_qtile<true>(qf1, lds + LB_K + kv * AKR * ARS, lds + LB_V + kv * AKR * ARS, 1, tab_lane, neg_lane, sink2, tm0 >> 1, lane, o1, s4);
        float ss = sumsq32(o1); ss += __shfl_xor(ss, 32); if (hi == 0) ssqx[(32 + q) * 8 + h] = ss; }
    LDS_BAR();
    IV_STAMP(3);
    LAS unsigned char* st1 = lds + wave * (32 * OST);
    {   const LAS f32x4* sp = (const LAS f32x4*)(ssqx + (32 + q) * 8); const f32x4 a = sp[0], c = sp[1];
        const float ra = rsqrtf((((a[0] + a[1]) + (a[2] + a[3])) + ((c[0] + c[1]) + (c[2] + c[3]))) * (1.f / 512.f) + EPS);
        unsigned p1[16]; pack_o(o1, ra, p1);
#pragma unroll
        for (int i = 0; i < 8; ++i) *(LAS unsigned long long*)(st1 + q * OST + (i >> 2) * 64 + (i & 3) * 16 + hi * 8) = (unsigned long long)p1[2 * i] | ((unsigned long long)p1[2 * i + 1] << 32); }
    asm volatile("s_waitcnt lgkmcnt(0)" ::: "memory");
#pragma unroll
    for (int i = 0; i < 4; ++i) { const int row = 8 * i + (lane >> 3), ch = lane & 7;
        const v4u d = *(const LAS v4u*)(st1 + row * OST + ch * 16);
        st16_wt(MB + (R0 + 32 + row) * DM + h * 64 + 8 * ch, d); }
    IV_STAMP(4);
    if (PROBE_IV >= 0) { asm volatile("s_waitcnt vmcnt(0)" ::: "memory"); IV_STAMP(5); }
}
struct SamplePre { f32x4 v0, v1, v2, v3, v4, v5, v6, v7; };
__device__ __forceinline__ SamplePre sample_prefetch(KArgs args, int l, int hu, int tid) {
    const int b = hu >> 1, kv = hu & 1; SamplePre sp;
#define SMP_LD(k_, P0_, P1_) { const int idx = tid + 512 * (k_), isv = idx >> 10, rem = idx & 1023, w = rem >> 3, pc = rem & 7; \
        const float* src = (isv ? args->in[I_CV] : args->in[I_CK]) + (size_t)l * DBATCH * WIN * 128 + (((size_t)b * WIN + w) * 2 + kv) * 64 + pc * 8; \
        P0_ = __builtin_nontemporal_load((const f32x4*)src); P1_ = __builtin_nontemporal_load((const f32x4*)(src + 4)); }
    SMP_LD(0, sp.v0, sp.v1) SMP_LD(1, sp.v2, sp.v3) SMP_LD(2, sp.v4, sp.v5) SMP_LD(3, sp.v6, sp.v7)
#undef SMP_LD
    return sp;
}
__device__ __forceinline__ void mixer_sample_half(const Frame& F, KArgs args, int l, int hu, bool build_tab, bool do_state, bool have_pre, const SamplePre& sp) {
    const int tid = F.tid, lane = F.lane, wave = F.wave, hi = lane >> 5;
    const int b = hu >> 1, kv = hu & 1;
    const size_t RS0 = (size_t)MP + 4 * b;
    const bf16* Z = WSP(bf16, WS_Z); bf16* MB = WSP(bf16, WS_MB);
    LAS unsigned char* lds = F.lds + RING_OFF;
    float* out = args->out;
    IV_STAMP(10);
    const int qc = lane & 31, t = (qc >> 2) & 3, g = qc & 3, head = 4 * kv + g;
    bf16x8 qf[4]; float sink2 = 0.f;
    float cw[3][8]; f32x4 s2a, s2b, s1a, s1b; v4u c2w, c1w, c0w, gbw;
    const int tt = 2 * kv + wave - 2;
    if (wave == 0) { sink2 = args->in[I_SK][l * 8 + head] * LOG2E; load_qf(Z + (RS0 + t) * ZP + head * 64 + 8 * hi, qf); }
    else if (wave == 2 || wave == 3) { load_cw(args->in[I_CW] + (size_t)l * 3 * 512, lane, cw);
        const float* st = args->in[I_ST] + (size_t)l * DBATCH * 2 * 512 + (size_t)b * 2 * 512;
        if (tt >= 2) c2w = *(const v4u*)(Z + (RS0 + tt - 2) * ZP + ZCU + 8 * lane); else { s2a = *(const f32x4*)(st + tt * 512 + 8 * lane); s2b = *(const f32x4*)(st + tt * 512 + 8 * lane + 4); }
        if (tt >= 1) c1w = *(const v4u*)(Z + (RS0 + tt - 1) * ZP + ZCU + 8 * lane); else { s1a = *(const f32x4*)(st + 512 + 8 * lane); s1b = *(const f32x4*)(st + 512 + 8 * lane + 4); }
        c0w = *(const v4u*)(Z + (RS0 + tt) * ZP + ZCU + 8 * lane); gbw = *(const v4u*)(Z + (RS0 + tt) * ZP + ZGB + 8 * lane); }
    float tb[3];
    {   int tl = tid; asm volatile("" : "+v"(tl));
#pragma unroll
        for (int k = 0; k < 3; ++k) { const int i = tl + 512 * k, hh = i / 192, d = i % 192 - 32, dc = d < 0 ? 0 : (d > 127 ? 127 : d); tb[k] = args->in[I_RB][bucket_of(dc) * 8 + hh]; } }
    const int si = hu * 512 + tid; bf16 sk = 0, sv = 0, scp = 0, scs = 0;
    if (do_state) {
        if (si < NBATCH * WIN * 128) { const int bb = si / (WIN * 128), w = (si / 128) % WIN, c = si % 128; const size_t r = (size_t)bb * SEQ + SEQ - WIN + w; sk = Z[r * ZP + ZK + c]; sv = Z[r * ZP + ZV + c]; }
        if (si < NBATCH * 2 * 512) { const int bb = si / 1024, j = (si / 512) % 2, ch = si % 512; const size_t r = (size_t)bb * SEQ + SEQ - 2 + j; scp = Z[r * ZP + ZCU + ch]; }
        { const int bb = si / 1024, j = (si / 512) % 2, ch = si % 512; const size_t r = (size_t)MP + bb * DT + 2 + j; scs = Z[r * ZP + ZCU + ch]; } }
    v4u nd = {0u, 0u, 0u, 0u};
    if (tid < 64) nd = *(const v4u*)(Z + (RS0 + (tid >> 4)) * ZP + (((tid >> 3) & 1) ? ZV : ZK) + kv * 64 + (tid & 7) * 8);
    asm volatile("" ::: "memory");
#define SMP_PIECE(k_, P0_, P1_) { const int idx = tid + 512 * (k_), isv = idx >> 10, rem = idx & 1023, w = rem >> 3, pc = rem & 7; \
        const size_t off = (size_t)l * DBATCH * WIN * 128 + (((size_t)b * WIN + w) * 2 + kv) * 64 + pc * 8; \
        const float* src = (isv ? args->in[I_CV] : args->in[I_CK]) + off; \
        f32x4 x0, x1; if (have_pre) { x0 = P0_; x1 = P1_; } else { x0 = __builtin_nontemporal_load((const f32x4*)src); x1 = __builtin_nontemporal_load((const f32x4*)(src + 4)); } \
        v4u pk; pk.x = pg8::cvt_pk_bf16(x0[0], x0[1]); pk.y = pg8::cvt_pk_bf16(x0[2], x0[3]); pk.z = pg8::cvt_pk_bf16(x1[0], x1[1]); pk.w = pg8::cvt_pk_bf16(x1[2], x1[3]); \
        *(LAS v4u*)(lds + (isv ? LB_V : LB_K) + w * ARS + pc * 16) = pk; \
        if (w >= DT) { float* dst = out + (isv ? OUT_NVS : OUT_NKS) + off - (size_t)DT * 128; \
            __builtin_nontemporal_store(x0, (f32x4*)dst); __builtin_nontemporal_store(x1, (f32x4*)(dst + 4)); } }
    SMP_PIECE(0, sp.v0, sp.v1) SMP_PIECE(1, sp.v2, sp.v3) SMP_PIECE(2, sp.v4, sp.v5) SMP_PIECE(3, sp.v6, sp.v7)
#undef SMP_PIECE
    if (tid < 64) { const int tr = tid >> 4, isv = (tid >> 3) & 1, pc = tid & 7; const v4u d = nd;
        *(LAS v4u*)(lds + (isv ? LB_V : LB_K) + (128 + tr) * ARS + pc * 16) = d;
        float f[8]; unpack8(d, f);
        float* dst = out + (isv ? OUT_NVS : OUT_NKS) + (size_t)l * DBATCH * WIN * 128 + (((size_t)b * WIN + (WIN - DT) + tr) * 2 + kv) * 64 + pc * 8;
        *(f32x4*)dst = (f32x4){f[0], f[1], f[2], f[3]}; *(f32x4*)(dst + 4) = (f32x4){f[4], f[5], f[6], f[7]}; }
    if (tid < 28 * 16) { const int zr = tid >> 4, isv = (tid >> 3) & 1, pc = tid & 7;
        v4u z4 = {0u, 0u, 0u, 0u}; asm volatile("" : "+v"(z4));
        *(LAS v4u*)(lds + (isv ? LB_V : LB_K) + (132 + zr) * ARS + pc * 16) = z4; }
    if (build_tab) { LAS float* tab = (LAS float*)(lds + LB_TAB);
#pragma unroll
        for (int k = 0; k < 3; ++k) { const int i = tid + 512 * k, d = i % 192 - 32; tab[i] = (d >= 0 && d < 128) ? tb[k] * LOG2E : -1e30f; }
        if (tid < 192) tab[8 * 192 + tid] = -1e30f; }
    IV_STAMP(11);
    LDS_BAR();
    IV_STAMP(12);
    if (wave == 0) {
        f32x16 o[2];
        const LAS float* tab_lane = (const LAS float*)(lds + LB_TAB) + head * 192 + (1 + t - 4 * hi);
        attn_qtile(qf, lds + LB_K, lds + LB_V, 0, tab_lane, tab_lane, sink2, 0u, lane, o);
        float ss = sumsq32(o); ss += __shfl_xor(ss, 32); ss += __shfl_xor(ss, 1); ss += __shfl_xor(ss, 2);
        if (lane < 16 && g == 0) __hip_atomic_store(WSP(float, WS_SSQS) + (4 * b + t) * 2 + kv, ss, __ATOMIC_RELAXED, __HIP_MEMORY_SCOPE_AGENT);
        if (qc < 16) store_o(MB + (RS0 + t) * DM + head * 64, o, 1.0f, hi);
    } else if (wave == 2 || wave == 3) {
        float c2[8], c1[8], c0[8];
        if (tt >= 2) unpack8(c2w, c2); else { c2[0] = s2a[0]; c2[1] = s2a[1]; c2[2] = s2a[2]; c2[3] = s2a[3]; c2[4] = s2b[0]; c2[5] = s2b[1]; c2[6] = s2b[2]; c2[7] = s2b[3]; }
        if (tt >= 1) unpack8(c1w, c1); else { c1[0] = s1a[0]; c1[1] = s1a[1]; c1[2] = s1a[2]; c1[3] = s1a[3]; c1[4] = s1b[0]; c1[5] = s1b[1]; c1[6] = s1b[2]; c1[7] = s1b[3]; }
        unpack8(c0w, c0);
        float gb[8]; unpack8(gbw, gb);
        float v[8]; float ss = 0.f;
#pragma unroll
        for (int i = 0; i < 8; ++i) { v[i] = gb[i] * (cw[0][i] * c2[i] + cw[1][i] * c1[i] + cw[2][i] * c0[i]); ss += v[i] * v[i]; }
        const float rc = rsqrtf(wave_sum(ss) * (1.f / 512.f) + EPS);
        v4u w; w.x = pg8::cvt_pk_bf16(v[0] * rc, v[1] * rc); w.y = pg8::cvt_pk_bf16(v[2] * rc, v[3] * rc); w.z = pg8::cvt_pk_bf16(v[4] * rc, v[5] * rc); w.w = pg8::cvt_pk_bf16(v[6] * rc, v[7] * rc);
        st16_wt(MB + (RS0 + tt) * DM + 512 + 8 * lane, w);
    }
    if (do_state) {
        if (si < NBATCH * WIN * 128) { out[OUT_NKP + (size_t)l * NBATCH * WIN * 128 + si] = bf2f(sk); out[OUT_NVP + (size_t)l * NBATCH * WIN * 128 + si] = bf2f(sv); }
        if (si < NBATCH * 2 * 512) out[OUT_NCP + (size_t)l * NBATCH * 1024 + si] = bf2f(scp);
        out[OUT_NCS + (size_t)l * DBATCH * 1024 + si] = bf2f(scs); }
    IV_STAMP(13);
}
__device__ __forceinline__ void state_outputs(const Frame& F, KArgs args, int l, int wg, int nwg) {
    const bf16* Z = WSP(bf16, WS_Z); float* out = args->out;
    const size_t gt = (size_t)wg * 512 + F.tid, NT = (size_t)nwg * 512;
    for (size_t i = gt; i < (size_t)DBATCH * 2 * 512; i += NT) {
        if (i < (size_t)NBATCH * WIN * 128) { const int b = i / (WIN * 128), w = (i / 128) % WIN, c = i % 128; const size_t r = (size_t)b * SEQ + SEQ - WIN + w;
            out[OUT_NKP + (size_t)l * NBATCH * WIN * 128 + i] = bf2f(Z[r * ZP + ZK + c]); out[OUT_NVP + (size_t)l * NBATCH * WIN * 128 + i] = bf2f(Z[r * ZP + ZV + c]); }
        if (i < (size_t)NBATCH * 2 * 512) { const int b = i / 1024, j = (i / 512) % 2, ch = i % 512; const size_t r = (size_t)b * SEQ + SEQ - 2 + j;
            out[OUT_NCP + (size_t)l * NBATCH * 1024 + i] = bf2f(Z[r * ZP + ZCU + ch]); }
        { const int b = i / 1024, j = (i / 512) % 2, ch = i % 512; const size_t r = (size_t)MP + b * DT + 2 + j;
            out[OUT_NCS + (size_t)l * DBATCH * 1024 + i] = bf2f(Z[r * ZP + ZCU + ch]); }
    }
}
template <bool PRE> __device__ __forceinline__ void phaseB(const Frame& F0, KArgs args, int l, const SamplePre& pre, int uid) {
    Frame F = F0; F.lane = hw_lane(); F.tid = F.wave * 64 + F.lane; asm volatile("" : "+v"(F.tid), "+v"(F.lane));
    IV_STAMP(6);
    if constexpr (PRE) {
        LDS_BAR(); mixer_sample_half(F, args, l, uid, true, true, true, pre);
        IV_STAMP(7);
        F.lane = hw_lane(); F.tid = F.wave * 64 + F.lane; asm volatile("" : "+v"(F.tid), "+v"(F.lane));
        mixer_prompt_unit(F, args, l, uid, false, true);
    } else {
        bool need_tab = true;
        for (int u = F.vcu; u < NBATCH * 64 * 2; u += F.G) { LDS_BAR(); mixer_prompt_unit(F, args, l, u, need_tab); need_tab = false; }
        F.lane = hw_lane(); F.tid = F.wave * 64 + F.lane; asm volatile("" : "+v"(F.tid), "+v"(F.lane));
        for (int hu = F.vcu; hu < 2 * DBATCH; hu += F.G) { LDS_BAR(); SamplePre none; mixer_sample_half(F, args, l, hu, need_tab, false, false, none); need_tab = false; }
        state_outputs(F, args, l, F.vcu, F.G);
    }
    IV_STAMP(8);
    WG_BAR();
}
template <int K, bool LAST>
__device__ __forceinline__ void tail_gemm_resid(const Frame& F, const bf16* A, const bf16* Bt, bf16* xb, float* out, float* ssq_rows  , int tile, const float* ssq_attn = nullptr) {
    const int lane = F.lane, wave = F.wave, fr = lane & 15, fq = lane >> 4;
    const int row0 = (tile >> 4) * 32, col0 = (tile & 15) * 64, tc = tile & 15;
    constexpr int KW = K / 8, STEPS = KW / 32; static_assert(KW % 32 == 0, "K split");
    f32x4 acc[2][4];
#pragma unroll
    for (int m = 0; m < 2; ++m)
#pragma unroll
        for (int n = 0; n < 4; ++n) acc[m][n] = (f32x4){0.f, 0.f, 0.f, 0.f};
    const bf16* ap = A + (size_t)(row0 + fr) * K + wave * KW + 8 * fq;
    const bf16* bp = Bt + (size_t)(col0 + fr) * K + wave * KW + 8 * fq;
#pragma unroll 2
    for (int s = 0; s < STEPS; ++s) {
        bf16x8 a[2], b[4];
#pragma unroll
        for (int m = 0; m < 2; ++m) a[m] = *(const bf16x8*)(ap + (size_t)(16 * m) * K + 32 * s);
#pragma unroll
        for (int n = 0; n < 4; ++n) b[n] = *(const bf16x8*)(bp + (size_t)(16 * n) * K + 32 * s);
#pragma unroll
        for (int m = 0; m < 2; ++m)
#pragma unroll
            for (int n = 0; n < 4; ++n) acc[m][n] = __builtin_amdgcn_mfma_f32_16x16x32_bf16(b[n], a[m], acc[m][n], 0, 0, 0);
    }
    if (ssq_attn && K == DM && wave < 4) {
#pragma unroll
        for (int m = 0; m < 2; ++m) { const float rs = rsqrtf((ssq_attn[2 * (row0 + 16 * m + fr)] + ssq_attn[2 * (row0 + 16 * m + fr) + 1]) * (1.0f / 512.0f) + EPS);
#pragma unroll
            for (int n = 0; n < 4; ++n) acc[m][n] *= rs; } }
    LAS float* red = (LAS float*)(F.lds + RING_OFF);
#pragma unroll
    for (int m = 0; m < 2; ++m)
#pragma unroll
        for (int n = 0; n < 4; ++n) *(LAS f32x4*)(red + ((wave * 32 + 16 * m + fr) * 64 + 16 * n + 4 * fq)) = acc[m][n];
    WG_BAR();
    const int t = F.tid, r = t >> 4, c4 = (t & 15) * 4;
    bf16* xp = xb + (size_t)(row0 + r) * DM + col0 + c4;
    const unsigned long long bw = *(const unsigned long long*)xp;
    f32x4 v = (f32x4){bflo((unsigned)bw), bfhi((unsigned)bw), bflo((unsigned)(bw >> 32)), bfhi((unsigned)(bw >> 32))};
#pragma unroll
    for (int w = 0; w < 8; ++w) v += *(const LAS f32x4*)(red + ((w * 32 + r) * 64 + c4));
    if (LAST) *(f32x4*)(out + (size_t)(row0 + r) * DM + col0 + c4) = v;
    else *(unsigned long long*)xp = (unsigned long long)pg8::cvt_pk_bf16(v[0], v[1]) | ((unsigned long long)pg8::cvt_pk_bf16(v[2], v[3]) << 32);
    float q = (v[0] * v[0] + v[1] * v[1]) + (v[2] * v[2] + v[3] * v[3]);
    q += __shfl_xor(q, 1); q += __shfl_xor(q, 2); q += __shfl_xor(q, 4); q += __shfl_xor(q, 8);
    if ((t & 15) == 0) ssq_rows[(size_t)tc * M + row0 + r] = q;
    WG_BAR();
}
__device__ __forceinline__ void phase_final(const Frame& F0, KArgs args) {
    Frame F = F0; F.lane = hw_lane(); F.tid = F.wave * 64 + F.lane; asm volatile("" : "+v"(F.tid), "+v"(F.lane));
    const int gw = F.vcu * NWAVES + F.wave, NGW = F.G * NWAVES;
    const float* SSQA = WSP(float, WS_SSQA);
    const bf16* XB = WSP(bf16, WS_XB);
    for (int m = gw; m < M; m += NGW) {
        float part = F.lane < 16 ? SSQA[(size_t)F.lane * M + m] : 0.f;
        const float rstd = rsqrtf(wave_sum(part) * (1.f / DM) + EPS);
        const GAS unsigned long long* xr = (const GAS unsigned long long*)(XB + (size_t)m * DM) + F.lane; const GAS f32x4* g = (const GAS f32x4*)args->in[I_FIN] + F.lane;
        GAS f32x4* yr = (GAS f32x4*)(args->out + (size_t)m * DM) + F.lane;
#pragma unroll
        for (int j = 0; j < 4; ++j) { const unsigned long long w = xr[64 * j]; const f32x4 gg = g[64 * j];
            f32x4 v = (f32x4){bflo((unsigned)w), bfhi((unsigned)w), bflo((unsigned)(w >> 32)), bfhi((unsigned)(w >> 32))}; v = v * rstd * gg; __builtin_nontemporal_store(v, (f32x4*)(yr + 64 * j)); }
    }
}

#ifndef REP_A
#define REP_A 1
#endif
#ifndef REP_D
#define REP_D 1
#endif
#ifndef REP_T
#define REP_T 1
#endif
#ifndef REP_BAR_REL
#define REP_BAR_REL true
#endif
#ifndef REP_BAR
#define REP_BAR 0
#endif
#ifndef REP_P0
#define REP_P0 1
#endif
#ifndef REP_B
#define REP_B 1
#endif
template <bool PRE> __global__ void __launch_bounds__(NWAVES * 64, 2) mega_fwd(Args args_) {
    extern __shared__ __attribute__((aligned(16))) unsigned char lds[];
    Frame F;
    F.lds = (LAS unsigned char*)lds;
    F.MISC = (volatile LAS unsigned*)(F.lds + MISC_OFF);
    F.tid = threadIdx.x; F.lane = F.tid & 63; F.wave = __builtin_amdgcn_readfirstlane(F.tid >> 6);
    F.G = gridDim.x; { const int bx = blockIdx.x; F.vcu = (F.G % 8 == 0) ? (bx % 8) * (F.G / 8) + bx / 8 : bx; }
    F.ctl = (gu32*)(args_.ws + WS_CTL);
    for (int u = F.tid; u < (LDS_BYTES - LDSCTL_OFF) / 4; u += NWAVES * 64) ((LAS unsigned*)(F.lds + LDSCTL_OFF))[u] = 0u;
    __syncthreads();
    XcdBarrier bar = xcd_barrier_post((unsigned*)(F.ctl + CW_BAR), F.MISC + 8, F.wave);
#if PROBE_TS
#define PROBE_HIT(i_) (((i_) == 0) ? false : ((i_) == 100 ? PROBE_PH == 7 : ((i_) == 1 ? PROBE_PH == 0 : (((i_) - 2) % 5 + 1 == PROBE_PH || (PROBE_PH == 8 && ((i_) - 2) % 5 == 1)))))
#define BAR_STAMP(i) do { const int i_ = (i); const bool hit_ = PROBE_HIT(i_); \
    for (int rb_ = 0; rb_ < (hit_ ? 2 : 1); ++rb_) { GRID_BAR(); \
        if (blockIdx.x == 0 && F.tid == 0) { const unsigned long long now_ = __builtin_amdgcn_s_memrealtime(); \
            if (hit_ && rb_ == 0) { const unsigned long long t0_ = ((unsigned long long)F.MISC[17] << 32) | F.MISC[16]; const unsigned long long d_ = now_ - t0_; while (__builtin_amdgcn_s_memrealtime() < now_ + 4 * d_) __builtin_amdgcn_s_sleep(20); } \
            if (PROBE_PH == 9 && i_ == 5 && rb_ == 0) { const unsigned long long t0_ = ((unsigned long long)F.MISC[17] << 32) | F.MISC[16], m0_ = ((unsigned long long)F.MISC[19] << 32) | F.MISC[18]; \
                const unsigned long long drt_ = now_ - t0_, dmt_ = __builtin_amdgcn_s_memtime() - m0_; const unsigned long long sp_ = dmt_ * 1000ull / drt_; while (__builtin_amdgcn_s_memrealtime() < now_ + sp_) __builtin_amdgcn_s_sleep(20); } \
            const unsigned long long n2_ = __builtin_amdgcn_s_memrealtime(); F.MISC[16] = (unsigned)n2_; F.MISC[17] = (unsigned)(n2_ >> 32); const unsigned long long m2_ = __builtin_amdgcn_s_memtime(); F.MISC[18] = (unsigned)m2_; F.MISC[19] = (unsigned)(m2_ >> 32); } } } while (0)
#define STAMP0() do { if (blockIdx.x == 0 && F.tid == 0) { const unsigned long long n2_ = __builtin_amdgcn_s_memrealtime(); F.MISC[16] = (unsigned)n2_; F.MISC[17] = (unsigned)(n2_ >> 32); } } while (0)
#else
#define BAR_STAMP(i) GRID_BAR()
#define STAMP0() do {} while (0)
#endif
#define GRID_BAR() do { XcdBarrier bb_ = bar; asm volatile("" : "+s"(bb_.x)); xcd_barrier(bb_); } while (0)
#define PHASE_ARGS() KArgs args = (KArgs)__builtin_amdgcn_kernarg_segment_ptr(); asm volatile("" : "+s"(args))
#define LAYER() int l = l_; asm volatile("" : "+s"(l))

    STAMP0();
    for (int rep_ = 0; rep_ < REP_P0; ++rep_) { PHASE_ARGS(); p0_prologue(F, args); }
    BAR_STAMP(1);
    int uid_b0 = F.vcu;
    if constexpr (PRE) { pg8::StaticOrder Sc; Sc.init(MP, DM, F.G, (int)blockIdx.x); pg8::Unit uc; uc.pm = 0; uc.pn = 0; (void)Sc.next(0, uc); uid_b0 = 4 * uc.pm + uc.pn; }
    asm volatile("" : "+s"(uid_b0));
    const int uid_k = uid_b0;
    for (int l_ = 0; l_ < NLAYER; ++l_) {
        int uid_b = uid_k; asm volatile("" : "+s"(uid_b));
        {   PHASE_ARGS(); LAYER();
            pg8::Gemm g{WSP(bf16, WS_XB), WSP(bf16, WS_WIN) + (size_t)l * NIN * DM, M, NIN, DM};
            pg8::EpiScaleBf16 E{WSP(bf16, WS_Z), ZP, WSP(float, WS_SSQA), l == 0 ? 1 : 16, M};
            if constexpr (PRE) { pg8::XcdOrder S; S.init(M, NIN, F.G, (int)blockIdx.x); pg8::gemm_phase<pg8::EpiScaleBf16, pg8::XcdOrder, true, true>(F.lds + RING_OFF, g, S, E, F.wave); }
            else { pg8::StaticOrder S; S.init(M, NIN, F.G, (int)blockIdx.x); pg8::gemm_phase<pg8::EpiScaleBf16, pg8::StaticOrder, true, true>(F.lds + RING_OFF, g, S, E, F.wave); }
            const int full = ((M / 256) * (NIN / 256)) % F.G;
            if ((int)blockIdx.x >= full) { Frame F2 = F; F2.lane = hw_lane(); F2.tid = F2.wave * 64 + F2.lane; asm volatile("" : "+v"(F2.tid), "+v"(F2.lane)); cvt_range(args, l, CI_G, (l + 1 < NLAYER) ? CI_END : CI_D, ((int)blockIdx.x - full) * NWAVES + F2.wave, (F.G - full) * NWAVES, F2.lane); }
        }
        SamplePre spre;
#if PROBE_TS
        BAR_STAMP(2 + 5 * l_);
        if constexpr (PRE) { PHASE_ARGS(); LAYER(); spre = sample_prefetch(args, l, uid_b, F.wave * 64 + hw_lane()); }
#else
        if constexpr (PRE) { PHASE_ARGS(); LAYER();
            const int hu_ = F.vcu, wv_ = F.wave; XcdBarrier bb_ = bar; asm volatile("" : "+s"(bb_.x));
            xcd_barrier_enter();
            spre = sample_prefetch(args, l, uid_b, wv_ * 64 + hw_lane());
            xcd_barrier_rest<true>(bb_);
        } else GRID_BAR();
#endif
        for (int rep_ = 0; rep_ < REP_B; ++rep_) { PHASE_ARGS(); LAYER(); phaseB<PRE>(F, args, l, spre, uid_b); }
#if PROBE_TS
        BAR_STAMP(3 + 5 * l_);
#else
        if constexpr (PRE) {
            LAYER(); unsigned* c_ = (unsigned*)(F.ctl + CW_BC) + 64 * l + (uid_b >> 2);
            asm volatile("s_waitcnt vmcnt(0)" ::: "memory"); __syncthreads();
            if (F.wave == 0 && hw_lane() == 0) { (void)__hip_atomic_fetch_add(c_, 1u, __ATOMIC_RELAXED, __HIP_MEMORY_SCOPE_AGENT);
                asm volatile("buffer_inv sc1" ::: "memory"); }
        } else GRID_BAR();
#endif
        if (PROBE_IV >= 0 && l_ == 0 && blockIdx.x == 0) { IV_STAMP(9); __syncthreads(); if (F.tid == 0) { const unsigned d_ = F.MISC[20 + PROBE_IV + 1] - F.MISC[20 + PROBE_IV]; const unsigned long long now_ = __builtin_amdgcn_s_memrealtime(); while (__builtin_amdgcn_s_memrealtime() < now_ + 16ull * d_) __builtin_amdgcn_s_sleep(20); } __syncthreads(); }
        {   PHASE_ARGS(); LAYER();
            pg8::Gemm g{WSP(bf16, WS_MB), WSP(bf16, WS_WOUT) + (size_t)l * DM * DM, MP, DM, DM}; pg8::StaticOrder S; S.init(MP, DM, F.G, (int)blockIdx.x);
            if (F.G == 256) {
                pg8::Unit u0; S.next(0, u0);
                pg8::EpiResidX<DM, true> E{WSP(bf16, WS_XB), WSP(float, WS_SSQD), M, WSP(bf16, WS_MB) + (size_t)MP * DM, MS, WSP(bf16, WS_XB) + (size_t)MP * DM, WSP(float, WS_SSQD) + MP, WSP(float, WS_SSQS), u0.pm, nullptr, nullptr, nullptr, MP};
#if PROBE_TS
                pg8::gemm_phase<pg8::EpiResidX<DM, true>, pg8::StaticOrder, false, true>(F.lds + RING_OFF, g, S, E, F.wave);
#else
                if constexpr (PRE) { pg8::MeetOrder Sm; Sm.init(MP, DM, F.G, (int)blockIdx.x); Sm.cnt = (unsigned*)(F.ctl + CW_BC) + 64 * l + (uid_b >> 2); Sm.wave = F.wave;
                    pg8::gemm_phase<pg8::EpiResidX<DM, true>, pg8::MeetOrder, false, true>(F.lds + RING_OFF, g, Sm, E, F.wave); }
                else pg8::gemm_phase<pg8::EpiResidX<DM, true>, pg8::StaticOrder, false, true>(F.lds + RING_OFF, g, S, E, F.wave);
#endif
            } else {
                pg8::EpiResid<false> E{WSP(bf16, WS_XB), args->out, WSP(float, WS_SSQD), M};
                pg8::gemm_phase<pg8::EpiResid<false>, pg8::StaticOrder, true, true>(F.lds + RING_OFF, g, S, E, F.wave);
                Frame F2 = F; F2.lane = hw_lane(); F2.tid = F2.wave * 64 + F2.lane; asm volatile("" : "+v"(F2.tid), "+v"(F2.lane));
                for (int tile = F.vcu; tile < 256; tile += F.G)
                    tail_gemm_resid<DM, false>(F2, WSP(bf16, WS_MB) + (size_t)MP * DM, WSP(bf16, WS_WOUT) + (size_t)l * DM * DM, WSP(bf16, WS_XB) + (size_t)MP * DM, args->out + (size_t)MP * DM, WSP(float, WS_SSQD) + MP, tile, WSP(float, WS_SSQS));
            }
        }
        BAR_STAMP(4 + 5 * l_);
        {   PHASE_ARGS(); LAYER();
            pg8::Gemm g{WSP(bf16, WS_XB), WSP(bf16, WS_WGU) + (size_t)l * NGU * DM, M, NGU, DM};
            pg8::EpiSwiGLU E{WSP(bf16, WS_HB), DFF, WSP(float, WS_SSQD), 16, M};
            if constexpr (PRE) { pg8::XcdOrder S; S.init(M, NGU, F.G, (int)blockIdx.x); pg8::gemm_phase<pg8::EpiSwiGLU, pg8::XcdOrder, true, true>(F.lds + RING_OFF, g, S, E, F.wave); }
            else { pg8::StaticOrder S; S.init(M, NGU, F.G, (int)blockIdx.x); pg8::gemm_phase<pg8::EpiSwiGLU, pg8::StaticOrder, true, true>(F.lds + RING_OFF, g, S, E, F.wave); }
            const int full = ((M / 256) * (NGU / 256)) % F.G;
            if ((int)blockIdx.x >= full) { Frame F2 = F; F2.lane = hw_lane(); F2.tid = F2.wave * 64 + F2.lane; asm volatile("" : "+v"(F2.tid), "+v"(F2.lane));
                if (l + 1 < NLAYER) cvt_range(args, l + 1, CI_IN, CI_G, ((int)blockIdx.x - full) * NWAVES + F2.wave, (F.G - full) * NWAVES, F2.lane);
                else cvt_range(args, l, CI_D, CI_END, ((int)blockIdx.x - full) * NWAVES + F2.wave, (F.G - full) * NWAVES, F2.lane); }
        }
        BAR_STAMP(5 + 5 * l_);
        {   PHASE_ARGS(); LAYER();
            pg8::Gemm g{WSP(bf16, WS_HB), WSP(bf16, WS_WDN) + (size_t)l * DM * DFF, MP, DM, DFF}; pg8::StaticOrder S; S.init(MP, DM, F.G, (int)blockIdx.x);
            if (F.G == 256) {
                if (l + 1 < NLAYER) {
                    pg8::EpiResidX<DFF, false> E{WSP(bf16, WS_XB), WSP(float, WS_SSQA), M, WSP(bf16, WS_HB) + (size_t)MP * DFF, MS, WSP(bf16, WS_XB) + (size_t)MP * DM, WSP(float, WS_SSQA) + MP, nullptr, 0, nullptr, nullptr, nullptr, MP};
                    pg8::gemm_phase<pg8::EpiResidX<DFF, false>, pg8::StaticOrder, false, true>(F.lds + RING_OFF, g, S, E, F.wave);
                } else {
                    pg8::EpiResidX<DFF, false, true> E{WSP(bf16, WS_XB), WSP(float, WS_SSQA), M, WSP(bf16, WS_HB) + (size_t)MP * DFF, MS, WSP(bf16, WS_XB) + (size_t)MP * DM, WSP(float, WS_SSQA) + MP, nullptr, 0, args->out, args->in[I_FIN], (unsigned*)(F.ctl + CW_FIN), MP};
                    pg8::gemm_phase<pg8::EpiResidX<DFF, false, true>, pg8::StaticOrder, false, true>(F.lds + RING_OFF, g, S, E, F.wave);
                }
            } else {
                pg8::EpiResid<false> E{WSP(bf16, WS_XB), args->out, WSP(float, WS_SSQA), M};
                pg8::gemm_phase<pg8::EpiResid<false>, pg8::StaticOrder, true, true>(F.lds + RING_OFF, g, S, E, F.wave);
                Frame F2 = F; F2.lane = hw_lane(); F2.tid = F2.wave * 64 + F2.lane; asm volatile("" : "+v"(F2.tid), "+v"(F2.lane));
                for (int tile = F.vcu; tile < 256; tile += F.G)
                    tail_gemm_resid<DFF, false>(F2, WSP(bf16, WS_HB) + (size_t)MP * DFF, WSP(bf16, WS_WDN) + (size_t)l * DM * DFF, WSP(bf16, WS_XB) + (size_t)MP * DM, args->out + (size_t)MP * DM, WSP(float, WS_SSQA) + MP, tile);
            }
        }
        if (!(F.G == 256 && l_ + 1 == NLAYER)) BAR_STAMP(6 + 5 * l_);
    }
    for (int rep_ = 0; rep_ < REP_BAR; ++rep_) { XcdBarrier bb_ = bar; asm volatile("" : "+s"(bb_.x)); xcd_barrier<REP_BAR_REL>(bb_); }
    if (F.G != 256) { PHASE_ARGS(); phase_final(F, args); }
#if PROBE_TS
    if (PROBE_PH == 6 && blockIdx.x == 0) { __syncthreads(); if (F.tid == 0) { const unsigned long long now_ = __builtin_amdgcn_s_memrealtime(); const unsigned long long t0_ = ((unsigned long long)F.MISC[17] << 32) | F.MISC[16]; const unsigned long long d_ = now_ - t0_; while (__builtin_amdgcn_s_memrealtime() < now_ + 4 * d_) __builtin_amdgcn_s_sleep(20); } }
#endif
}

extern "C" void kernel_launch(void* const* d_in, const int* in_sizes, int n_in, void* d_out, int out_size, void* d_ws, size_t ws_size, hipStream_t stream) {
    static int grid = 0;
    if (grid == 0) {
        if (n_in != 17 || (size_t)out_size != OUT_END || ws_size < WS_END) { fprintf(stderr, "kernel_launch: unexpected shapes: n_in %d out %d ws %zu\n", n_in, out_size, ws_size); grid = -1; return; }
        int dev = 0, cus = 0, per_cu = 0;
        if (hipGetDevice(&dev) != hipSuccess || hipDeviceGetAttribute(&cus, hipDeviceAttributeMultiprocessorCount, dev) != hipSuccess) { grid = -1; return; }
        if (hipFuncSetAttribute((const void*)mega_fwd<true>, hipFuncAttributeMaxDynamicSharedMemorySize, LDS_BYTES) != hipSuccess || hipFuncSetAttribute((const void*)mega_fwd<false>, hipFuncAttributeMaxDynamicSharedMemorySize, LDS_BYTES) != hipSuccess) { fprintf(stderr, "kernel_launch: hipFuncSetAttribute failed\n"); grid = -1; return; }
        if (hipOccupancyMaxActiveBlocksPerMultiprocessor(&per_cu, (const void*)mega_fwd<true>, NWAVES * 64, LDS_BYTES) != hipSuccess || per_cu < 1 || hipOccupancyMaxActiveBlocksPerMultiprocessor(&per_cu, (const void*)mega_fwd<false>, NWAVES * 64, LDS_BYTES) != hipSuccess || per_cu < 1) { fprintf(stderr, "kernel_launch: occupancy query says %d blocks per CU\n", per_cu); grid = -1; (void)hipGetLastError(); return; }
        grid = cus;
        if (grid > 256) grid = 256;
        grid &= ~7;
    }
    if (grid <= 0) return;
    if (hipMemsetAsync((char*)d_ws + WS_CTL, 0, CTL_ZERO_BYTES, stream) != hipSuccess) return;
    Args a{};
    for (int i = 0; i < 17; ++i) a.in[i] = (const float*)d_in[i];
    a.out = (float*)d_out; a.ws = (unsigned char*)d_ws;
    if (grid == 2 * DBATCH) hipLaunchKernelGGL(mega_fwd<true>, dim3(grid), dim3(NWAVES * 64), LDS_BYTES, stream, a);
    else hipLaunchKernelGGL(mega_fwd<false>, dim3(grid), dim3(NWAVES * 64), LDS_BYTES, stream, a);
}
```
